# Optimizing an MI355X kernel written in HIP

```python
import math
import jax, jax.numpy as jnp
from jax import lax
import numpy as np

D_MODEL = 1024
BATCH = 4
SEQ = 4096
DEPTH = 4
DEC_BATCH = 32
DEC_SEQ = 16
PAST_LEN = 4096

CHUNK = 64
N_EVEN = (DEPTH + 1) // 2
N_ODD = DEPTH // 2
N_VRES = max(N_ODD - 1, 0)
MIX_WIDTH = D_MODEL
POOL_WIDTH = MIX_WIDTH // 2
POOL_GROUPS = 4
POOL_GW = POOL_WIDTH // POOL_GROUPS
POOL_WINDOWS = (2, 4, 8, 16)
POOL_HIST = max(POOL_WINDOWS) - 1
DIFF_WIDTH = MIX_WIDTH - POOL_WIDTH
DIFF_DH = 64
DIFF_HEADS = DIFF_WIDTH // (2 * DIFF_DH)
DIFF_VD = 2 * DIFF_DH
EVEN_IN = POOL_WIDTH + 3 * DIFF_WIDTH
ATTN_Q_BLOCK = 128
RW_N = 64
RW_HEADS = D_MODEL // RW_N
RW_DECAY_LORA = 64
RW_A_LORA = 64
RW_V_LORA = 32
RW_G_LORA = 160
RW_LN_EPS = 64e-5
N_MEM = 256
XA_HEADS = 4
XA_DH = D_MODEL // XA_HEADS
D_FF = -(-8 * D_MODEL // (3 * 256)) * 256
NORM_EPS = 1e-6
NEG_INF = -1e30

kernel_name = 'hybrid_pool_diffattn_rwkv7_stream_step'


def rmsnorm(x, g):
    x32 = x.astype(jnp.float32)
    y = x32 * lax.rsqrt(jnp.mean(x32 * x32, axis=-1, keepdims=True) + NORM_EPS)
    return (y * g.astype(jnp.float32)).astype(x.dtype)


def swiglu(h, wg, wu, wd):
    return (jax.nn.silu(h @ wg) * (h @ wu)) @ wd


def pool_mixer(u, hist, pos, w_grp, scale):
    T = u.shape[1]
    full = jnp.concatenate([hist.astype(u.dtype), u], axis=1)
    csum = jnp.cumsum(full.astype(jnp.float32), axis=1)
    csum = jnp.concatenate([jnp.zeros_like(csum[:, :1]), csum], axis=1)
    end = csum[:, POOL_HIST + 1:POOL_HIST + 1 + T]
    outs = []
    for g, w in enumerate(POOL_WINDOWS):
        sl = slice(g * POOL_GW, (g + 1) * POOL_GW)
        start = csum[:, POOL_HIST + 1 - w:POOL_HIST + 1 - w + T, sl]
        cnt = jnp.minimum(pos + 1, w).astype(jnp.float32)[None, :, None]
        pooled = ((end[..., sl] - start) / cnt - u[..., sl].astype(jnp.float32)).astype(u.dtype)
        outs.append(pooled @ w_grp[g])
    y = jnp.concatenate(outs, axis=-1) * scale
    return y, full[:, -POOL_HIST:]


def diff_attend(q, k, v, q_pos, k_pos, lam):
    s = jnp.einsum('bqhmd,bkhmd->bhmqk', q, k).astype(jnp.float32) * (DIFF_DH ** -0.5)
    mask = (k_pos[None, :] // CHUNK) <= (q_pos[:, None] // CHUNK)
    p = jax.nn.softmax(jnp.where(mask, s, NEG_INF), axis=-1)
    p = p[:, :, 0] - lam * p[:, :, 1]
    return jnp.einsum('bhqk,bkhe->bqhe', p.astype(v.dtype), v)


def diff_attention(q, k, v, q_pos, k_pos, lam):
    B, Tq = q.shape[:2]
    if Tq <= ATTN_Q_BLOCK:
        return diff_attend(q, k, v, q_pos, k_pos, lam)
    nb = Tq // ATTN_Q_BLOCK
    qb = jnp.moveaxis(q.reshape(B, nb, ATTN_Q_BLOCK, *q.shape[2:]), 1, 0)
    pb = q_pos.reshape(nb, ATTN_Q_BLOCK)
    ob = lax.map(lambda a: diff_attend(a[0], k, v, a[1], k_pos, lam), (qb, pb))
    return jnp.moveaxis(ob, 0, 1).reshape(B, Tq, *ob.shape[3:])


def even_mixer(h, pos, k_pos, k_past, v_past, pool_hist, layer_idx, w_in, pool_w, pool_scale,
               lq1, lk1, lq2, lk2, subln_g, w_out):
    B, T, _ = h.shape
    z = h @ w_in
    o1, o2, o3 = POOL_WIDTH, POOL_WIDTH + DIFF_WIDTH, POOL_WIDTH + 2 * DIFF_WIDTH
    u = z[..., :o1]
    q = z[..., o1:o2].reshape(B, T, DIFF_HEADS, 2, DIFF_DH)
    k_new = z[..., o2:o3].reshape(B, T, DIFF_HEADS, 2 * DIFF_DH)
    v_new = z[..., o3:].reshape(B, T, DIFF_HEADS, DIFF_VD)
    pool_out, pool_state = pool_mixer(u, pool_hist, pos, pool_w, pool_scale)
    if k_past is None:
        k_all, v_all = k_new, v_new
    else:
        k_all = jnp.concatenate([k_past.astype(k_new.dtype), k_new], axis=1)
        v_all = jnp.concatenate([v_past.astype(v_new.dtype), v_new], axis=1)
    lam_init = 0.8 - 0.6 * math.exp(-0.3 * layer_idx)
    f32 = jnp.float32
    lam = (jnp.exp(jnp.sum(lq1.astype(f32) * lk1.astype(f32)))
           - jnp.exp(jnp.sum(lq2.astype(f32) * lk2.astype(f32))) + lam_init)
    a = diff_attention(q, k_all.reshape(B, -1, DIFF_HEADS, 2, DIFF_DH), v_all, pos, k_pos, lam)
    a = rmsnorm(a, subln_g) * (1.0 - lam_init)
    y = jnp.concatenate([pool_out, a.reshape(B, T, DIFF_WIDTH).astype(pool_out.dtype)], axis=-1) @ w_out
    return y, k_new, v_new, pool_state


def rwkv_mixer(h, shift_prev, S0, v_first, vres, mu, wr, wk, wv, wo, w0, w1, w2, a0, a1, a2,
               g1, g2, k_k, k_a, r_k, lnx_g, lnx_b):
    B, T, D = h.shape
    f32 = jnp.float32
    h_prev = jnp.concatenate([shift_prev[:, None].astype(h.dtype), h[:, :-1]], axis=1)
    xx = h_prev - h
    xr, xw, xk, xv, xa, xg = [h + xx * mu[i] for i in range(6)]
    r = xr @ wr
    w = -jax.nn.softplus(-(w0 + jnp.tanh(xw @ w1) @ w2)) - 0.5
    k = xk @ wk
    v = xv @ wv
    if vres is None:
        v_first = v
    else:
        v0, v1, v2 = vres
        v = v + (v_first - v) * jax.nn.sigmoid(v0 + (xv @ v1) @ v2)
    a = jax.nn.sigmoid(a0 + (xa @ a1) @ a2)
    g = jax.nn.sigmoid(xg @ g1) @ g2
    heads = lambda t: t.reshape(B, T, RW_HEADS, RW_N).astype(f32)
    kk = heads(k * k_k)
    kk = kk / jnp.maximum(jnp.sqrt(jnp.sum(kk * kk, axis=-1, keepdims=True)), 1e-12)
    k = k * (1 + (a - 1) * k_a)
    decay = jnp.exp(-jnp.exp(w.astype(f32)))
    rh, kh, vh, ah, dh = heads(r), heads(k), heads(v), heads(a), heads(decay)

    def step(S, inp):
        r_t, d_t, k_t, v_t, kk_t, a_t = inp
        sa = jnp.einsum('bhvk,bhk->bhv', S, -kk_t)
        S = (S * d_t[:, :, None, :] + sa[..., None] * (kk_t * a_t)[:, :, None, :]
             + v_t[..., None] * k_t[:, :, None, :])
        return S, jnp.einsum('bhvk,bhk->bhv', S, r_t)

    xs = tuple(jnp.moveaxis(t, 1, 0) for t in (rh, dh, kh, vh, kk, ah))
    S_fin, y = lax.scan(step, S0.astype(f32), xs)
    y = jnp.moveaxis(y, 0, 1)
    m = jnp.mean(y, axis=-1, keepdims=True)
    var = jnp.mean(jnp.square(y - m), axis=-1, keepdims=True)
    y = (y - m) * lax.rsqrt(var + RW_LN_EPS)
    y = y.reshape(B, T, D) * lnx_g.astype(f32) + lnx_b.astype(f32)
    bonus = jnp.sum(rh * kh * r_k.astype(f32), axis=-1, keepdims=True) * vh
    y = (y + bonus.reshape(B, T, D)).astype(h.dtype)
    return (y * g) @ wo, h[:, -1], S_fin, v_first


def cross_attn(h, mk, mv, wq, wo):
    B, T, _ = h.shape
    q = (h @ wq).reshape(B, T, XA_HEADS, XA_DH)
    s = jnp.einsum('bqhd,bkhd->bhqk', q, mk.astype(q.dtype)).astype(jnp.float32) * (XA_DH ** -0.5)
    p = jax.nn.softmax(s, axis=-1).astype(q.dtype)
    o = jnp.einsum('bhqk,bkhd->bqhd', p, mv.astype(q.dtype)).reshape(B, T, D_MODEL)
    return o @ wo


def trunk(x, pos, k_pos, diff_k_past, diff_v_past, pool_hist, rw_shift, rw_state, mem_k, mem_v, P):
    new_k, new_v, new_pool, new_shift, new_S = [], [], [], [], []
    v_first = None
    for l in range(DEPTH):
        h = rmsnorm(x, P['norm_mix_g'][l])
        if l % 2 == 0:
            e = l // 2
            kp = None if diff_k_past is None else diff_k_past[e]
            vp = None if diff_v_past is None else diff_v_past[e]
            y, kn, vn, ps = even_mixer(h, pos, k_pos, kp, vp, pool_hist[e], l, P['ev_w_in'][e],
                                       P['ev_pool_w'][e], P['ev_pool_scale'][e], P['ev_lam_q1'][e],
                                       P['ev_lam_k1'][e], P['ev_lam_q2'][e], P['ev_lam_k2'][e],
                                       P['ev_subln_g'][e], P['ev_w_out'][e])
            new_k.append(kn)
            new_v.append(vn)
            new_pool.append(ps)
        else:
            o = l // 2
            vres = None if o == 0 else (P['rw_v0'][o - 1], P['rw_v1'][o - 1], P['rw_v2'][o - 1])
            y, sh, S, v_first = rwkv_mixer(h, rw_shift[o], rw_state[o], v_first, vres, P['rw_mu'][o],
                                           P['rw_wr'][o], P['rw_wk'][o], P['rw_wv'][o], P['rw_wo'][o],
                                           P['rw_w0'][o], P['rw_w1'][o], P['rw_w2'][o], P['rw_a0'][o],
                                           P['rw_a1'][o], P['rw_a2'][o], P['rw_g1'][o], P['rw_g2'][o],
                                           P['rw_k_k'][o], P['rw_k_a'][o], P['rw_r_k'][o],
                                           P['rw_lnx_g'][o], P['rw_lnx_b'][o])
            new_shift.append(sh)
            new_S.append(S)
        x = x + y
        h = rmsnorm(x, P['norm_xa_g'][l])
        x = x + cross_attn(h, mem_k[l], mem_v[l], P['xa_wq'][l], P['xa_wo'][l])
        h = rmsnorm(x, P['norm_ffn_g'][l])
        x = x + swiglu(h, P['ffn_wg'][l], P['ffn_wu'][l], P['ffn_wd'][l])
    y = rmsnorm(x, P['final_norm_g'])
    return y, jnp.stack(new_k), jnp.stack(new_v), jnp.stack(new_pool), jnp.stack(new_shift), jnp.stack(new_S)


def setup_inputs(seed: int = 0) -> dict:
    key = jax.random.key(seed)
    ks = iter(jax.random.split(key, 64))
    nrm = lambda shape, s=1.0: jax.random.normal(next(ks), shape, jnp.float32) * s
    gain = lambda shape: 1.0 + 0.02 * jax.random.normal(next(ks), shape, jnp.float32)
    D = D_MODEL
    return {
        'x_prompt': nrm((BATCH, SEQ, D)),
        'x_sample': nrm((DEC_BATCH, DEC_SEQ, D)),
        'cache_diff_k': nrm((N_EVEN, DEC_BATCH, PAST_LEN, DIFF_HEADS, 2 * DIFF_DH)),
        'cache_diff_v': nrm((N_EVEN, DEC_BATCH, PAST_LEN, DIFF_HEADS, DIFF_VD)),
        'state_pool': nrm((N_EVEN, DEC_BATCH, POOL_HIST, POOL_WIDTH)),
        'state_rw_shift': nrm((N_ODD, DEC_BATCH, D)),
        'state_rw_wkv': nrm((N_ODD, DEC_BATCH, RW_HEADS, RW_N, RW_N), 0.5),
        'cache_mem_k': nrm((DEPTH, DEC_BATCH, N_MEM, XA_HEADS, XA_DH)),
        'cache_mem_v': nrm((DEPTH, DEC_BATCH, N_MEM, XA_HEADS, XA_DH)),
        'mem_prompt': nrm((BATCH, N_MEM, D)),
        'norm_mix_g': gain((DEPTH, D)),
        'norm_xa_g': gain((DEPTH, D)),
        'norm_ffn_g': gain((DEPTH, D)),
        'final_norm_g': gain((D,)),
        'ev_w_in': nrm((N_EVEN, D, EVEN_IN), D ** -0.5),
        'ev_pool_w': nrm((N_EVEN, POOL_GROUPS, POOL_GW, POOL_GW), POOL_GW ** -0.5),
        'ev_pool_scale': gain((N_EVEN, POOL_WIDTH)),
        'ev_lam_q1': nrm((N_EVEN, DIFF_DH), 0.1),
        'ev_lam_k1': nrm((N_EVEN, DIFF_DH), 0.1),
        'ev_lam_q2': nrm((N_EVEN, DIFF_DH), 0.1),
        'ev_lam_k2': nrm((N_EVEN, DIFF_DH), 0.1),
        'ev_subln_g': gain((N_EVEN, DIFF_VD)),
        'ev_w_out': nrm((N_EVEN, MIX_WIDTH, D), MIX_WIDTH ** -0.5),
        'rw_mu': jax.random.uniform(next(ks), (N_ODD, 6, D), jnp.float32),
        'rw_wr': nrm((N_ODD, D, D), D ** -0.5),
        'rw_wk': nrm((N_ODD, D, D), D ** -0.5),
        'rw_wv': nrm((N_ODD, D, D), D ** -0.5),
        'rw_wo': nrm((N_ODD, D, D), D ** -0.5),
        'rw_w0': jnp.linspace(-6.5, -1.5, D, dtype=jnp.float32)[None] + nrm((N_ODD, D), 0.1),
        'rw_w1': nrm((N_ODD, D, RW_DECAY_LORA), D ** -0.5),
        'rw_w2': nrm((N_ODD, RW_DECAY_LORA, D), 0.1 * RW_DECAY_LORA ** -0.5),
        'rw_a0': nrm((N_ODD, D), 0.1),
        'rw_a1': nrm((N_ODD, D, RW_A_LORA), D ** -0.5),
        'rw_a2': nrm((N_ODD, RW_A_LORA, D), 0.1 * RW_A_LORA ** -0.5),
        'rw_v0': nrm((N_VRES, D), 0.1),
        'rw_v1': nrm((N_VRES, D, RW_V_LORA), D ** -0.5),
        'rw_v2': nrm((N_VRES, RW_V_LORA, D), 0.1 * RW_V_LORA ** -0.5),
        'rw_g1': nrm((N_ODD, D, RW_G_LORA), D ** -0.5),
        'rw_g2': nrm((N_ODD, RW_G_LORA, D), RW_G_LORA ** -0.5),
        'rw_k_k': 0.85 + nrm((N_ODD, D), 0.02),
        'rw_k_a': gain((N_ODD, D)),
        'rw_r_k': nrm((N_ODD, RW_HEADS, RW_N), 0.1),
        'rw_lnx_g': gain((N_ODD, D)),
        'rw_lnx_b': nrm((N_ODD, D), 0.02),
        'xa_wq': nrm((DEPTH, D, D), D ** -0.5),
        'xa_wk': nrm((DEPTH, D, D), D ** -0.5),
        'xa_wv': nrm((DEPTH, D, D), D ** -0.5),
        'xa_wo': nrm((DEPTH, D, D), D ** -0.5),
        'ffn_wg': nrm((DEPTH, D, D_FF), D ** -0.5),
        'ffn_wu': nrm((DEPTH, D, D_FF), D ** -0.5),
        'ffn_wd': nrm((DEPTH, D_FF, D), D_FF ** -0.5),
    }


def reference(x_prompt, x_sample, cache_diff_k, cache_diff_v, state_pool, state_rw_shift, state_rw_wkv,
              cache_mem_k, cache_mem_v, mem_prompt, norm_mix_g, norm_xa_g, norm_ffn_g, final_norm_g,
              ev_w_in, ev_pool_w, ev_pool_scale, ev_lam_q1, ev_lam_k1, ev_lam_q2, ev_lam_k2, ev_subln_g,
              ev_w_out, rw_mu, rw_wr, rw_wk, rw_wv, rw_wo, rw_w0, rw_w1, rw_w2, rw_a0, rw_a1, rw_a2,
              rw_v0, rw_v1, rw_v2, rw_g1, rw_g2, rw_k_k, rw_k_a, rw_r_k, rw_lnx_g, rw_lnx_b,
              xa_wq, xa_wk, xa_wv, xa_wo, ffn_wg, ffn_wu, ffn_wd):
    P = dict(norm_mix_g=norm_mix_g, norm_xa_g=norm_xa_g, norm_ffn_g=norm_ffn_g, final_norm_g=final_norm_g,
             ev_w_in=ev_w_in, ev_pool_w=ev_pool_w, ev_pool_scale=ev_pool_scale, ev_lam_q1=ev_lam_q1,
             ev_lam_k1=ev_lam_k1, ev_lam_q2=ev_lam_q2, ev_lam_k2=ev_lam_k2, ev_subln_g=ev_subln_g,
             ev_w_out=ev_w_out, rw_mu=rw_mu, rw_wr=rw_wr, rw_wk=rw_wk, rw_wv=rw_wv, rw_wo=rw_wo,
             rw_w0=rw_w0, rw_w1=rw_w1, rw_w2=rw_w2, rw_a0=rw_a0, rw_a1=rw_a1, rw_a2=rw_a2,
             rw_v0=rw_v0, rw_v1=rw_v1, rw_v2=rw_v2, rw_g1=rw_g1, rw_g2=rw_g2, rw_k_k=rw_k_k,
             rw_k_a=rw_k_a, rw_r_k=rw_r_k, rw_lnx_g=rw_lnx_g, rw_lnx_b=rw_lnx_b, xa_wq=xa_wq,
             xa_wo=xa_wo, ffn_wg=ffn_wg, ffn_wu=ffn_wu, ffn_wd=ffn_wd)
    Bp, Tp = x_prompt.shape[:2]
    pos_p = jnp.arange(Tp, dtype=jnp.int32)
    p_mem_k = jnp.stack([(mem_prompt @ xa_wk[l]).reshape(Bp, -1, XA_HEADS, XA_DH) for l in range(DEPTH)])
    p_mem_v = jnp.stack([(mem_prompt @ xa_wv[l]).reshape(Bp, -1, XA_HEADS, XA_DH) for l in range(DEPTH)])
    zero_pool = jnp.zeros((N_EVEN, Bp, POOL_HIST, POOL_WIDTH), x_prompt.dtype)
    zero_shift = jnp.zeros((N_ODD, Bp, D_MODEL), x_prompt.dtype)
    zero_wkv = jnp.zeros((N_ODD, Bp, RW_HEADS, RW_N, RW_N), jnp.float32)
    y_prompt, p_diff_k, p_diff_v, p_pool, p_rw_shift, p_rw_wkv = trunk(
        x_prompt, pos_p, pos_p, None, None, zero_pool, zero_shift, zero_wkv, p_mem_k, p_mem_v, P)
    past = cache_diff_k.shape[2]
    Ts = x_sample.shape[1]
    pos_s = past + jnp.arange(Ts, dtype=jnp.int32)
    kpos_s = jnp.arange(past + Ts, dtype=jnp.int32)
    y_sample, s_diff_k, s_diff_v, s_pool, s_rw_shift, s_rw_wkv = trunk(
        x_sample, pos_s, kpos_s, cache_diff_k, cache_diff_v, state_pool, state_rw_shift, state_rw_wkv,
        cache_mem_k, cache_mem_v, P)
    return (y_prompt, y_sample, p_diff_k, p_diff_v, p_pool, p_rw_shift, p_rw_wkv, p_mem_k, p_mem_v,
            s_diff_k, s_diff_v, s_pool, s_rw_shift, s_rw_wkv)
```

```cpp
#include <hip/hip_runtime.h>
#include <stdint.h>

#define DEVI __device__ __forceinline__

namespace {
constexpr int D = 1024, NBP = 4, TP = 4096, NBS = 32, TS = 16, PAST = 4096;
constexpr int MP = NBP * TP, MS = NBS * TS, M = MP + MS;
constexpr int PW = 512, PHIST = 15;
constexpr int NMEM = 256;
constexpr int DFF = 2816;
constexpr float NORM_EPS = 1e-6f, RW_LN_EPS = 64e-5f;

constexpr size_t O_YP = 0;
constexpr size_t O_YS = O_YP + (size_t)MP * D;
constexpr size_t O_PDK = O_YS + (size_t)MS * D;
constexpr size_t O_PDV = O_PDK + (size_t)2 * MP * 512;
constexpr size_t O_PPOOL = O_PDV + (size_t)2 * MP * 512;
constexpr size_t O_PSHIFT = O_PPOOL + (size_t)2 * NBP * PHIST * PW;
constexpr size_t O_PWKV = O_PSHIFT + (size_t)2 * NBP * D;
constexpr size_t O_PMK = O_PWKV + (size_t)2 * NBP * 16 * 4096;
constexpr size_t O_PMV = O_PMK + (size_t)4 * NBP * NMEM * D;
constexpr size_t O_SDK = O_PMV + (size_t)4 * NBP * NMEM * D;
constexpr size_t O_SDV = O_SDK + (size_t)2 * MS * 512;
constexpr size_t O_SPOOL = O_SDV + (size_t)2 * MS * 512;
constexpr size_t O_SSHIFT = O_SPOOL + (size_t)2 * NBS * PHIST * PW;
constexpr size_t O_SWKV = O_SSHIFT + (size_t)2 * NBS * D;
constexpr size_t O_END = O_SWKV + (size_t)2 * NBS * 16 * 4096;

enum { I_XP = 0, I_XS, I_CDK, I_CDV, I_SPOOL, I_SSHIFT, I_SWKV, I_CMK, I_CMV, I_MEMP, I_NMIX, I_NXA, I_NFFN, I_NFIN,
       I_EWIN, I_EPW, I_EPS, I_LQ1, I_LK1, I_LQ2, I_LK2, I_SUBG, I_EWOUT, I_MU, I_WR, I_WK, I_WV, I_WO, I_W0, I_W1, I_W2,
       I_A0, I_A1, I_A2, I_V0, I_V1, I_V2, I_G1, I_G2, I_KK, I_KA, I_RK, I_LNG, I_LNB, I_XWQ, I_XWK, I_XWV, I_XWO,
       I_FWG, I_FWU, I_FWD, N_IN };

constexpr size_t U = (size_t)M * D;
constexpr size_t W_CTL = 0;
constexpr size_t W_X = 65536;
constexpr size_t W_H = W_X + U;
constexpr size_t W_Z = W_H + U;
constexpr size_t W_XM = W_Z + 2 * U;
constexpr size_t W_R = W_XM + 6 * U;
constexpr size_t W_K = W_R + U;
constexpr size_t W_V = W_K + U;
constexpr size_t W_W = W_V + U;
constexpr size_t W_A = W_W + U;
constexpr size_t W_G = W_A + U;
constexpr size_t W_KK = W_G + U;
constexpr size_t W_VF = W_KK + U;
constexpr size_t W_Y = W_VF + U;
constexpr size_t W_LORA = W_Y + U;
constexpr size_t W_VG = W_LORA + U;
constexpr size_t W_END = W_VG + U;
constexpr size_t W_LW = W_LORA, W_LA = W_LW + (size_t)M * 64, W_LG = W_LA + (size_t)M * 64, W_LV = W_LG + (size_t)M * 160;
constexpr size_t W_CAT = W_XM, W_POOLED = W_XM + U, W_Q = W_XM + 2 * U, W_S = W_XM + 3 * U, W_O = W_XM + 4 * U;
constexpr size_t W_GATE = W_XM, W_UP = W_XM + 3 * U;

struct Ctx { const float* in[N_IN]; float* out; float* ws; };

DEVI float wave_sum(float v) {
#pragma unroll
    for (int o = 32; o > 0; o >>= 1) v += __shfl_xor(v, o, 64);
    return v;
}
DEVI float sigmoidf_(float x) { return 1.f / (1.f + __expf(-x)); }

DEVI void ph_rms(const float* __restrict__ X, const float* __restrict__ g, float* __restrict__ H, int rows, int bid, int nb) {
    const int wave = threadIdx.x >> 6, lane = threadIdx.x & 63;
    for (int r = bid * 4 + wave; r < rows; r += nb * 4) {
        const float4* xr = (const float4*)(X + (size_t)r * D);
        float4 v[4]; float ss = 0.f;
#pragma unroll
        for (int i = 0; i < 4; ++i) { v[i] = xr[lane + 64 * i]; ss += v[i].x * v[i].x + v[i].y * v[i].y + v[i].z * v[i].z + v[i].w * v[i].w; }
        ss = wave_sum(ss);
        const float s = rsqrtf(ss * (1.f / D) + NORM_EPS);
        float4* hr = (float4*)(H + (size_t)r * D);
#pragma unroll
        for (int i = 0; i < 4; ++i) { const float4 g4 = ((const float4*)g)[lane + 64 * i]; float4 o; o.x = v[i].x * s * g4.x; o.y = v[i].y * s * g4.y; o.z = v[i].z * s * g4.z; o.w = v[i].w * s * g4.w; hr[lane + 64 * i] = o; }
    }
}

struct GemmD {
    const float* A; const float* B; float* C; int M, N, K, lda, ldb, ldc; int transB; int accum; const float* colscale;
    int nb1, nb2; long sA1, sA2, sB1, sB2, sC1, sC2;
};
DEVI GemmD mk_gemm(const float* A, const float* B, float* C, int M_, int N_, int K_, int lda, int ldb, int ldc, int accum) {
    GemmD g; g.A = A; g.B = B; g.C = C; g.M = M_; g.N = N_; g.K = K_; g.lda = lda; g.ldb = ldb; g.ldc = ldc; g.transB = 0; g.accum = accum; g.colscale = nullptr;
    g.nb1 = 1; g.nb2 = 1; g.sA1 = g.sA2 = g.sB1 = g.sB2 = g.sC1 = g.sC2 = 0; return g;
}
DEVI void ph_gemm(const GemmD& g, int bid, int nb, float* sm) {
    float (*As)[68] = (float (*)[68])sm;
    float (*Bs)[68] = (float (*)[68])(sm + 16 * 68);
    const int t = threadIdx.x, ty = t >> 4, tx = t & 15;
    const int tm = (g.M + 63) >> 6, tn = (g.N + 63) >> 6, per = tm * tn, items = per * g.nb1 * g.nb2;
    for (int it = bid; it < items; it += nb) {
        const int bz = it / per, tt = it % per, z1 = bz / g.nb2, z2 = bz % g.nb2;
        const int m0 = (tt / tn) << 6, n0 = (tt % tn) << 6;
        const float* A = g.A + z1 * g.sA1 + z2 * g.sA2;
        const float* B = g.B + z1 * g.sB1 + z2 * g.sB2;
        float* C = g.C + z1 * g.sC1 + z2 * g.sC2;
        float acc[4][4];
#pragma unroll
        for (int i = 0; i < 4; ++i)
#pragma unroll
            for (int j = 0; j < 4; ++j) acc[i][j] = 0.f;
        for (int k0 = 0; k0 < g.K; k0 += 16) {
            __syncthreads();
            {
                const int row = t >> 2, kq = (t & 3) * 4;
                float4 a = make_float4(0.f, 0.f, 0.f, 0.f);
                if (m0 + row < g.M) a = *(const float4*)(A + (size_t)(m0 + row) * g.lda + k0 + kq);
                As[kq + 0][row] = a.x; As[kq + 1][row] = a.y; As[kq + 2][row] = a.z; As[kq + 3][row] = a.w;
            }
            if (!g.transB) {
                const int k = t >> 4, nq = (t & 15) * 4;
                float4 b = make_float4(0.f, 0.f, 0.f, 0.f);
                if (n0 + nq < g.N) b = *(const float4*)(B + (size_t)(k0 + k) * g.ldb + n0 + nq);
                *(float4*)&Bs[k][nq] = b;
            } else {
                const int n = t >> 2, kq = (t & 3) * 4;
                float4 b = make_float4(0.f, 0.f, 0.f, 0.f);
                if (n0 + n < g.N) b = *(const float4*)(B + (size_t)(n0 + n) * g.ldb + k0 + kq);
                Bs[kq + 0][n] = b.x; Bs[kq + 1][n] = b.y; Bs[kq + 2][n] = b.z; Bs[kq + 3][n] = b.w;
            }
            __syncthreads();
#pragma unroll
            for (int k = 0; k < 16; ++k) {
                const float4 a4 = *(const float4*)&As[k][ty * 4];
                const float4 b4 = *(const float4*)&Bs[k][tx * 4];
                const float a[4] = {a4.x, a4.y, a4.z, a4.w}, b[4] = {b4.x, b4.y, b4.z, b4.w};
#pragma unroll
                for (int i = 0; i < 4; ++i)
#pragma unroll
                    for (int j = 0; j < 4; ++j) acc[i][j] = fmaf(a[i], b[j], acc[i][j]);
            }
        }
        const int col = n0 + tx * 4;
        if (col < g.N) {
            float4 cs = make_float4(1.f, 1.f, 1.f, 1.f);
            if (g.colscale) cs = *(const float4*)(g.colscale + (col - 0));
#pragma unroll
            for (int i = 0; i < 4; ++i) {
                const int row = m0 + ty * 4 + i;
                if (row < g.M) {
                    float4* cp = (float4*)(C + (size_t)row * g.ldc + col);
                    float4 o = make_float4(acc[i][0] * cs.x, acc[i][1] * cs.y, acc[i][2] * cs.z, acc[i][3] * cs.w);
                    if (g.accum) { const float4 p = *cp; o.x += p.x; o.y += p.y; o.z += p.z; o.w += p.w; }
                    *cp = o;
                }
            }
        }
    }
}

DEVI float lam_init_of(int layer) { return 0.8f - 0.6f * __expf(-0.3f * (float)layer); }
DEVI float lam_of(const Ctx& c, int e) {
    float s1 = 0.f, s2 = 0.f;
    for (int i = 0; i < 64; ++i) { s1 += c.in[I_LQ1][e * 64 + i] * c.in[I_LK1][e * 64 + i]; s2 += c.in[I_LQ2][e * 64 + i] * c.in[I_LK2][e * 64 + i]; }
    return __expf(s1) - __expf(s2) + lam_init_of(2 * e);
}

DEVI void ph_pool_prep(const Ctx& c, int e, int bid, int nb) {
    const float* Z = c.ws + W_Z; float* P = c.ws + W_POOLED;
    const size_t total = (size_t)M * 128;
    for (size_t idx = (size_t)bid * 256 + threadIdx.x; idx < total; idx += (size_t)nb * 256) {
        const int row = (int)(idx >> 7), c4 = (int)(idx & 127), col = c4 * 4;
        const int grp = col >> 7, w = 2 << grp;
        const bool prompt = row < MP;
        const int b = prompt ? row / TP : (row - MP) / TS, t = prompt ? row % TP : (row - MP) % TS;
        const float4 u = *(const float4*)(Z + (size_t)row * 2048 + col);
        float4 s = make_float4(0.f, 0.f, 0.f, 0.f);
        for (int i = 0; i < w; ++i) {
            const int tt = t - i;
            float4 v = make_float4(0.f, 0.f, 0.f, 0.f);
            if (tt >= 0) v = *(const float4*)(Z + (size_t)(row - i) * 2048 + col);
            else if (!prompt) v = *(const float4*)(c.in[I_SPOOL] + ((size_t)(e * NBS + b) * PHIST + (PHIST + tt)) * PW + col);
            s.x += v.x; s.y += v.y; s.z += v.z; s.w += v.w;
        }
        const float cnt = prompt ? (float)((t + 1) < w ? (t + 1) : w) : (float)w;
        const float ic = 1.f / cnt;
        float4 o = make_float4(s.x * ic - u.x, s.y * ic - u.y, s.z * ic - u.z, s.w * ic - u.w);
        *(float4*)(P + (size_t)row * PW + col) = o;
        if (prompt) { if (t >= TP - PHIST) *(float4*)(c.out + O_PPOOL + ((size_t)(e * NBP + b) * PHIST + (t - (TP - PHIST))) * PW + col) = u; }
        else { if (t >= 1) *(float4*)(c.out + O_SPOOL + ((size_t)(e * NBS + b) * PHIST + (t - 1)) * PW + col) = u; }
        const float4 kn = *(const float4*)(Z + (size_t)row * 2048 + 1024 + col);
        const float4 vn = *(const float4*)(Z + (size_t)row * 2048 + 1536 + col);
        if (prompt) { *(float4*)(c.out + O_PDK + ((size_t)e * MP + row) * 512 + col) = kn; *(float4*)(c.out + O_PDV + ((size_t)e * MP + row) * 512 + col) = vn; }
        else { *(float4*)(c.out + O_SDK + ((size_t)e * MS + (row - MP)) * 512 + col) = kn; *(float4*)(c.out + O_SDV + ((size_t)e * MS + (row - MP)) * 512 + col) = vn; }
    }
}

DEVI void ph_diffattn(const Ctx& c, int e, int bid, int nb, float* sm) {
    const float* Z = c.ws + W_Z; float* CAT = c.ws + W_CAT;
    const int t = threadIdx.x, qi = t & 63, map = (t >> 6) & 1, half = t >> 7;
    float* Ks = sm; float* Vs = sm + 32 * 128;
    const float lam = lam_of(c, e), li = lam_init_of(2 * e);
    for (int item = bid; item < 1152; item += nb) {
        int b, h, nq, qrow0, n_past, n_new, newrow0; const float* pastK = nullptr; const float* pastV = nullptr;
        if (item < 1024) { b = item >> 8; h = (item >> 6) & 3; const int ch = item & 63; nq = 64; qrow0 = b * TP + ch * 64; n_past = 0; n_new = (ch + 1) * 64; newrow0 = b * TP; }
        else { const int it = item - 1024; b = it >> 2; h = it & 3; nq = TS; qrow0 = MP + b * TS; n_past = PAST; n_new = TS; newrow0 = MP + b * TS;
               pastK = c.in[I_CDK] + ((size_t)(e * NBS + b) * PAST) * 512 + h * 128; pastV = c.in[I_CDV] + ((size_t)(e * NBS + b) * PAST) * 512 + h * 128; }
        const bool act = qi < nq;
        float q[64], o[64];
        {
            const float* qp = Z + (size_t)(qrow0 + (act ? qi : 0)) * 2048 + 512 + h * 128 + map * 64;
#pragma unroll
            for (int d = 0; d < 64; d += 4) { const float4 v = *(const float4*)(qp + d); q[d] = v.x * 0.125f; q[d + 1] = v.y * 0.125f; q[d + 2] = v.z * 0.125f; q[d + 3] = v.w * 0.125f; }
        }
#pragma unroll
        for (int d = 0; d < 64; ++d) o[d] = 0.f;
        float mx = -1e30f, l = 0.f;
        const int total = n_past + n_new;
        for (int k0 = 0; k0 < total; k0 += 32) {
            __syncthreads();
#pragma unroll
            for (int i = 0; i < 4; ++i) {
                const int idx = t + 256 * i, key = idx >> 5, c4 = idx & 31, kg = k0 + key;
                float4 kv = make_float4(0.f, 0.f, 0.f, 0.f), vv = kv;
                if (kg < total) {
                    if (kg < n_past) { kv = *(const float4*)(pastK + (size_t)kg * 512 + c4 * 4); vv = *(const float4*)(pastV + (size_t)kg * 512 + c4 * 4); }
                    else { const size_t row = (size_t)(newrow0 + kg - n_past); kv = *(const float4*)(Z + row * 2048 + 1024 + h * 128 + c4 * 4); vv = *(const float4*)(Z + row * 2048 + 1536 + h * 128 + c4 * 4); }
                }
                *(float4*)(Ks + key * 128 + c4 * 4) = kv; *(float4*)(Vs + key * 128 + c4 * 4) = vv;
            }
            __syncthreads();
            const int nk = (total - k0) < 32 ? (total - k0) : 32;
            for (int kk = 0; kk < nk; ++kk) {
                const float* kr = Ks + kk * 128 + map * 64;
                float s = 0.f;
#pragma unroll
                for (int d = 0; d < 64; d += 4) { const float4 k4 = *(const float4*)(kr + d); s = fmaf(q[d], k4.x, s); s = fmaf(q[d + 1], k4.y, s); s = fmaf(q[d + 2], k4.z, s); s = fmaf(q[d + 3], k4.w, s); }
                if (s > mx) { const float cf = __expf(mx - s); l *= cf;
#pragma unroll
                    for (int d = 0; d < 64; ++d) o[d] *= cf;
                    mx = s; }
                const float p = __expf(s - mx); l += p;
                const float* vr = Vs + kk * 128 + half * 64;
#pragma unroll
                for (int d = 0; d < 64; d += 4) { const float4 v4 = *(const float4*)(vr + d); o[d] = fmaf(p, v4.x, o[d]); o[d + 1] = fmaf(p, v4.y, o[d + 1]); o[d + 2] = fmaf(p, v4.z, o[d + 2]); o[d + 3] = fmaf(p, v4.w, o[d + 3]); }
            }
        }
        __syncthreads();
        const float inv = 1.f / l;
        if (map == 1) {
#pragma unroll
            for (int d = 0; d < 64; ++d) sm[qi * 128 + half * 64 + d] = o[d] * inv;
        }
        __syncthreads();
        float ssq = 0.f;
        if (map == 0) {
#pragma unroll
            for (int d = 0; d < 64; ++d) { o[d] = o[d] * inv - lam * sm[qi * 128 + half * 64 + d]; ssq += o[d] * o[d]; }
        }
        __syncthreads();
        if (map == 0) sm[half * 64 + qi] = ssq;
        __syncthreads();
        if (map == 0 && act) {
            const float tot = sm[qi] + sm[64 + qi];
            const float sc = rsqrtf(tot * (1.f / 128.f) + NORM_EPS) * (1.f - li);
            float* op = CAT + (size_t)(qrow0 + qi) * D + 512 + h * 128 + half * 64;
            const float* gp = c.in[I_SUBG] + e * 128 + half * 64;
#pragma unroll
            for (int d = 0; d < 64; ++d) op[d] = o[d] * sc * gp[d];
        }
    }
}

DEVI void ph_shiftmix(const Ctx& c, int o, int bid, int nb) {
    const float* H = c.ws + W_H; float* XM = c.ws + W_XM; const float* mu = c.in[I_MU] + (size_t)o * 6 * D;
    const size_t total = (size_t)M * 256;
    for (size_t idx = (size_t)bid * 256 + threadIdx.x; idx < total; idx += (size_t)nb * 256) {
        const int row = (int)(idx >> 8), col = (int)(idx & 255) * 4;
        const bool prompt = row < MP;
        const int b = prompt ? row / TP : (row - MP) / TS, t = prompt ? row % TP : (row - MP) % TS;
        const float4 h = *(const float4*)(H + (size_t)row * D + col);
        float4 hp = make_float4(0.f, 0.f, 0.f, 0.f);
        if (t > 0) hp = *(const float4*)(H + (size_t)(row - 1) * D + col);
        else if (!prompt) hp = *(const float4*)(c.in[I_SSHIFT] + ((size_t)o * NBS + b) * D + col);
        const float4 xx = make_float4(hp.x - h.x, hp.y - h.y, hp.z - h.z, hp.w - h.w);
#pragma unroll
        for (int i = 0; i < 6; ++i) {
            const float4 m4 = *(const float4*)(mu + i * D + col);
            *(float4*)(XM + (size_t)i * U + (size_t)row * D + col) = make_float4(h.x + xx.x * m4.x, h.y + xx.y * m4.y, h.z + xx.z * m4.z, h.w + xx.w * m4.w);
        }
        if (prompt) { if (t == TP - 1) *(float4*)(c.out + O_PSHIFT + ((size_t)o * NBP + b) * D + col) = h; }
        else { if (t == TS - 1) *(float4*)(c.out + O_SSHIFT + ((size_t)o * NBS + b) * D + col) = h; }
    }
}
DEVI void ph_rw_act(const Ctx& c, int bid, int nb) {
    float* LW = c.ws + W_LW; float* LG = c.ws + W_LG;
    const size_t n1 = (size_t)M * 64, n2 = (size_t)M * 160;
    for (size_t i = (size_t)bid * 256 + threadIdx.x; i < n1 + n2; i += (size_t)nb * 256) {
        if (i < n1) LW[i] = tanhf(LW[i]); else LG[i - n1] = sigmoidf_(LG[i - n1]);
    }
}
DEVI void ph_rw_prep(const Ctx& c, int o, int bid, int nb) {
    float* R = c.ws + W_R; float* K = c.ws + W_K; float* V = c.ws + W_V; float* W = c.ws + W_W; float* A = c.ws + W_A; float* KKb = c.ws + W_KK; float* VF = c.ws + W_VF; const float* VG = c.ws + W_VG;
    (void)R;
    const int wave = threadIdx.x >> 6, lane = threadIdx.x & 63;
    const int items = M * 16;
    for (int it = bid * 4 + wave; it < items; it += nb * 4) {
        const int row = it >> 4, h = it & 15, col = h * 64 + lane; const size_t base = (size_t)row * D + col;
        const float wpre = c.in[I_W0][o * D + col] + W[base];
        const float x = -wpre; const float sp = x > 20.f ? x : log1pf(__expf(x));
        const float w = -sp - 0.5f; const float decay = __expf(-__expf(w));
        const float a = sigmoidf_(c.in[I_A0][o * D + col] + A[base]);
        float v = V[base];
        if (o == 0) VF[base] = v; else v = v + (VF[base] - v) * sigmoidf_(c.in[I_V0][(o - 1) * D + col] + VG[base]);
        const float k = K[base];
        float kk = k * c.in[I_KK][o * D + col];
        const float nrm = sqrtf(wave_sum(kk * kk));
        kk = kk / fmaxf(nrm, 1e-12f);
        const float k2 = k * (1.f + (a - 1.f) * c.in[I_KA][o * D + col]);
        W[base] = decay; A[base] = a; V[base] = v; KKb[base] = kk; K[base] = k2;
    }
}
DEVI void ph_rw_scan(const Ctx& c, int o, int bid, int nb, float* sm) {
    const float* R = c.ws + W_R; const float* K = c.ws + W_K; const float* V = c.ws + W_V; const float* W = c.ws + W_W; const float* A = c.ws + W_A; const float* KKb = c.ws + W_KK; float* Y = c.ws + W_Y;
    const int wave = threadIdx.x >> 6, lane = threadIdx.x & 63;
    float* sv = sm + wave * 5 * 64;
    for (int grp = bid; grp < 144; grp += nb) {
        const bool prompt = grp < 16;
        const int it = prompt ? grp * 4 + wave : (grp - 16) * 4 + wave;
        const int b = it >> 4, h = it & 15;
        const int T = prompt ? TP : TS, row0 = prompt ? b * TP : MP + b * TS;
        float S[64];
        if (prompt) {
#pragma unroll
            for (int k = 0; k < 64; ++k) S[k] = 0.f;
        } else {
            const float* sp = c.in[I_SWKV] + (((size_t)(o * NBS + b) * 16 + h) * 64 + lane) * 64;
#pragma unroll
            for (int k = 0; k < 64; k += 4) { const float4 v = *(const float4*)(sp + k); S[k] = v.x; S[k + 1] = v.y; S[k + 2] = v.z; S[k + 3] = v.w; }
        }
        size_t base = (size_t)row0 * D + h * 64 + lane;
        float nr = R[base], nd = W[base], nk = K[base], nkk = KKb[base], na = A[base], nv = V[base];
        for (int t = 0; t < T; ++t, base += D) {
            const float rj = nr, dj = nd, kj = nk, kkj = nkk, aj = na, vj = nv;
            if (t + 1 < T) { const size_t b2 = base + D; nr = R[b2]; nd = W[b2]; nk = K[b2]; nkk = KKb[b2]; na = A[b2]; nv = V[b2]; }
            __syncthreads();
            sv[lane] = rj; sv[64 + lane] = dj; sv[128 + lane] = kj; sv[192 + lane] = kkj; sv[256 + lane] = kkj * aj;
            __syncthreads();
            float sa = 0.f;
#pragma unroll
            for (int k = 0; k < 64; k += 4) { const float4 q = *(const float4*)(sv + 192 + k); sa = fmaf(S[k], q.x, sa); sa = fmaf(S[k + 1], q.y, sa); sa = fmaf(S[k + 2], q.z, sa); sa = fmaf(S[k + 3], q.w, sa); }
            sa = -sa;
            float y = 0.f;
#pragma unroll
            for (int k = 0; k < 64; k += 4) {
                const float4 d4 = *(const float4*)(sv + 64 + k), ab = *(const float4*)(sv + 256 + k), k4 = *(const float4*)(sv + 128 + k), r4 = *(const float4*)(sv + k);
                S[k] = fmaf(S[k], d4.x, fmaf(sa, ab.x, vj * k4.x)); y = fmaf(S[k], r4.x, y);
                S[k + 1] = fmaf(S[k + 1], d4.y, fmaf(sa, ab.y, vj * k4.y)); y = fmaf(S[k + 1], r4.y, y);
                S[k + 2] = fmaf(S[k + 2], d4.z, fmaf(sa, ab.z, vj * k4.z)); y = fmaf(S[k + 2], r4.z, y);
                S[k + 3] = fmaf(S[k + 3], d4.w, fmaf(sa, ab.w, vj * k4.w)); y = fmaf(S[k + 3], r4.w, y);
            }
            Y[base] = y;
        }
        float* op = c.out + (prompt ? O_PWKV + (((size_t)(o * NBP + b) * 16 + h) * 64 + lane) * 64 : O_SWKV + (((size_t)(o * NBS + b) * 16 + h) * 64 + lane) * 64);
#pragma unroll
        for (int k = 0; k < 64; k += 4) *(float4*)(op + k) = make_float4(S[k], S[k + 1], S[k + 2], S[k + 3]);
    }
}
DEVI void ph_rw_post(const Ctx& c, int o, int bid, int nb) {
    const float* R = c.ws + W_R; const float* K = c.ws + W_K; const float* V = c.ws + W_V; const float* G = c.ws + W_G; const float* Y = c.ws + W_Y; float* OUT = c.ws + W_XM;
    const int wave = threadIdx.x >> 6, lane = threadIdx.x & 63;
    const int items = M * 16;
    for (int it = bid * 4 + wave; it < items; it += nb * 4) {
        const int row = it >> 4, h = it & 15, col = h * 64 + lane; const size_t base = (size_t)row * D + col;
        const float y = Y[base];
        const float m = wave_sum(y) * (1.f / 64.f);
        const float dlt = y - m;
        const float var = wave_sum(dlt * dlt) * (1.f / 64.f);
        const float yn = dlt * rsqrtf(var + RW_LN_EPS) * c.in[I_LNG][o * D + col] + c.in[I_LNB][o * D + col];
        const float bon = wave_sum(R[base] * K[base] * c.in[I_RK][o * D + col]) * V[base];
        OUT[base] = (yn + bon) * G[base];
    }
}

DEVI void ph_softmax256(float* S, int bid, int nb) {
    const int wave = threadIdx.x >> 6, lane = threadIdx.x & 63;
    const int items = M * 4;
    for (int it = bid * 4 + wave; it < items; it += nb * 4) {
        float4* p = (float4*)(S + (size_t)it * 256) + lane;
        float4 v = *p; v.x *= 0.0625f; v.y *= 0.0625f; v.z *= 0.0625f; v.w *= 0.0625f;
        float mx = fmaxf(fmaxf(v.x, v.y), fmaxf(v.z, v.w));
#pragma unroll
        for (int o = 32; o > 0; o >>= 1) mx = fmaxf(mx, __shfl_xor(mx, o, 64));
        v.x = __expf(v.x - mx); v.y = __expf(v.y - mx); v.z = __expf(v.z - mx); v.w = __expf(v.w - mx);
        const float s = wave_sum(v.x + v.y + v.z + v.w), inv = 1.f / s;
        v.x *= inv; v.y *= inv; v.z *= inv; v.w *= inv; *p = v;
    }
}
DEVI void ph_swiglu_act(const Ctx& c, int bid, int nb) {
    float* Gt = c.ws + W_GATE; const float* Up = c.ws + W_UP;
    const size_t n = (size_t)M * DFF / 4;
    for (size_t i = (size_t)bid * 256 + threadIdx.x; i < n; i += (size_t)nb * 256) {
        float4 g = ((float4*)Gt)[i]; const float4 u = ((const float4*)Up)[i];
        g.x = g.x * sigmoidf_(g.x) * u.x; g.y = g.y * sigmoidf_(g.y) * u.y; g.z = g.z * sigmoidf_(g.z) * u.z; g.w = g.w * sigmoidf_(g.w) * u.w;
        ((float4*)Gt)[i] = g;
    }
}
DEVI void ph_copy_x(const Ctx& c, int bid, int nb) {
    float4* X = (float4*)(c.ws + W_X); const size_t np = (size_t)MP * D / 4, n = (size_t)M * D / 4;
    for (size_t i = (size_t)bid * 256 + threadIdx.x; i < n; i += (size_t)nb * 256) X[i] = i < np ? ((const float4*)c.in[I_XP])[i] : ((const float4*)c.in[I_XS])[i - np];
}

enum Phase { P_INIT = 0, P_MEMK, P_MEMV, P_RMS_MIX, P_EV_IN, P_EV_POOLPREP, P_EV_POOLGEMM, P_EV_ATTN, P_EV_OUT,
             P_RW_MIX, P_RW_R, P_RW_K, P_RW_V, P_RW_LW, P_RW_LA, P_RW_LG, P_RW_LV, P_RW_ACT, P_RW_W2, P_RW_A2, P_RW_G2, P_RW_V2, P_RW_PREP, P_RW_SCAN, P_RW_POST, P_RW_OUT,
             P_RMS_XA, P_XA_Q, P_XA_SP, P_XA_SS, P_XA_SOFTMAX, P_XA_OP, P_XA_OS, P_XA_OUT, P_RMS_FFN, P_FFN_G, P_FFN_U, P_FFN_ACT, P_FFN_DOWN, P_FINAL };

template <int PHS> DEVI void run_phase(const Ctx& c, int l, int bid, int nb, float* sm) {
    float* ws = c.ws; const int e = l >> 1, o = l >> 1;
    if constexpr (PHS == P_INIT) ph_copy_x(c, bid, nb);
    else if constexpr (PHS == P_MEMK || PHS == P_MEMV) {
        GemmD g = mk_gemm(c.in[I_MEMP], c.in[PHS == P_MEMK ? I_XWK : I_XWV], c.out + (PHS == P_MEMK ? O_PMK : O_PMV), NBP * NMEM, D, D, D, D, D, 0);
        g.nb1 = 4; g.sB1 = (long)D * D; g.sC1 = (long)NBP * NMEM * D; ph_gemm(g, bid, nb, sm);
    }
    else if constexpr (PHS == P_RMS_MIX) ph_rms(ws + W_X, c.in[I_NMIX] + l * D, ws + W_H, M, bid, nb);
    else if constexpr (PHS == P_EV_IN) { GemmD g = mk_gemm(ws + W_H, c.in[I_EWIN] + (size_t)e * D * 2048, ws + W_Z, M, 2048, D, D, 2048, 2048, 0); ph_gemm(g, bid, nb, sm); }
    else if constexpr (PHS == P_EV_POOLPREP) ph_pool_prep(c, e, bid, nb);
    else if constexpr (PHS == P_EV_POOLGEMM) {
        for (int gidx = 0; gidx < 4; ++gidx) {
            GemmD g = mk_gemm(ws + W_POOLED + gidx * 128, c.in[I_EPW] + ((size_t)e * 4 + gidx) * 128 * 128, ws + W_CAT + gidx * 128, M, 128, 128, PW, 128, D, 0);
            g.colscale = c.in[I_EPS] + e * PW + gidx * 128; ph_gemm(g, bid, nb, sm);
        }
    }
    else if constexpr (PHS == P_EV_ATTN) ph_diffattn(c, e, bid, nb, sm);
    else if constexpr (PHS == P_EV_OUT) { GemmD g = mk_gemm(ws + W_CAT, c.in[I_EWOUT] + (size_t)e * D * D, ws + W_X, M, D, D, D, D, D, 1); ph_gemm(g, bid, nb, sm); }
    else if constexpr (PHS == P_RW_MIX) ph_shiftmix(c, o, bid, nb);
    else if constexpr (PHS == P_RW_R) { GemmD g = mk_gemm(ws + W_XM + 0 * U, c.in[I_WR] + (size_t)o * D * D, ws + W_R, M, D, D, D, D, D, 0); ph_gemm(g, bid, nb, sm); }
    else if constexpr (PHS == P_RW_K) { GemmD g = mk_gemm(ws + W_XM + 2 * U, c.in[I_WK] + (size_t)o * D * D, ws + W_K, M, D, D, D, D, D, 0); ph_gemm(g, bid, nb, sm); }
    else if constexpr (PHS == P_RW_V) { GemmD g = mk_gemm(ws + W_XM + 3 * U, c.in[I_WV] + (size_t)o * D * D, ws + W_V, M, D, D, D, D, D, 0); ph_gemm(g, bid, nb, sm); }
    else if constexpr (PHS == P_RW_LW) { GemmD g = mk_gemm(ws + W_XM + 1 * U, c.in[I_W1] + (size_t)o * D * 64, ws + W_LW, M, 64, D, D, 64, 64, 0); ph_gemm(g, bid, nb, sm); }
    else if constexpr (PHS == P_RW_LA) { GemmD g = mk_gemm(ws + W_XM + 4 * U, c.in[I_A1] + (size_t)o * D * 64, ws + W_LA, M, 64, D, D, 64, 64, 0); ph_gemm(g, bid, nb, sm); }
    else if constexpr (PHS == P_RW_LG) { GemmD g = mk_gemm(ws + W_XM + 5 * U, c.in[I_G1] + (size_t)o * D * 160, ws + W_LG, M, 160, D, D, 160, 160, 0); ph_gemm(g, bid, nb, sm); }
    else if constexpr (PHS == P_RW_LV) { if (o > 0) { GemmD g = mk_gemm(ws + W_XM + 3 * U, c.in[I_V1] + (size_t)(o - 1) * D * 32, ws + W_LV, M, 32, D, D, 32, 32, 0); ph_gemm(g, bid, nb, sm); } }
    else if constexpr (PHS == P_RW_ACT) ph_rw_act(c, bid, nb);
    else if constexpr (PHS == P_RW_W2) { GemmD g = mk_gemm(ws + W_LW, c.in[I_W2] + (size_t)o * 64 * D, ws + W_W, M, D, 64, 64, D, D, 0); ph_gemm(g, bid, nb, sm); }
    else if constexpr (PHS == P_RW_A2) { GemmD g = mk_gemm(ws + W_LA, c.in[I_A2] + (size_t)o * 64 * D, ws + W_A, M, D, 64, 64, D, D, 0); ph_gemm(g, bid, nb, sm); }
    else if constexpr (PHS == P_RW_G2) { GemmD g = mk_gemm(ws + W_LG, c.in[I_G2] + (size_t)o * 160 * D, ws + W_G, M, D, 160, 160, D, D, 0); ph_gemm(g, bid, nb, sm); }
    else if constexpr (PHS == P_RW_V2) { if (o > 0) { GemmD g = mk_gemm(ws + W_LV, c.in[I_V2] + (size_t)(o - 1) * 32 * D, ws + W_VG, M, D, 32, 32, D, D, 0); ph_gemm(g, bid, nb, sm); } }
    else if constexpr (PHS == P_RW_PREP) ph_rw_prep(c, o, bid, nb);
    else if constexpr (PHS == P_RW_SCAN) ph_rw_scan(c, o, bid, nb, sm);
    else if constexpr (PHS == P_RW_POST) ph_rw_post(c, o, bid, nb);
    else if constexpr (PHS == P_RW_OUT) { GemmD g = mk_gemm(ws + W_XM, c.in[I_WO] + (size_t)o * D * D, ws + W_X, M, D, D, D, D, D, 1); ph_gemm(g, bid, nb, sm); }
    else if constexpr (PHS == P_RMS_XA) ph_rms(ws + W_X, c.in[I_NXA] + l * D, ws + W_H, M, bid, nb);
    else if constexpr (PHS == P_XA_Q) { GemmD g = mk_gemm(ws + W_H, c.in[I_XWQ] + (size_t)l * D * D, ws + W_Q, M, D, D, D, D, D, 0); ph_gemm(g, bid, nb, sm); }
    else if constexpr (PHS == P_XA_SP) {
        GemmD g = mk_gemm(ws + W_Q, c.out + O_PMK + (size_t)l * NBP * NMEM * D, ws + W_S, TP, NMEM, 256, D, D, D, 0);
        g.transB = 1; g.nb1 = NBP; g.nb2 = 4; g.sA1 = (long)TP * D; g.sA2 = 256; g.sB1 = (long)NMEM * D; g.sB2 = 256; g.sC1 = (long)TP * D; g.sC2 = 256; ph_gemm(g, bid, nb, sm);
    }
    else if constexpr (PHS == P_XA_SS) {
        GemmD g = mk_gemm(ws + W_Q + (size_t)MP * D, c.in[I_CMK] + (size_t)l * NBS * NMEM * D, ws + W_S + (size_t)MP * D, TS, NMEM, 256, D, D, D, 0);
        g.transB = 1; g.nb1 = NBS; g.nb2 = 4; g.sA1 = (long)TS * D; g.sA2 = 256; g.sB1 = (long)NMEM * D; g.sB2 = 256; g.sC1 = (long)TS * D; g.sC2 = 256; ph_gemm(g, bid, nb, sm);
    }
    else if constexpr (PHS == P_XA_SOFTMAX) ph_softmax256(ws + W_S, bid, nb);
    else if constexpr (PHS == P_XA_OP) {
        GemmD g = mk_gemm(ws + W_S, c.out + O_PMV + (size_t)l * NBP * NMEM * D, ws + W_O, TP, 256, NMEM, D, D, D, 0);
        g.nb1 = NBP; g.nb2 = 4; g.sA1 = (long)TP * D; g.sA2 = 256; g.sB1 = (long)NMEM * D; g.sB2 = 256; g.sC1 = (long)TP * D; g.sC2 = 256; ph_gemm(g, bid, nb, sm);
    }
    else if constexpr (PHS == P_XA_OS) {
        GemmD g = mk_gemm(ws + W_S + (size_t)MP * D, c.in[I_CMV] + (size_t)l * NBS * NMEM * D, ws + W_O + (size_t)MP * D, TS, 256, NMEM, D, D, D, 0);
        g.nb1 = NBS; g.nb2 = 4; g.sA1 = (long)TS * D; g.sA2 = 256; g.sB1 = (long)NMEM * D; g.sB2 = 256; g.sC1 = (long)TS * D; g.sC2 = 256; ph_gemm(g, bid, nb, sm);
    }
    else if constexpr (PHS == P_XA_OUT) { GemmD g = mk_gemm(ws + W_O, c.in[I_XWO] + (size_t)l * D * D, ws + W_X, M, D, D, D, D, D, 1); ph_gemm(g, bid, nb, sm); }
    else if constexpr (PHS == P_RMS_FFN) ph_rms(ws + W_X, c.in[I_NFFN] + l * D, ws + W_H, M, bid, nb);
    else if constexpr (PHS == P_FFN_G) { GemmD g = mk_gemm(ws + W_H, c.in[I_FWG] + (size_t)l * D * DFF, ws + W_GATE, M, DFF, D, D, DFF, DFF, 0); ph_gemm(g, bid, nb, sm); }
    else if constexpr (PHS == P_FFN_U) { GemmD g = mk_gemm(ws + W_H, c.in[I_FWU] + (size_t)l * D * DFF, ws + W_UP, M, DFF, D, D, DFF, DFF, 0); ph_gemm(g, bid, nb, sm); }
    else if constexpr (PHS == P_FFN_ACT) ph_swiglu_act(c, bid, nb);
    else if constexpr (PHS == P_FFN_DOWN) { GemmD g = mk_gemm(ws + W_GATE, c.in[I_FWD] + (size_t)l * DFF * D, ws + W_X, M, D, DFF, DFF, D, D, 1); ph_gemm(g, bid, nb, sm); }
    else if constexpr (PHS == P_FINAL) ph_rms(ws + W_X, c.in[I_NFIN], c.out + O_YP, M, bid, nb);
}

constexpr int SMEM_FLOATS = 2 * 32 * 128;
template <int PHS> __global__ void __launch_bounds__(256) k_phase(Ctx c, int l) {
    __shared__ float sm[SMEM_FLOATS];
    run_phase<PHS>(c, l, blockIdx.x, gridDim.x, sm);
}
}

template <int PHS> static void launch(const Ctx& c, int l, hipStream_t s, int grid = 1024) { hipLaunchKernelGGL(k_phase<PHS>, dim3(grid), dim3(256), 0, s, c, l); }

extern "C" void kernel_launch(void* const* d_in, const int* in_sizes, int n_in, void* d_out, int out_size, void* d_ws, size_t ws_size, hipStream_t stream) {
    if (n_in != N_IN || (size_t)out_size != O_END || ws_size < W_END * sizeof(float)) return;
    Ctx c; for (int i = 0; i < N_IN; ++i) c.in[i] = (const float*)d_in[i];
    c.out = (float*)d_out; c.ws = (float*)d_ws;
    launch<P_INIT>(c, 0, stream); launch<P_MEMK>(c, 0, stream); launch<P_MEMV>(c, 0, stream);
    for (int l = 0; l < 4; ++l) {
        launch<P_RMS_MIX>(c, l, stream);
        if ((l & 1) == 0) {
            launch<P_EV_IN>(c, l, stream); launch<P_EV_POOLPREP>(c, l, stream); launch<P_EV_POOLGEMM>(c, l, stream); launch<P_EV_ATTN>(c, l, stream, 1152); launch<P_EV_OUT>(c, l, stream);
        } else {
            launch<P_RW_MIX>(c, l, stream); launch<P_RW_R>(c, l, stream); launch<P_RW_K>(c, l, stream); launch<P_RW_V>(c, l, stream);
            launch<P_RW_LW>(c, l, stream); launch<P_RW_LA>(c, l, stream); launch<P_RW_LG>(c, l, stream); if (l > 1) launch<P_RW_LV>(c, l, stream);
            launch<P_RW_ACT>(c, l, stream); launch<P_RW_W2>(c, l, stream); launch<P_RW_A2>(c, l, stream); launch<P_RW_G2>(c, l, stream); if (l > 1) launch<P_RW_V2>(c, l, stream);
            launch<P_RW_PREP>(c, l, stream); launch<P_RW_SCAN>(c, l, stream, 144); launch<P_RW_POST>(c, l, stream); launch<P_RW_OUT>(c, l, stream);
        }
        launch<P_RMS_XA>(c, l, stream); launch<P_XA_Q>(c, l, stream); launch<P_XA_SP>(c, l, stream); launch<P_XA_SS>(c, l, stream); launch<P_XA_SOFTMAX>(c, l, stream);
        launch<P_XA_OP>(c, l, stream); launch<P_XA_OS>(c, l, stream); launch<P_XA_OUT>(c, l, stream);
        launch<P_RMS_FFN>(c, l, stream); launch<P_FFN_G>(c, l, stream); launch<P_FFN_U>(c, l, stream); launch<P_FFN_ACT>(c, l, stream); launch<P_FFN_DOWN>(c, l, stream);
    }
    launch<P_FINAL>(c, 0, stream);
}
```

```cpp
#include <hip/hip_runtime.h>
#include <stdint.h>

#define DEVI __device__ __forceinline__

namespace {
constexpr int D = 1024, NBP = 4, TP = 4096, NBS = 32, TS = 16, PAST = 4096;
constexpr int MP = NBP * TP, MS = NBS * TS, M = MP + MS;
constexpr int PW = 512, PHIST = 15;
constexpr int NMEM = 256;
constexpr int DFF = 2816;
constexpr float NORM_EPS = 1e-6f, RW_LN_EPS = 64e-5f;

constexpr size_t O_YP = 0;
constexpr size_t O_YS = O_YP + (size_t)MP * D;
constexpr size_t O_PDK = O_YS + (size_t)MS * D;
constexpr size_t O_PDV = O_PDK + (size_t)2 * MP * 512;
constexpr size_t O_PPOOL = O_PDV + (size_t)2 * MP * 512;
constexpr size_t O_PSHIFT = O_PPOOL + (size_t)2 * NBP * PHIST * PW;
constexpr size_t O_PWKV = O_PSHIFT + (size_t)2 * NBP * D;
constexpr size_t O_PMK = O_PWKV + (size_t)2 * NBP * 16 * 4096;
constexpr size_t O_PMV = O_PMK + (size_t)4 * NBP * NMEM * D;
constexpr size_t O_SDK = O_PMV + (size_t)4 * NBP * NMEM * D;
constexpr size_t O_SDV = O_SDK + (size_t)2 * MS * 512;
constexpr size_t O_SPOOL = O_SDV + (size_t)2 * MS * 512;
constexpr size_t O_SSHIFT = O_SPOOL + (size_t)2 * NBS * PHIST * PW;
constexpr size_t O_SWKV = O_SSHIFT + (size_t)2 * NBS * D;
constexpr size_t O_END = O_SWKV + (size_t)2 * NBS * 16 * 4096;

enum { I_XP = 0, I_XS, I_CDK, I_CDV, I_SPOOL, I_SSHIFT, I_SWKV, I_CMK, I_CMV, I_MEMP, I_NMIX, I_NXA, I_NFFN, I_NFIN,
       I_EWIN, I_EPW, I_EPS, I_LQ1, I_LK1, I_LQ2, I_LK2, I_SUBG, I_EWOUT, I_MU, I_WR, I_WK, I_WV, I_WO, I_W0, I_W1, I_W2,
       I_A0, I_A1, I_A2, I_V0, I_V1, I_V2, I_G1, I_G2, I_KK, I_KA, I_RK, I_LNG, I_LNB, I_XWQ, I_XWK, I_XWV, I_XWO,
       I_FWG, I_FWU, I_FWD, N_IN };

constexpr size_t U = (size_t)M * D;
constexpr size_t W_CTL = 0;
constexpr size_t W_X = 65536;
constexpr size_t W_H = W_X + U;
constexpr size_t W_Z = W_H + U;
constexpr size_t W_XM = W_Z + 2 * U;
constexpr size_t W_R = W_XM + 6 * U;
constexpr size_t W_K = W_R + U;
constexpr size_t W_V = W_K + U;
constexpr size_t W_W = W_V + U;
constexpr size_t W_A = W_W + U;
constexpr size_t W_G = W_A + U;
constexpr size_t W_KK = W_G + U;
constexpr size_t W_VF = W_KK + U;
constexpr size_t W_Y = W_VF + U;
constexpr size_t W_LORA = W_Y + U;
constexpr size_t W_VG = W_LORA + U;
constexpr size_t W_END = W_VG + U;
constexpr size_t W_LW = W_LORA, W_LA = W_LW + (size_t)M * 64, W_LG = W_LA + (size_t)M * 64, W_LV = W_LG + (size_t)M * 160;
constexpr size_t W_CAT = W_XM, W_POOLED = W_XM + U, W_Q = W_XM + 2 * U, W_S = W_XM + 3 * U, W_O = W_XM + 4 * U;
constexpr size_t W_GATE = W_XM, W_UP = W_XM + 3 * U;

struct Ctx { const float* in[N_IN]; float* out; float* ws; };

DEVI float wave_sum(float v) {
#pragma unroll
    for (int o = 32; o > 0; o >>= 1) v += __shfl_xor(v, o, 64);
    return v;
}
DEVI float sigmoidf_(float x) { return 1.f / (1.f + __expf(-x)); }

DEVI void ph_rms(const float* __restrict__ X, const float* __restrict__ g, float* __restrict__ H, int rows, int bid, int nb) {
    const int wave = threadIdx.x >> 6, lane = threadIdx.x & 63;
    for (int r = bid * 4 + wave; r < rows; r += nb * 4) {
        const float4* xr = (const float4*)(X + (size_t)r * D);
        float4 v[4]; float ss = 0.f;
#pragma unroll
        for (int i = 0; i < 4; ++i) { v[i] = xr[lane + 64 * i]; ss += v[i].x * v[i].x + v[i].y * v[i].y + v[i].z * v[i].z + v[i].w * v[i].w; }
        ss = wave_sum(ss);
        const float s = rsqrtf(ss * (1.f / D) + NORM_EPS);
        float4* hr = (float4*)(H + (size_t)r * D);
#pragma unroll
        for (int i = 0; i < 4; ++i) { const float4 g4 = ((const float4*)g)[lane + 64 * i]; float4 o; o.x = v[i].x * s * g4.x; o.y = v[i].y * s * g4.y; o.z = v[i].z * s * g4.z; o.w = v[i].w * s * g4.w; hr[lane + 64 * i] = o; }
    }
}

struct GemmD {
    const float* A; const float* B; float* C; int M, N, K, lda, ldb, ldc; int transB; int accum; const float* colscale;
    int nb1, nb2; long sA1, sA2, sB1, sB2, sC1, sC2;
};
DEVI GemmD mk_gemm(const float* A, const float* B, float* C, int M_, int N_, int K_, int lda, int ldb, int ldc, int accum) {
    GemmD g; g.A = A; g.B = B; g.C = C; g.M = M_; g.N = N_; g.K = K_; g.lda = lda; g.ldb = ldb; g.ldc = ldc; g.transB = 0; g.accum = accum; g.colscale = nullptr;
    g.nb1 = 1; g.nb2 = 1; g.sA1 = g.sA2 = g.sB1 = g.sB2 = g.sC1 = g.sC2 = 0; return g;
}
DEVI void ph_gemm(const GemmD& g, int bid, int nb, float* sm) {
    float (*As)[68] = (float (*)[68])sm;
    float (*Bs)[68] = (float (*)[68])(sm + 16 * 68);
    const int t = threadIdx.x, ty = t >> 4, tx = t & 15;
    const int tm = (g.M + 63) >> 6, tn = (g.N + 63) >> 6, per = tm * tn, items = per * g.nb1 * g.nb2;
    for (int it = bid; it < items; it += nb) {
        const int bz = it / per, tt = it % per, z1 = bz / g.nb2, z2 = bz % g.nb2;
        const int m0 = (tt / tn) << 6, n0 = (tt % tn) << 6;
        const float* A = g.A + z1 * g.sA1 + z2 * g.sA2;
        const float* B = g.B + z1 * g.sB1 + z2 * g.sB2;
        float* C = g.C + z1 * g.sC1 + z2 * g.sC2;
        float acc[4][4];
#pragma unroll
        for (int i = 0; i < 4; ++i)
#pragma unroll
            for (int j = 0; j < 4; ++j) acc[i][j] = 0.f;
        for (int k0 = 0; k0 < g.K; k0 += 16) {
            __syncthreads();
            {
                const int row = t >> 2, kq = (t & 3) * 4;
                float4 a = make_float4(0.f, 0.f, 0.f, 0.f);
                if (m0 + row < g.M) a = *(const float4*)(A + (size_t)(m0 + row) * g.lda + k0 + kq);
                As[kq + 0][row] = a.x; As[kq + 1][row] = a.y; As[kq + 2][row] = a.z; As[kq + 3][row] = a.w;
            }
            if (!g.transB) {
                const int k = t >> 4, nq = (t & 15) * 4;
                float4 b = make_float4(0.f, 0.f, 0.f, 0.f);
                if (n0 + nq < g.N) b = *(const float4*)(B + (size_t)(k0 + k) * g.ldb + n0 + nq);
                *(float4*)&Bs[k][nq] = b;
            } else {
                const int n = t >> 2, kq = (t & 3) * 4;
                float4 b = make_float4(0.f, 0.f, 0.f, 0.f);
                if (n0 + n < g.N) b = *(const float4*)(B + (size_t)(n0 + n) * g.ldb + k0 + kq);
                Bs[kq + 0][n] = b.x; Bs[kq + 1][n] = b.y; Bs[kq + 2][n] = b.z; Bs[kq + 3][n] = b.w;
            }
            __syncthreads();
#pragma unroll
            for (int k = 0; k < 16; ++k) {
                const float4 a4 = *(const float4*)&As[k][ty * 4];
                const float4 b4 = *(const float4*)&Bs[k][tx * 4];
                const float a[4] = {a4.x, a4.y, a4.z, a4.w}, b[4] = {b4.x, b4.y, b4.z, b4.w};
#pragma unroll
                for (int i = 0; i < 4; ++i)
#pragma unroll
                    for (int j = 0; j < 4; ++j) acc[i][j] = fmaf(a[i], b[j], acc[i][j]);
            }
        }
        const int col = n0 + tx * 4;
        if (col < g.N) {
            float4 cs = make_float4(1.f, 1.f, 1.f, 1.f);
            if (g.colscale) cs = *(const float4*)(g.colscale + (col - 0));
#pragma unroll
            for (int i = 0; i < 4; ++i) {
                const int row = m0 + ty * 4 + i;
                if (row < g.M) {
                    float4* cp = (float4*)(C + (size_t)row * g.ldc + col);
                    float4 o = make_float4(acc[i][0] * cs.x, acc[i][1] * cs.y, acc[i][2] * cs.z, acc[i][3] * cs.w);
                    if (g.accum) { const float4 p = *cp; o.x += p.x; o.y += p.y; o.z += p.z; o.w += p.w; }
                    *cp = o;
                }
            }
        }
    }
}

DEVI float lam_init_of(int layer) { return 0.8f - 0.6f * __expf(-0.3f * (float)layer); }
DEVI float lam_of(const Ctx& c, int e) {
    float s1 = 0.f, s2 = 0.f;
    for (int i = 0; i < 64; ++i) { s1 += c.in[I_LQ1][e * 64 + i] * c.in[I_LK1][e * 64 + i]; s2 += c.in[I_LQ2][e * 64 + i] * c.in[I_LK2][e * 64 + i]; }
    return __expf(s1) - __expf(s2) + lam_init_of(2 * e);
}

DEVI void ph_pool_prep(const Ctx& c, int e, int bid, int nb) {
    const float* Z = c.ws + W_Z; float* P = c.ws + W_POOLED;
    const size_t total = (size_t)M * 128;
    for (size_t idx = (size_t)bid * 256 + threadIdx.x; idx < total; idx += (size_t)nb * 256) {
        const int row = (int)(idx >> 7), c4 = (int)(idx & 127), col = c4 * 4;
        const int grp = col >> 7, w = 2 << grp;
        const bool prompt = row < MP;
        const int b = prompt ? row / TP : (row - MP) / TS, t = prompt ? row % TP : (row - MP) % TS;
        const float4 u = *(const float4*)(Z + (size_t)row * 2048 + col);
        float4 s = make_float4(0.f, 0.f, 0.f, 0.f);
        for (int i = 0; i < w; ++i) {
            const int tt = t - i;
            float4 v = make_float4(0.f, 0.f, 0.f, 0.f);
            if (tt >= 0) v = *(const float4*)(Z + (size_t)(row - i) * 2048 + col);
            else if (!prompt) v = *(const float4*)(c.in[I_SPOOL] + ((size_t)(e * NBS + b) * PHIST + (PHIST + tt)) * PW + col);
            s.x += v.x; s.y += v.y; s.z += v.z; s.w += v.w;
        }
        const float cnt = prompt ? (float)((t + 1) < w ? (t + 1) : w) : (float)w;
        const float ic = 1.f / cnt;
        float4 o = make_float4(s.x * ic - u.x, s.y * ic - u.y, s.z * ic - u.z, s.w * ic - u.w);
        *(float4*)(P + (size_t)row * PW + col) = o;
        if (prompt) { if (t >= TP - PHIST) *(float4*)(c.out + O_PPOOL + ((size_t)(e * NBP + b) * PHIST + (t - (TP - PHIST))) * PW + col) = u; }
        else { if (t >= 1) *(float4*)(c.out + O_SPOOL + ((size_t)(e * NBS + b) * PHIST + (t - 1)) * PW + col) = u; }
        const float4 kn = *(const float4*)(Z + (size_t)row * 2048 + 1024 + col);
        const float4 vn = *(const float4*)(Z + (size_t)row * 2048 + 1536 + col);
        if (prompt) { *(float4*)(c.out + O_PDK + ((size_t)e * MP + row) * 512 + col) = kn; *(float4*)(c.out + O_PDV + ((size_t)e * MP + row) * 512 + col) = vn; }
        else { *(float4*)(c.out + O_SDK + ((size_t)e * MS + (row - MP)) * 512 + col) = kn; *(float4*)(c.out + O_SDV + ((size_t)e * MS + (row - MP)) * 512 + col) = vn; }
    }
}

DEVI void ph_diffattn(const Ctx& c, int e, int bid, int nb, float* sm) {
    const float* Z = c.ws + W_Z; float* CAT = c.ws + W_CAT;
    const int t = threadIdx.x, qi = t & 63, map = (t >> 6) & 1, half = t >> 7;
    float* Ks = sm; float* Vs = sm + 32 * 128;
    const float lam = lam_of(c, e), li = lam_init_of(2 * e);
    for (int item = bid; item < 1152; item += nb) {
        int b, h, nq, qrow0, n_past, n_new, newrow0; const float* pastK = nullptr; const float* pastV = nullptr;
        if (item < 1024) { b = item >> 8; h = (item >> 6) & 3; const int ch = item & 63; nq = 64; qrow0 = b * TP + ch * 64; n_past = 0; n_new = (ch + 1) * 64; newrow0 = b * TP; }
        else { const int it = item - 1024; b = it >> 2; h = it & 3; nq = TS; qrow0 = MP + b * TS; n_past = PAST; n_new = TS; newrow0 = MP + b * TS;
               pastK = c.in[I_CDK] + ((size_t)(e * NBS + b) * PAST) * 512 + h * 128; pastV = c.in[I_CDV] + ((size_t)(e * NBS + b) * PAST) * 512 + h * 128; }
        const bool act = qi < nq;
        float q[64], o[64];
        {
            const float* qp = Z + (size_t)(qrow0 + (act ? qi : 0)) * 2048 + 512 + h * 128 + map * 64;
#pragma unroll
            for (int d = 0; d < 64; d += 4) { const float4 v = *(const float4*)(qp + d); q[d] = v.x * 0.125f; q[d + 1] = v.y * 0.125f; q[d + 2] = v.z * 0.125f; q[d + 3] = v.w * 0.125f; }
        }
#pragma unroll
        for (int d = 0; d < 64; ++d) o[d] = 0.f;
        float mx = -1e30f, l = 0.f;
        const int total = n_past + n_new;
        for (int k0 = 0; k0 < total; k0 += 32) {
            __syncthreads();
#pragma unroll
            for (int i = 0; i < 4; ++i) {
                const int idx = t + 256 * i, key = idx >> 5, c4 = idx & 31, kg = k0 + key;
                float4 kv = make_float4(0.f, 0.f, 0.f, 0.f), vv = kv;
                if (kg < total) {
                    if (kg < n_past) { kv = *(const float4*)(pastK + (size_t)kg * 512 + c4 * 4); vv = *(const float4*)(pastV + (size_t)kg * 512 + c4 * 4); }
                    else { const size_t row = (size_t)(newrow0 + kg - n_past); kv = *(const float4*)(Z + row * 2048 + 1024 + h * 128 + c4 * 4); vv = *(const float4*)(Z + row * 2048 + 1536 + h * 128 + c4 * 4); }
                }
                *(float4*)(Ks + key * 128 + c4 * 4) = kv; *(float4*)(Vs + key * 128 + c4 * 4) = vv;
            }
            __syncthreads();
            const int nk = (total - k0) < 32 ? (total - k0) : 32;
            for (int kk = 0; kk < nk; ++kk) {
                const float* kr = Ks + kk * 128 + map * 64;
                float s = 0.f;
#pragma unroll
                for (int d = 0; d < 64; d += 4) { const float4 k4 = *(const float4*)(kr + d); s = fmaf(q[d], k4.x, s); s = fmaf(q[d + 1], k4.y, s); s = fmaf(q[d + 2], k4.z, s); s = fmaf(q[d + 3], k4.w, s); }
                if (s > mx) { const float cf = __expf(mx - s); l *= cf;
#pragma unroll
                    for (int d = 0; d < 64; ++d) o[d] *= cf;
                    mx = s; }
                const float p = __expf(s - mx); l += p;
                const float* vr = Vs + kk * 128 + half * 64;
#pragma unroll
                for (int d = 0; d < 64; d += 4) { const float4 v4 = *(const float4*)(vr + d); o[d] = fmaf(p, v4.x, o[d]); o[d + 1] = fmaf(p, v4.y, o[d + 1]); o[d + 2] = fmaf(p, v4.z, o[d + 2]); o[d + 3] = fmaf(p, v4.w, o[d + 3]); }
            }
        }
        __syncthreads();
        const float inv = 1.f / l;
        if (map == 1) {
#pragma unroll
            for (int d = 0; d < 64; ++d) sm[qi * 128 + half * 64 + d] = o[d] * inv;
        }
        __syncthreads();
        float ssq = 0.f;
        if (map == 0) {
#pragma unroll
            for (int d = 0; d < 64; ++d) { o[d] = o[d] * inv - lam * sm[qi * 128 + half * 64 + d]; ssq += o[d] * o[d]; }
        }
        __syncthreads();
        if (map == 0) sm[half * 64 + qi] = ssq;
        __syncthreads();
        if (map == 0 && act) {
            const float tot = sm[qi] + sm[64 + qi];
            const float sc = rsqrtf(tot * (1.f / 128.f) + NORM_EPS) * (1.f - li);
            float* op = CAT + (size_t)(qrow0 + qi) * D + 512 + h * 128 + half * 64;
            const float* gp = c.in[I_SUBG] + e * 128 + half * 64;
#pragma unroll
            for (int d = 0; d < 64; ++d) op[d] = o[d] * sc * gp[d];
        }
    }
}

DEVI void ph_shiftmix(const Ctx& c, int o, int bid, int nb) {
    const float* H = c.ws + W_H; float* XM = c.ws + W_XM; const float* mu = c.in[I_MU] + (size_t)o * 6 * D;
    const size_t total = (size_t)M * 256;
    for (size_t idx = (size_t)bid * 256 + threadIdx.x; idx < total; idx += (size_t)nb * 256) {
        const int row = (int)(idx >> 8), col = (int)(idx & 255) * 4;
        const bool prompt = row < MP;
        const int b = prompt ? row / TP : (row - MP) / TS, t = prompt ? row % TP : (row - MP) % TS;
        const float4 h = *(const float4*)(H + (size_t)row * D + col);
        float4 hp = make_float4(0.f, 0.f, 0.f, 0.f);
        if (t > 0) hp = *(const float4*)(H + (size_t)(row - 1) * D + col);
        else if (!prompt) hp = *(const float4*)(c.in[I_SSHIFT] + ((size_t)o * NBS + b) * D + col);
        const float4 xx = make_float4(hp.x - h.x, hp.y - h.y, hp.z - h.z, hp.w - h.w);
#pragma unroll
        for (int i = 0; i < 6; ++i) {
            const float4 m4 = *(const float4*)(mu + i * D + col);
            *(float4*)(XM + (size_t)i * U + (size_t)row * D + col) = make_float4(h.x + xx.x * m4.x, h.y + xx.y * m4.y, h.z + xx.z * m4.z, h.w + xx.w * m4.w);
        }
        if (prompt) { if (t == TP - 1) *(float4*)(c.out + O_PSHIFT + ((size_t)o * NBP + b) * D + col) = h; }
        else { if (t == TS - 1) *(float4*)(c.out + O_SSHIFT + ((size_t)o * NBS + b) * D + col) = h; }
    }
}
DEVI void ph_rw_act(const Ctx& c, int bid, int nb) {
    float* LW = c.ws + W_LW; float* LG = c.ws + W_LG;
    const size_t n1 = (size_t)M * 64, n2 = (size_t)M * 160;
    for (size_t i = (size_t)bid * 256 + threadIdx.x; i < n1 + n2; i += (size_t)nb * 256) {
        if (i < n1) LW[i] = tanhf(LW[i]); else LG[i - n1] = sigmoidf_(LG[i - n1]);
    }
}
DEVI void ph_rw_prep(const Ctx& c, int o, int bid, int nb) {
    float* R = c.ws + W_R; float* K = c.ws + W_K; float* V = c.ws + W_V; float* W = c.ws + W_W; float* A = c.ws + W_A; float* KKb = c.ws + W_KK; float* VF = c.ws + W_VF; const float* VG = c.ws + W_VG;
    (void)R;
    const int wave = threadIdx.x >> 6, lane = threadIdx.x & 63;
    const int items = M * 16;
    for (int it = bid * 4 + wave; it < items; it += nb * 4) {
        const int row = it >> 4, h = it & 15, col = h * 64 + lane; const size_t base = (size_t)row * D + col;
        const float wpre = c.in[I_W0][o * D + col] + W[base];
        const float x = -wpre; const float sp = x > 20.f ? x : log1pf(__expf(x));
        const float w = -sp - 0.5f; const float decay = __expf(-__expf(w));
        const float a = sigmoidf_(c.in[I_A0][o * D + col] + A[base]);
        float v = V[base];
        if (o == 0) VF[base] = v; else v = v + (VF[base] - v) * sigmoidf_(c.in[I_V0][(o - 1) * D + col] + VG[base]);
        const float k = K[base];
        float kk = k * c.in[I_KK][o * D + col];
        const float nrm = sqrtf(wave_sum(kk * kk));
        kk = kk / fmaxf(nrm, 1e-12f);
        const float k2 = k * (1.f + (a - 1.f) * c.in[I_KA][o * D + col]);
        W[base] = decay; A[base] = a; V[base] = v; KKb[base] = kk; K[base] = k2;
    }
}
DEVI void ph_rw_scan(const Ctx& c, int o, int bid, int nb, float* sm) {
    const float* R = c.ws + W_R; const float* K = c.ws + W_K; const float* V = c.ws + W_V; const float* W = c.ws + W_W; const float* A = c.ws + W_A; const float* KKb = c.ws + W_KK; float* Y = c.ws + W_Y;
    const int wave = threadIdx.x >> 6, lane = threadIdx.x & 63;
    float* sv = sm + wave * 5 * 64;
    for (int grp = bid; grp < 144; grp += nb) {
        const bool prompt = grp < 16;
        const int it = prompt ? grp * 4 + wave : (grp - 16) * 4 + wave;
        const int b = it >> 4, h = it & 15;
        const int T = prompt ? TP : TS, row0 = prompt ? b * TP : MP + b * TS;
        float S[64];
        if (prompt) {
#pragma unroll
            for (int k = 0; k < 64; ++k) S[k] = 0.f;
        } else {
            const float* sp = c.in[I_SWKV] + (((size_t)(o * NBS + b) * 16 + h) * 64 + lane) * 64;
#pragma unroll
            for (int k = 0; k < 64; k += 4) { const float4 v = *(const float4*)(sp + k); S[k] = v.x; S[k + 1] = v.y; S[k + 2] = v.z; S[k + 3] = v.w; }
        }
        size_t base = (size_t)row0 * D + h * 64 + lane;
        float nr = R[base], nd = W[base], nk = K[base], nkk = KKb[base], na = A[base], nv = V[base];
        for (int t = 0; t < T; ++t, base += D) {
            const float rj = nr, dj = nd, kj = nk, kkj = nkk, aj = na, vj = nv;
            if (t + 1 < T) { const size_t b2 = base + D; nr = R[b2]; nd = W[b2]; nk = K[b2]; nkk = KKb[b2]; na = A[b2]; nv = V[b2]; }
            __syncthreads();
            sv[lane] = rj; sv[64 + lane] = dj; sv[128 + lane] = kj; sv[192 + lane] = kkj; sv[256 + lane] = kkj * aj;
            __syncthreads();
            float sa = 0.f;
#pragma unroll
            for (int k = 0; k < 64; k += 4) { const float4 q = *(const float4*)(sv + 192 + k); sa = fmaf(S[k], q.x, sa); sa = fmaf(S[k + 1], q.y, sa); sa = fmaf(S[k + 2], q.z, sa); sa = fmaf(S[k + 3], q.w, sa); }
            sa = -sa;
            float y = 0.f;
#pragma unroll
            for (int k = 0; k < 64; k += 4) {
                const float4 d4 = *(const float4*)(sv + 64 + k), ab = *(const float4*)(sv + 256 + k), k4 = *(const float4*)(sv + 128 + k), r4 = *(const float4*)(sv + k);
                S[k] = fmaf(S[k], d4.x, fmaf(sa, ab.x, vj * k4.x)); y = fmaf(S[k], r4.x, y);
                S[k + 1] = fmaf(S[k + 1], d4.y, fmaf(sa, ab.y, vj * k4.y)); y = fmaf(S[k + 1], r4.y, y);
                S[k + 2] = fmaf(S[k + 2], d4.z, fmaf(sa, ab.z, vj * k4.z)); y = fmaf(S[k + 2], r4.z, y);
                S[k + 3] = fmaf(S[k + 3], d4.w, fmaf(sa, ab.w, vj * k4.w)); y = fmaf(S[k + 3], r4.w, y);
            }
            Y[base] = y;
        }
        float* op = c.out + (prompt ? O_PWKV + (((size_t)(o * NBP + b) * 16 + h) * 64 + lane) * 64 : O_SWKV + (((size_t)(o * NBS + b) * 16 + h) * 64 + lane) * 64);
#pragma unroll
        for (int k = 0; k < 64; k += 4) *(float4*)(op + k) = make_float4(S[k], S[k + 1], S[k + 2], S[k + 3]);
    }
}
DEVI void ph_rw_post(const Ctx& c, int o, int bid, int nb) {
    const float* R = c.ws + W_R; const float* K = c.ws + W_K; const float* V = c.ws + W_V; const float* G = c.ws + W_G; const float* Y = c.ws + W_Y; float* OUT = c.ws + W_XM;
    const int wave = threadIdx.x >> 6, lane = threadIdx.x & 63;
    const int items = M * 16;
    for (int it = bid * 4 + wave; it < items; it += nb * 4) {
        const int row = it >> 4, h = it & 15, col = h * 64 + lane; const size_t base = (size_t)row * D + col;
        const float y = Y[base];
        const float m = wave_sum(y) * (1.f / 64.f);
        const float dlt = y - m;
        const float var = wave_sum(dlt * dlt) * (1.f / 64.f);
        const float yn = dlt * rsqrtf(var + RW_LN_EPS) * c.in[I_LNG][o * D + col] + c.in[I_LNB][o * D + col];
        const float bon = wave_sum(R[base] * K[base] * c.in[I_RK][o * D + col]) * V[base];
        OUT[base] = (yn + bon) * G[base];
    }
}

DEVI void ph_softmax256(float* S, int bid, int nb) {
    const int wave = threadIdx.x >> 6, lane = threadIdx.x & 63;
    const int items = M * 4;
    for (int it = bid * 4 + wave; it < items; it += nb * 4) {
        float4* p = (float4*)(S + (size_t)it * 256) + lane;
        float4 v = *p; v.x *= 0.0625f; v.y *= 0.0625f; v.z *= 0.0625f; v.w *= 0.0625f;
        float mx = fmaxf(fmaxf(v.x, v.y), fmaxf(v.z, v.w));
#pragma unroll
        for (int o = 32; o > 0; o >>= 1) mx = fmaxf(mx, __shfl_xor(mx, o, 64));
        v.x = __expf(v.x - mx); v.y = __expf(v.y - mx); v.z = __expf(v.z - mx); v.w = __expf(v.w - mx);
        const float s = wave_sum(v.x + v.y + v.z + v.w), inv = 1.f / s;
        v.x *= inv; v.y *= inv; v.z *= inv; v.w *= inv; *p = v;
    }
}
DEVI void ph_swiglu_act(const Ctx& c, int bid, int nb) {
    float* Gt = c.ws + W_GATE; const float* Up = c.ws + W_UP;
    const size_t n = (size_t)M * DFF / 4;
    for (size_t i = (size_t)bid * 256 + threadIdx.x; i < n; i += (size_t)nb * 256) {
        float4 g = ((float4*)Gt)[i]; const float4 u = ((const float4*)Up)[i];
        g.x = g.x * sigmoidf_(g.x) * u.x; g.y = g.y * sigmoidf_(g.y) * u.y; g.z = g.z * sigmoidf_(g.z) * u.z; g.w = g.w * sigmoidf_(g.w) * u.w;
        ((float4*)Gt)[i] = g;
    }
}
DEVI void ph_copy_x(const Ctx& c, int bid, int nb) {
    float4* X = (float4*)(c.ws + W_X); const size_t np = (size_t)MP * D / 4, n = (size_t)M * D / 4;
    for (size_t i = (size_t)bid * 256 + threadIdx.x; i < n; i += (size_t)nb * 256) X[i] = i < np ? ((const float4*)c.in[I_XP])[i] : ((const float4*)c.in[I_XS])[i - np];
}

enum Phase { P_INIT = 0, P_MEMK, P_MEMV, P_RMS_MIX, P_EV_IN, P_EV_POOLPREP, P_EV_POOLGEMM, P_EV_ATTN, P_EV_OUT,
             P_RW_MIX, P_RW_R, P_RW_K, P_RW_V, P_RW_LW, P_RW_LA, P_RW_LG, P_RW_LV, P_RW_ACT, P_RW_W2, P_RW_A2, P_RW_G2, P_RW_V2, P_RW_PREP, P_RW_SCAN, P_RW_POST, P_RW_OUT,
             P_RMS_XA, P_XA_Q, P_XA_SP, P_XA_SS, P_XA_SOFTMAX, P_XA_OP, P_XA_OS, P_XA_OUT, P_RMS_FFN, P_FFN_G, P_FFN_U, P_FFN_ACT, P_FFN_DOWN, P_FINAL };

template <int PHS> DEVI void run_phase(const Ctx& c, int l, int bid, int nb, float* sm) {
    float* ws = c.ws; const int e = l >> 1, o = l >> 1;
    if constexpr (PHS == P_INIT) ph_copy_x(c, bid, nb);
    else if constexpr (PHS == P_MEMK || PHS == P_MEMV) {
        GemmD g = mk_gemm(c.in[I_MEMP], c.in[PHS == P_MEMK ? I_XWK : I_XWV], c.out + (PHS == P_MEMK ? O_PMK : O_PMV), NBP * NMEM, D, D, D, D, D, 0);
        g.nb1 = 4; g.sB1 = (long)D * D; g.sC1 = (long)NBP * NMEM * D; ph_gemm(g, bid, nb, sm);
    }
    else if constexpr (PHS == P_RMS_MIX) ph_rms(ws + W_X, c.in[I_NMIX] + l * D, ws + W_H, M, bid, nb);
    else if constexpr (PHS == P_EV_IN) { GemmD g = mk_gemm(ws + W_H, c.in[I_EWIN] + (size_t)e * D * 2048, ws + W_Z, M, 2048, D, D, 2048, 2048, 0); ph_gemm(g, bid, nb, sm); }
    else if constexpr (PHS == P_EV_POOLPREP) ph_pool_prep(c, e, bid, nb);
    else if constexpr (PHS == P_EV_POOLGEMM) {
        for (int gidx = 0; gidx < 4; ++gidx) {
            GemmD g = mk_gemm(ws + W_POOLED + gidx * 128, c.in[I_EPW] + ((size_t)e * 4 + gidx) * 128 * 128, ws + W_CAT + gidx * 128, M, 128, 128, PW, 128, D, 0);
            g.colscale = c.in[I_EPS] + e * PW + gidx * 128; ph_gemm(g, bid, nb, sm);
        }
    }
    else if constexpr (PHS == P_EV_ATTN) ph_diffattn(c, e, bid, nb, sm);
    else if constexpr (PHS == P_EV_OUT) { GemmD g = mk_gemm(ws + W_CAT, c.in[I_EWOUT] + (size_t)e * D * D, ws + W_X, M, D, D, D, D, D, 1); ph_gemm(g, bid, nb, sm); }
    else if constexpr (PHS == P_RW_MIX) ph_shiftmix(c, o, bid, nb);
    else if constexpr (PHS == P_RW_R) { GemmD g = mk_gemm(ws + W_XM + 0 * U, c.in[I_WR] + (size_t)o * D * D, ws + W_R, M, D, D, D, D, D, 0); ph_gemm(g, bid, nb, sm); }
    else if constexpr (PHS == P_RW_K) { GemmD g = mk_gemm(ws + W_XM + 2 * U, c.in[I_WK] + (size_t)o * D * D, ws + W_K, M, D, D, D, D, D, 0); ph_gemm(g, bid, nb, sm); }
    else if constexpr (PHS == P_RW_V) { GemmD g = mk_gemm(ws + W_XM + 3 * U, c.in[I_WV] + (size_t)o * D * D, ws + W_V, M, D, D, D, D, D, 0); ph_gemm(g, bid, nb, sm); }
    else if constexpr (PHS == P_RW_LW) { GemmD g = mk_gemm(ws + W_XM + 1 * U, c.in[I_W1] + (size_t)o * D * 64, ws + W_LW, M, 64, D, D, 64, 64, 0); ph_gemm(g, bid, nb, sm); }
    else if constexpr (PHS == P_RW_LA) { GemmD g = mk_gemm(ws + W_XM + 4 * U, c.in[I_A1] + (size_t)o * D * 64, ws + W_LA, M, 64, D, D, 64, 64, 0); ph_gemm(g, bid, nb, sm); }
    else if constexpr (PHS == P_RW_LG) { GemmD g = mk_gemm(ws + W_XM + 5 * U, c.in[I_G1] + (size_t)o * D * 160, ws + W_LG, M, 160, D, D, 160, 160, 0); ph_gemm(g, bid, nb, sm); }
    else if constexpr (PHS == P_RW_LV) { if (o > 0) { GemmD g = mk_gemm(ws + W_XM + 3 * U, c.in[I_V1] + (size_t)(o - 1) * D * 32, ws + W_LV, M, 32, D, D, 32, 32, 0); ph_gemm(g, bid, nb, sm); } }
    else if constexpr (PHS == P_RW_ACT) ph_rw_act(c, bid, nb);
    else if constexpr (PHS == P_RW_W2) { GemmD g = mk_gemm(ws + W_LW, c.in[I_W2] + (size_t)o * 64 * D, ws + W_W, M, D, 64, 64, D, D, 0); ph_gemm(g, bid, nb, sm); }
    else if constexpr (PHS == P_RW_A2) { GemmD g = mk_gemm(ws + W_LA, c.in[I_A2] + (size_t)o * 64 * D, ws + W_A, M, D, 64, 64, D, D, 0); ph_gemm(g, bid, nb, sm); }
    else if constexpr (PHS == P_RW_G2) { GemmD g = mk_gemm(ws + W_LG, c.in[I_G2] + (size_t)o * 160 * D, ws + W_G, M, D, 160, 160, D, D, 0); ph_gemm(g, bid, nb, sm); }
    else if constexpr (PHS == P_RW_V2) { if (o > 0) { GemmD g = mk_gemm(ws + W_LV, c.in[I_V2] + (size_t)(o - 1) * 32 * D, ws + W_VG, M, D, 32, 32, D, D, 0); ph_gemm(g, bid, nb, sm); } }
    else if constexpr (PHS == P_RW_PREP) ph_rw_prep(c, o, bid, nb);
    else if constexpr (PHS == P_RW_SCAN) ph_rw_scan(c, o, bid, nb, sm);
    else if constexpr (PHS == P_RW_POST) ph_rw_post(c, o, bid, nb);
    else if constexpr (PHS == P_RW_OUT) { GemmD g = mk_gemm(ws + W_XM, c.in[I_WO] + (size_t)o * D * D, ws + W_X, M, D, D, D, D, D, 1); ph_gemm(g, bid, nb, sm); }
    else if constexpr (PHS == P_RMS_XA) ph_rms(ws + W_X, c.in[I_NXA] + l * D, ws + W_H, M, bid, nb);
    else if constexpr (PHS == P_XA_Q) { GemmD g = mk_gemm(ws + W_H, c.in[I_XWQ] + (size_t)l * D * D, ws + W_Q, M, D, D, D, D, D, 0); ph_gemm(g, bid, nb, sm); }
    else if constexpr (PHS == P_XA_SP) {
        GemmD g = mk_gemm(ws + W_Q, c.out + O_PMK + (size_t)l * NBP * NMEM * D, ws + W_S, TP, NMEM, 256, D, D, D, 0);
        g.transB = 1; g.nb1 = NBP; g.nb2 = 4; g.sA1 = (long)TP * D; g.sA2 = 256; g.sB1 = (long)NMEM * D; g.sB2 = 256; g.sC1 = (long)TP * D; g.sC2 = 256; ph_gemm(g, bid, nb, sm);
    }
    else if constexpr (PHS == P_XA_SS) {
        GemmD g = mk_gemm(ws + W_Q + (size_t)MP * D, c.in[I_CMK] + (size_t)l * NBS * NMEM * D, ws + W_S + (size_t)MP * D, TS, NMEM, 256, D, D, D, 0);
        g.transB = 1; g.nb1 = NBS; g.nb2 = 4; g.sA1 = (long)TS * D; g.sA2 = 256; g.sB1 = (long)NMEM * D; g.sB2 = 256; g.sC1 = (long)TS * D; g.sC2 = 256; ph_gemm(g, bid, nb, sm);
    }
    else if constexpr (PHS == P_XA_SOFTMAX) ph_softmax256(ws + W_S, bid, nb);
    else if constexpr (PHS == P_XA_OP) {
        GemmD g = mk_gemm(ws + W_S, c.out + O_PMV + (size_t)l * NBP * NMEM * D, ws + W_O, TP, 256, NMEM, D, D, D, 0);
        g.nb1 = NBP; g.nb2 = 4; g.sA1 = (long)TP * D; g.sA2 = 256; g.sB1 = (long)NMEM * D; g.sB2 = 256; g.sC1 = (long)TP * D; g.sC2 = 256; ph_gemm(g, bid, nb, sm);
    }
    else if constexpr (PHS == P_XA_OS) {
        GemmD g = mk_gemm(ws + W_S + (size_t)MP * D, c.in[I_CMV] + (size_t)l * NBS * NMEM * D, ws + W_O + (size_t)MP * D, TS, 256, NMEM, D, D, D, 0);
        g.nb1 = NBS; g.nb2 = 4; g.sA1 = (long)TS * D; g.sA2 = 256; g.sB1 = (long)NMEM * D; g.sB2 = 256; g.sC1 = (long)TS * D; g.sC2 = 256; ph_gemm(g, bid, nb, sm);
    }
    else if constexpr (PHS == P_XA_OUT) { GemmD g = mk_gemm(ws + W_O, c.in[I_XWO] + (size_t)l * D * D, ws + W_X, M, D, D, D, D, D, 1); ph_gemm(g, bid, nb, sm); }
    else if constexpr (PHS == P_RMS_FFN) ph_rms(ws + W_X, c.in[I_NFFN] + l * D, ws + W_H, M, bid, nb);
    else if constexpr (PHS == P_FFN_G) { GemmD g = mk_gemm(ws + W_H, c.in[I_FWG] + (size_t)l * D * DFF, ws + W_GATE, M, DFF, D, D, DFF, DFF, 0); ph_gemm(g, bid, nb, sm); }
    else if constexpr (PHS == P_FFN_U) { GemmD g = mk_gemm(ws + W_H, c.in[I_FWU] + (size_t)l * D * DFF, ws + W_UP, M, DFF, D, D, DFF, DFF, 0); ph_gemm(g, bid, nb, sm); }
    else if constexpr (PHS == P_FFN_ACT) ph_swiglu_act(c, bid, nb);
    else if constexpr (PHS == P_FFN_DOWN) { GemmD g = mk_gemm(ws + W_GATE, c.in[I_FWD] + (size_t)l * DFF * D, ws + W_X, M, D, DFF, DFF, D, D, 1); ph_gemm(g, bid, nb, sm); }
    else if constexpr (PHS == P_FINAL) ph_rms(ws + W_X, c.in[I_NFIN], c.out + O_YP, M, bid, nb);
}

constexpr int SMEM_FLOATS = 2 * 32 * 128;
template <int PHS> __global__ void __launch_bounds__(256) k_phase(Ctx c, int l) {
    __shared__ float sm[SMEM_FLOATS];
    run_phase<PHS>(c, l, blockIdx.x, gridDim.x, sm);
}

#define XB_TMO      128
#define XB_XCNT(j)  (256  + 64 * (j))
#define XB_XSUB(j)  (1280 + 64 * (j))
#define XB_XGEN(j)  (2304 + 64 * (j))
#define XB_TOP      3328
#define XB_TOPGEN   3392
#define XCD_BAR_WORDS 3456
#define XB_SPIN_CAP (1u << 22)
#define LAS __attribute__((address_space(3)))
DEVI unsigned xb_ld(unsigned* p)              { return __hip_atomic_load(p, __ATOMIC_RELAXED, __HIP_MEMORY_SCOPE_AGENT); }
DEVI unsigned xb_add(unsigned* p, unsigned v) { return __hip_atomic_fetch_add(p, v, __ATOMIC_RELAXED, __HIP_MEMORY_SCOPE_AGENT); }
DEVI unsigned xb_xcc_id() { return (unsigned)__builtin_amdgcn_s_getreg((3 << 11) | 20) & 0xFu; }
#define XB_SPIN(cond, bar) do { unsigned _sp = 0; while (cond) { __builtin_amdgcn_s_sleep(1); \
    if ((++_sp & 255u) == 0u) { if (xb_ld(&(bar)[XB_TMO])) break; if (_sp > XB_SPIN_CAP) { atomicAdd(&(bar)[XB_TMO], 1u); break; } } } } while (0)
struct XcdBarrier { unsigned* bar; unsigned x; volatile LAS unsigned* st; };
DEVI XcdBarrier xcd_barrier_post(unsigned* bar, volatile LAS unsigned* st) {
    XcdBarrier b; b.bar = bar; b.x = xb_xcc_id(); b.st = st;
    if (threadIdx.x == 0) (void)xb_add(&bar[XB_XCNT(b.x)], 1u);
    return b;
}
DEVI void xcd_barrier_complete(unsigned* bar, unsigned x, unsigned& nloc, unsigned& nx) {
    const unsigned G = gridDim.x * gridDim.y * gridDim.z;
    unsigned sum, cnt, mine, sp = 0u;
    for (;;) {
        sum = 0u; cnt = 0u; mine = 0u;
#pragma unroll
        for (unsigned j = 0; j < 16; ++j) { const unsigned c = xb_ld(&bar[XB_XCNT(j)]); sum += c; cnt += (c > 0u) ? 1u : 0u; mine = (j == x) ? c : mine; }
        if (sum == G) break;
        __builtin_amdgcn_s_sleep(1);
        if ((++sp & 255u) == 0u) { if (xb_ld(&bar[XB_TMO])) break; if (sp > XB_SPIN_CAP) { atomicAdd(&bar[XB_TMO], 1u); break; } }
    }
    nloc = mine > 0u ? mine : 1u; nx = cnt > 0u ? cnt : 1u;
}
DEVI void xcd_barrier(const XcdBarrier& b) {
    asm volatile("s_waitcnt vmcnt(0)" ::: "memory");
    __syncthreads();
    if (threadIdx.x == 0) {
        unsigned* bar = b.bar;
        __builtin_amdgcn_s_waitcnt(0);
        unsigned nloc = b.st[0], nx = b.st[1];
        if (nloc == 0u) { xcd_barrier_complete(bar, b.x, nloc, nx); b.st[0] = nloc; b.st[1] = nx; }
        const unsigned old = xb_add(&bar[XB_XSUB(b.x)], 1u);
        const unsigned gen = old / nloc;
        if (old + 1u == (gen + 1u) * nloc) {
            __builtin_amdgcn_fence(__ATOMIC_RELEASE, "agent");
            asm volatile("s_waitcnt vmcnt(0)" ::: "memory");
            const unsigned og = xb_add(&bar[XB_TOP], 1u);
            const unsigned tg = og / nx;
            if (og + 1u == (tg + 1u) * nx) xb_add(&bar[XB_TOPGEN], 1u);
            else XB_SPIN(xb_ld(&bar[XB_TOPGEN]) == tg, bar);
            __builtin_amdgcn_fence(__ATOMIC_ACQUIRE, "agent");
            xb_add(&bar[XB_XGEN(b.x)], 1u);
            asm volatile("s_waitcnt vmcnt(0)" ::: "memory");
        } else {
            XB_SPIN(xb_ld(&bar[XB_XGEN(b.x)]) == gen, bar);
            __builtin_amdgcn_fence(__ATOMIC_ACQUIRE, "agent");
            asm volatile("s_waitcnt vmcnt(0)" ::: "memory");
        }
    }
    __syncthreads();
}

#define RUN(PH_, l_) run_phase<PH_>(c, (l_), bid, nb, sm)
#define BAR() xcd_barrier(xb)
__global__ void __launch_bounds__(256, 1) mega_fwd(Ctx c) {
    __shared__ float sm[SMEM_FLOATS];
    __shared__ uint4 xb_words;
    if (threadIdx.x == 0) xb_words = make_uint4(0u, 0u, 0u, 0u);
    __syncthreads();
    XcdBarrier xb = xcd_barrier_post((unsigned*)c.ws, (volatile LAS unsigned*)&xb_words);
    const int bid = blockIdx.x, nb = gridDim.x;
    RUN(P_INIT, 0); RUN(P_MEMK, 0); RUN(P_MEMV, 0); BAR();
    for (int l = 0; l < 4; ++l) {
        RUN(P_RMS_MIX, l); BAR();
        if ((l & 1) == 0) {
            RUN(P_EV_IN, l); BAR();
            RUN(P_EV_POOLPREP, l); BAR();
            RUN(P_EV_POOLGEMM, l); RUN(P_EV_ATTN, l); BAR();
            RUN(P_EV_OUT, l); BAR();
        } else {
            RUN(P_RW_MIX, l); BAR();
            RUN(P_RW_R, l); RUN(P_RW_K, l); RUN(P_RW_V, l); RUN(P_RW_LW, l); RUN(P_RW_LA, l); RUN(P_RW_LG, l); RUN(P_RW_LV, l); BAR();
            RUN(P_RW_ACT, l); BAR();
            RUN(P_RW_W2, l); RUN(P_RW_A2, l); RUN(P_RW_G2, l); RUN(P_RW_V2, l); BAR();
            RUN(P_RW_PREP, l); BAR();
            RUN(P_RW_SCAN, l); BAR();
            RUN(P_RW_POST, l); BAR();
            RUN(P_RW_OUT, l); BAR();
        }
        RUN(P_RMS_XA, l); BAR();
        RUN(P_XA_Q, l); BAR();
        RUN(P_XA_SP, l); RUN(P_XA_SS, l); BAR();
        RUN(P_XA_SOFTMAX, l); BAR();
        RUN(P_XA_OP, l); RUN(P_XA_OS, l); BAR();
        RUN(P_XA_OUT, l); BAR();
        RUN(P_RMS_FFN, l); BAR();
        RUN(P_FFN_G, l); RUN(P_FFN_U, l); BAR();
        RUN(P_FFN_ACT, l); BAR();
        RUN(P_FFN_DOWN, l); BAR();
    }
    RUN(P_FINAL, 0);
}
}

extern "C" void kernel_launch(void* const* d_in, const int* in_sizes, int n_in, void* d_out, int out_size, void* d_ws, size_t ws_size, hipStream_t stream) {
    if (n_in != N_IN || (size_t)out_size != O_END || ws_size < W_END * sizeof(float)) return;
    Ctx c; for (int i = 0; i < N_IN; ++i) c.in[i] = (const float*)d_in[i];
    c.out = (float*)d_out; c.ws = (float*)d_ws;
    static int grid = 0;
    if (!grid) {
        int dev = 0, cus = 0, per_cu = 0;
        hipGetDevice(&dev);
        hipDeviceGetAttribute(&cus, hipDeviceAttributeMultiprocessorCount, dev);
        hipOccupancyMaxActiveBlocksPerMultiprocessor(&per_cu, mega_fwd, 256, 0);
        if (per_cu > 1) per_cu = 1;
        if (per_cu < 1) per_cu = 1;
        grid = cus * per_cu;
    }
    hipMemsetAsync(d_ws, 0, XCD_BAR_WORDS * sizeof(unsigned), stream);
    hipLaunchKernelGGL(mega_fwd, dim3(grid), dim3(256), 0, stream, c);
}
```

```cpp
#include <hip/hip_runtime.h>
#include <stdint.h>

#define DEVI __device__ __forceinline__
#define LAS __attribute__((address_space(3)))

namespace {
typedef unsigned short bf16_t;
typedef short bf16x8 __attribute__((ext_vector_type(8)));
typedef float f32x4 __attribute__((ext_vector_type(4)));
typedef unsigned u32x4 __attribute__((ext_vector_type(4)));
typedef unsigned u32x2 __attribute__((ext_vector_type(2)));

constexpr int D = 1024, NBP = 4, TP = 4096, NBS = 32, TS = 16, PAST = 4096;
constexpr int MP = NBP * TP, MS = NBS * TS, M = MP + MS;
constexpr int PW = 512, PHIST = 15;
constexpr int NMEM = 256;
constexpr int DFF = 2816;
constexpr float NORM_EPS = 1e-6f, RW_LN_EPS = 64e-5f;
constexpr int NT = 512;

constexpr size_t O_YP = 0;
constexpr size_t O_YS = O_YP + (size_t)MP * D;
constexpr size_t O_PDK = O_YS + (size_t)MS * D;
constexpr size_t O_PDV = O_PDK + (size_t)2 * MP * 512;
constexpr size_t O_PPOOL = O_PDV + (size_t)2 * MP * 512;
constexpr size_t O_PSHIFT = O_PPOOL + (size_t)2 * NBP * PHIST * PW;
constexpr size_t O_PWKV = O_PSHIFT + (size_t)2 * NBP * D;
constexpr size_t O_PMK = O_PWKV + (size_t)2 * NBP * 16 * 4096;
constexpr size_t O_PMV = O_PMK + (size_t)4 * NBP * NMEM * D;
constexpr size_t O_SDK = O_PMV + (size_t)4 * NBP * NMEM * D;
constexpr size_t O_SDV = O_SDK + (size_t)2 * MS * 512;
constexpr size_t O_SPOOL = O_SDV + (size_t)2 * MS * 512;
constexpr size_t O_SSHIFT = O_SPOOL + (size_t)2 * NBS * PHIST * PW;
constexpr size_t O_SWKV = O_SSHIFT + (size_t)2 * NBS * D;
constexpr size_t O_END = O_SWKV + (size_t)2 * NBS * 16 * 4096;

enum { I_XP = 0, I_XS, I_CDK, I_CDV, I_SPOOL, I_SSHIFT, I_SWKV, I_CMK, I_CMV, I_MEMP, I_NMIX, I_NXA, I_NFFN, I_NFIN,
       I_EWIN, I_EPW, I_EPS, I_LQ1, I_LK1, I_LQ2, I_LK2, I_SUBG, I_EWOUT, I_MU, I_WR, I_WK, I_WV, I_WO, I_W0, I_W1, I_W2,
       I_A0, I_A1, I_A2, I_V0, I_V1, I_V2, I_G1, I_G2, I_KK, I_KA, I_RK, I_LNG, I_LNB, I_XWQ, I_XWK, I_XWV, I_XWO,
       I_FWG, I_FWU, I_FWD, N_IN };

constexpr size_t MiB = 1u << 20;
constexpr size_t B_CTL = 0;
constexpr size_t B_ROWSS = 65536;
constexpr size_t CTL_BYTES = 2 * MiB;
constexpr size_t UB2 = (size_t)M * D * 2, UB4 = (size_t)M * D * 4;
constexpr size_t B_WIN = CTL_BYTES;
constexpr size_t B_WOUT = B_WIN + (size_t)2 * 2048 * 1024 * 2;
constexpr size_t B_WR = B_WOUT + (size_t)2 * 1024 * 1024 * 2;
constexpr size_t B_WK = B_WR + (size_t)2 * 1024 * 1024 * 2;
constexpr size_t B_WV = B_WK + (size_t)2 * 1024 * 1024 * 2;
constexpr size_t B_WO = B_WV + (size_t)2 * 1024 * 1024 * 2;
constexpr size_t B_L1 = B_WO + (size_t)2 * 1024 * 1024 * 2;
constexpr size_t B_L2W = B_L1 + (size_t)2 * 4 * 256 * 1024 * 2;
constexpr size_t B_L2A = B_L2W + (size_t)2 * 1024 * 128 * 2;
constexpr size_t B_L2G = B_L2A + (size_t)2 * 1024 * 128 * 2;
constexpr size_t B_L2V = B_L2G + (size_t)2 * 1024 * 256 * 2;
constexpr size_t B_XWQ = B_L2V + (size_t)2 * 1024 * 128 * 2;
constexpr size_t B_XWK = B_XWQ + (size_t)4 * 1024 * 1024 * 2;
constexpr size_t B_XWV = B_XWK + (size_t)4 * 1024 * 1024 * 2;
constexpr size_t B_XWO = B_XWV + (size_t)4 * 1024 * 1024 * 2;
constexpr size_t B_FGU = B_XWO + (size_t)4 * 1024 * 1024 * 2;
constexpr size_t B_FWD = B_FGU + (size_t)4 * 5632 * 1024 * 2;
constexpr size_t B_MEMB = B_FWD + (size_t)4 * 1024 * 2816 * 2;
constexpr size_t B_PMKB = B_MEMB + (size_t)1024 * 1024 * 2;
constexpr size_t B_PMVT = B_PMKB + (size_t)4 * 1024 * 1024 * 2;
constexpr size_t B_X = ((B_PMVT + (size_t)4 * 1024 * 1024 * 2 + 255) / 256) * 256;
constexpr size_t B_XB = B_X + UB4;
constexpr size_t B_S0 = B_XB + UB2;
constexpr size_t B_U = B_S0;
constexpr size_t B_QB = B_U + (size_t)M * 512 * 4;
constexpr size_t B_KB = B_QB + (size_t)M * 512 * 2;
constexpr size_t B_VB = B_KB + (size_t)M * 512 * 2;
constexpr size_t B_CAT = B_VB + (size_t)M * 512 * 2;
constexpr size_t B_XM = B_S0;
constexpr size_t B_R = B_XM + 6 * UB2;
constexpr size_t B_K = B_R + UB4;
constexpr size_t B_V = B_K + UB4;
constexpr size_t B_W = B_V + UB4;
constexpr size_t B_A = B_W + UB4;
constexpr size_t B_G = B_A + UB4;
constexpr size_t B_VG = B_G + UB4;
constexpr size_t B_KK = B_VG + UB4;
constexpr size_t B_Y = B_KK + UB4;
constexpr size_t B_LW = B_Y + UB4;
constexpr size_t B_LA = B_LW + (size_t)M * 128 * 2;
constexpr size_t B_LG = B_LA + (size_t)M * 128 * 2;
constexpr size_t B_LV = B_LG + (size_t)M * 256 * 2;
constexpr size_t B_YG = B_LV + (size_t)M * 128 * 2;
constexpr size_t B_ODD_END = B_YG + UB2;
constexpr size_t B_Q = B_S0;
constexpr size_t B_S = B_Q + UB2;
constexpr size_t B_P = B_S + UB4;
constexpr size_t B_O = B_P + UB2;
constexpr size_t B_HG = B_S0;
constexpr size_t B_VF = B_ODD_END;
constexpr size_t B_END = B_VF + UB4;

struct Ctx { const float* in[N_IN]; float* out; unsigned char* ws; };

template <int OFF> DEVI const void* karg_ptr() {
    unsigned long long p;
    asm volatile("s_load_dwordx2 %0, %1, %2\n\ts_waitcnt lgkmcnt(0)" : "=s"(p) : "s"(__builtin_amdgcn_kernarg_segment_ptr()), "n"(OFF) : "memory");
    return (const void*)(const __attribute__((address_space(1))) void*)p;
}
#define CIN(I) ((const float*)karg_ptr<(I) * 8>())
#define COUT ((float*)karg_ptr<N_IN * 8>())
#define CWS ((unsigned char*)karg_ptr<(N_IN + 1) * 8>())
DEVI float wave_sum(float v) {
#pragma unroll
    for (int o = 32; o > 0; o >>= 1) v += __shfl_xor(v, o, 64);
    return v;
}
DEVI int tid_opaque() { int t = threadIdx.x; asm volatile("" : "+v"(t)); return t; }
DEVI int opaque_s(int v) { asm volatile("" : "+s"(v)); return v; }
DEVI float sigmoidf_(float x) { return 1.f / (1.f + __expf(-x)); }
DEVI unsigned cvt_pk_bf16(float lo, float hi) { unsigned r; asm volatile("v_cvt_pk_bf16_f32 %0, %1, %2" : "=v"(r) : "v"(lo), "v"(hi)); return r; }
DEVI float bf2f(unsigned short b) { return __uint_as_float((unsigned)b << 16); }
DEVI float bflo(unsigned w) { return __uint_as_float(w << 16); }
DEVI float bfhi(unsigned w) { return __uint_as_float(w & 0xffff0000u); }
DEVI u32x4 pack8(const f32x4& a, const f32x4& b) { u32x4 w; w.x = cvt_pk_bf16(a[0], a[1]); w.y = cvt_pk_bf16(a[2], a[3]); w.z = cvt_pk_bf16(b[0], b[1]); w.w = cvt_pk_bf16(b[2], b[3]); return w; }

namespace pg8 {
constexpr int BM = 256, BK = 64, HALF = 128, HTB = HALF * BK * 2, STAGE_BYTES = 8 * HTB, NXCD = 8, WGM = 8;
__host__ __device__ __forceinline__ int lds_byte(int r, int c) { const int st = (r >> 4) * 2 + (c >> 5), rr = r & 15, cc = c & 31, ob = rr * 64 + cc * 2; return st * 1024 + (ob ^ (((ob >> 9) & 1) << 5)); }
__host__ __device__ __forceinline__ void stage_rc(int b, int& R, int& C) { const int st = b / 1024, sb = b % 1024, swz = sb ^ (((sb >> 9) & 1) << 5); R = (st >> 1) * 16 + swz / 64; C = (st & 1) * 32 + (swz % 64) / 2; }
__host__ __device__ __forceinline__ int perm32(int rho) { const int n = rho >> 4, i = rho & 15; return 8 * (i >> 2) + 4 * n + (i & 3); }

struct Unit { int pm, pn, z; };

template <int LDA, int LDB, bool BATCH> struct Order {
    int nM, nN, nz, per, G, c; unsigned aZ1, aZ2, bZ1, bZ2;
    DEVI void init(int nM_, int nN_, int G_, int c_) { nM = nM_; nN = nN_; nz = 1; per = nM * nN; G = G_; c = c_; aZ1 = aZ2 = bZ1 = bZ2 = 0; }
    DEVI bool next(int i, Unit& u) const {
        const int L = i * G + c; if (L >= per * nz) return false;
        int wgid = L % per; u.z = L / per;
        if (!BATCH) { const int q = per / NXCD, r = per % NXCD, xcd = wgid % NXCD, off = wgid / NXCD; wgid = (xcd < r ? xcd * (q + 1) : r * (q + 1) + (xcd - r) * q) + off; }
        const int nig = WGM * nN, gid = wgid / nig, fm = gid * WGM, gsz = (nM - fm) < WGM ? (nM - fm) : WGM;
        u.pm = fm + ((wgid % nig) % gsz); u.pn = (wgid % nig) / gsz; return true;
    }
    DEVI unsigned a_off(const Unit& u) const { return (BATCH ? (unsigned)(u.z >> 2) * aZ1 + (unsigned)(u.z & 3) * aZ2 : 0u) + (unsigned)u.pm * (256u * LDA * 2u); }
    DEVI unsigned b_off(const Unit& u) const { return (BATCH ? (unsigned)(u.z >> 2) * bZ1 + (unsigned)(u.z & 3) * bZ2 : 0u) + (unsigned)u.pn * (256u * LDB * 2u); }
};

template <int LDA, int LDB, int KDIM, bool BATCH, class Epi>
DEVI void gemm_phase(LAS unsigned char* lds, const bf16_t* Ag, const bf16_t* Bg, const Order<LDA, LDB, BATCH>& S, const Epi& E) {
    const int tid = tid_opaque(), wid = __builtin_amdgcn_readfirstlane(tid >> 6), lane = tid & 63, wr = wid >> 2, wc = wid & 3, fr = lane & 15, fq = lane >> 4;
    const int nt = opaque_s(KDIM / BK);
    unsigned voffA[2], voffB[2];
#pragma unroll
    for (int i = 0; i < 2; ++i) { int R, C; stage_rc(tid * 16 + i * 8192, R, C); const int Rb = (R & ~31) + perm32(R & 31);
        voffA[i] = (unsigned)(R * LDA + C) * 2u; voffB[i] = (unsigned)(Rb * LDB + C) * 2u; }
    constexpr unsigned kstep = BK * 2, hstepA = HALF * LDA * 2, hstepB = HALF * LDB * 2;
    const unsigned ldsw = (unsigned)wid * 1024u;
    const int aoff = lds_byte(wr * 64 + fr, fq * 8), boff = lds_byte(wc * 32 + fr, fq * 8);
#define PG8_SA(b, h) (((b) * 2 + (h)) * HTB)
#define PG8_SB(b, h) ((4 + (b) * 2 + (h)) * HTB)
#define PG8_STAGE(bufoff, gbase, voff) do { _Pragma("unroll") for (int _i = 0; _i < 2; ++_i) \
        __builtin_amdgcn_global_load_lds((const __attribute__((address_space(1))) unsigned*)((const __attribute__((address_space(1))) char*)(gbase) + (voff)[_i]), (LAS unsigned*)(lds + (bufoff) + ldsw + _i * 8192), 16, 0, 0); } while (0)
#define PG8_LDA(dst, b, h) do { _Pragma("unroll") for (int m = 0; m < 4; ++m) _Pragma("unroll") for (int k = 0; k < 2; ++k) dst[m][k] = *(const LAS bf16x8*)(lds + PG8_SA(b, h) + aoff + m * 2048 + k * 1024); } while (0)
#define PG8_LDB(dst, b, h) do { _Pragma("unroll") for (int n = 0; n < 2; ++n) _Pragma("unroll") for (int k = 0; k < 2; ++k) dst[n][k] = *(const LAS bf16x8*)(lds + PG8_SB(b, h) + boff + n * 2048 + k * 1024); } while (0)
#define PG8_MMA(ai, bj, At, Bt) do { __builtin_amdgcn_s_setprio(1); _Pragma("unroll") for (int m = 0; m < 4; ++m) _Pragma("unroll") for (int n = 0; n < 2; ++n) _Pragma("unroll") for (int k = 0; k < 2; ++k) \
        acc[ai][bj][m][n] = __builtin_amdgcn_mfma_f32_16x16x32_bf16(Bt[n][k], At[m][k], acc[ai][bj][m][n], 0, 0, 0); __builtin_amdgcn_s_setprio(0); } while (0)
#define PG8_WAIT_V(n) asm volatile("s_waitcnt vmcnt(" #n ")" ::: "memory")
#define PG8_WAIT_L(n) asm volatile("s_waitcnt lgkmcnt(" #n ")" ::: "memory")
#define PG8_BAR __builtin_amdgcn_s_barrier()
#define PG8_SCHED __builtin_amdgcn_sched_barrier(0)
    typedef const __attribute__((address_space(1))) char* gptr;
    Unit cur, nxt; int ui = 0;
    if (!S.next(0, cur)) return;
    f32x4 acc[2][2][4][2];
#pragma unroll
    for (int a = 0; a < 2; ++a)
#pragma unroll
        for (int b = 0; b < 2; ++b)
#pragma unroll
            for (int m = 0; m < 4; ++m)
#pragma unroll
                for (int n = 0; n < 2; ++n) acc[a][b][m][n] = (f32x4){0.f, 0.f, 0.f, 0.f};
    bf16x8 At[4][2], B0[2][2], B1[2][2];
    const gptr A0 = (gptr)Ag, B0p = (gptr)Bg;
    gptr cA = A0 + S.a_off(cur); gptr cB = B0p + S.b_off(cur);
    PG8_STAGE(PG8_SB(0, 0), cB, voffB); PG8_STAGE(PG8_SB(0, 1), cB + hstepB, voffB); PG8_STAGE(PG8_SA(0, 0), cA, voffA); PG8_STAGE(PG8_SA(0, 1), cA + hstepA, voffA);
    if (wr == 1) PG8_BAR;
    PG8_WAIT_V(2); PG8_BAR;
    PG8_STAGE(PG8_SB(1, 0), cB + kstep, voffB); PG8_STAGE(PG8_SA(1, 0), cA + kstep, voffA); PG8_STAGE(PG8_SB(1, 1), cB + hstepB + kstep, voffB);
    PG8_WAIT_V(6); PG8_BAR;
    for (;;) {
        const bool has_next = S.next(ui + 1, nxt);
        gptr nA = has_next ? A0 + S.a_off(nxt) : cA; gptr nB = has_next ? B0p + S.b_off(nxt) : cB;
        for (int t = 0; t < nt; t += 2) {
            const bool last = (t == nt - 2);
            gptr a1 = cA + (unsigned)(t + 1) * kstep;
            gptr a2 = last ? nA : cA + (unsigned)(t + 2) * kstep; gptr b2 = last ? nB : cB + (unsigned)(t + 2) * kstep;
            gptr a3 = a2 + kstep; gptr b3 = b2 + kstep;
            PG8_LDB(B0, 0, 0); PG8_LDB(B1, 0, 1); PG8_SCHED; PG8_LDA(At, 0, 0); PG8_STAGE(PG8_SA(1, 1), a1 + hstepA, voffA);
            PG8_WAIT_V(8); PG8_WAIT_L(0); PG8_BAR; PG8_MMA(0, 0, At, B0); PG8_MMA(0, 1, At, B1); PG8_BAR; PG8_SCHED;
            PG8_LDA(At, 0, 1); PG8_STAGE(PG8_SB(0, 0), b2, voffB); PG8_STAGE(PG8_SB(0, 1), b2 + hstepB, voffB); PG8_STAGE(PG8_SA(0, 0), a2, voffA);
            PG8_WAIT_V(8); PG8_WAIT_L(0); PG8_BAR; PG8_MMA(1, 0, At, B0); PG8_MMA(1, 1, At, B1); PG8_BAR; PG8_SCHED;
            PG8_LDB(B0, 1, 0); PG8_LDB(B1, 1, 1); PG8_SCHED; PG8_LDA(At, 1, 0); PG8_STAGE(PG8_SA(0, 1), a2 + hstepA, voffA);
            PG8_WAIT_V(8); PG8_WAIT_L(0); PG8_BAR; PG8_MMA(0, 0, At, B0); PG8_MMA(0, 1, At, B1); PG8_BAR; PG8_SCHED;
            PG8_LDA(At, 1, 1); PG8_STAGE(PG8_SB(1, 0), b3, voffB); PG8_STAGE(PG8_SB(1, 1), b3 + hstepB, voffB); PG8_STAGE(PG8_SA(1, 0), a3, voffA);
            PG8_WAIT_V(8); PG8_WAIT_L(0); PG8_BAR; PG8_MMA(1, 0, At, B0); PG8_MMA(1, 1, At, B1); PG8_BAR; PG8_SCHED;
        }
        if (wr == 0) PG8_BAR;
        E(acc, cur, wr, wc, fr, fq);
        if (!has_next) break;
#pragma unroll
        for (int a = 0; a < 2; ++a)
#pragma unroll
            for (int b = 0; b < 2; ++b)
#pragma unroll
                for (int m = 0; m < 4; ++m)
#pragma unroll
                    for (int n = 0; n < 2; ++n) acc[a][b][m][n] = (f32x4){0.f, 0.f, 0.f, 0.f};
        cur = nxt; cA = nA; cB = nB; ++ui;
        if (wr == 1) PG8_BAR;
    }
    PG8_WAIT_V(0);
    PG8_BAR;
#undef PG8_SA
#undef PG8_SB
#undef PG8_STAGE
#undef PG8_LDA
#undef PG8_LDB
#undef PG8_MMA
#undef PG8_WAIT_V
#undef PG8_WAIT_L
#undef PG8_BAR
#undef PG8_SCHED
}

#define GPTR(T, p) ((__attribute__((address_space(1))) T*)(p))
DEVI float rs_of(const float* rowss, unsigned row) { return rsqrtf(*GPTR(const float, rowss + row) * (1.f / D) + NORM_EPS); }
template <bool F32, bool BF16, int ACT, bool RS, int LDC, int NCOL, unsigned PNS, bool BATCH> struct EpiStore {
    float* Of; bf16_t* Ob; const float* rowss; unsigned zs1, zs2;
    DEVI void operator()(const f32x4 (&acc)[2][2][4][2], const Unit& u, int wr, int wc, int fr, int fq) const {
        const unsigned row0 = u.pm * BM + wr * 64 + fr;
        const unsigned o0 = (unsigned)u.pn * PNS + (BATCH ? (unsigned)(u.z >> 2) * zs1 + (unsigned)(u.z & 3) * zs2 : 0u) + row0 * LDC + wc * 32 + 8 * fq;
#pragma unroll
        for (int ai = 0; ai < 2; ++ai)
#pragma unroll
            for (int m = 0; m < 4; ++m) {
                float sc = 1.f; if (RS) sc = rs_of(rowss, row0 + ai * HALF + m * 16);
#pragma unroll
                for (int bj = 0; bj < 2; ++bj) {
                    if (bj * HALF < NCOL) {
                        f32x4 v0 = acc[ai][bj][m][0], v1 = acc[ai][bj][m][1];
                        if (RS) { v0 *= sc; v1 *= sc; }
                        if (ACT == 1) {
#pragma unroll
                            for (int i = 0; i < 4; ++i) { v0[i] = 1.f - 2.f / (__expf(2.f * v0[i]) + 1.f); v1[i] = 1.f - 2.f / (__expf(2.f * v1[i]) + 1.f); }
                        } else if (ACT == 2) {
#pragma unroll
                            for (int i = 0; i < 4; ++i) { v0[i] = sigmoidf_(v0[i]); v1[i] = sigmoidf_(v1[i]); }
                        }
                        const unsigned off = o0 + (unsigned)((ai * HALF + m * 16) * LDC + bj * HALF);
                        if (NCOL == 256 || wc * 32 + 8 * fq + bj * HALF < NCOL) {
                            if (F32) { *GPTR(f32x4, Of + off) = v0; *GPTR(f32x4, Of + off + 4) = v1; }
                            if (BF16) *GPTR(u32x4, Ob + off) = pack8(v0, v1);
                        }
                    }
                }
            }
    }
};
struct EpiEvIn {
    const float* rowss; float* out; unsigned char* wsb; int e;
    DEVI void operator()(const f32x4 (&acc)[2][2][4][2], const Unit& u, int wr, int wc, int fr, int fq) const {
        const int seg = u.pn >> 1; const unsigned row0 = u.pm * BM + wr * 64 + fr;
        const unsigned o0 = row0 * 512 + (u.pn & 1) * 256 + wc * 32 + 8 * fq;
        const bool prompt = u.pm < (MP / 256);
        const size_t fo = (seg == 2 ? (prompt ? O_PDK : O_SDK) : (prompt ? O_PDV : O_SDV)) + (size_t)e * (prompt ? (size_t)MP : (size_t)MS) * 512 - (prompt ? (size_t)0 : (size_t)MP * 512);
        float* of = seg == 0 ? (float*)(wsb + B_U) : out + fo;
        bf16_t* ob = (bf16_t*)(wsb + (seg == 1 ? B_QB : (seg == 2 ? B_KB : B_VB)));
#pragma unroll
        for (int ai = 0; ai < 2; ++ai)
#pragma unroll
            for (int m = 0; m < 4; ++m) {
                const float sc = rs_of(rowss, row0 + ai * HALF + m * 16);
#pragma unroll
                for (int bj = 0; bj < 2; ++bj) {
                    const f32x4 v0 = acc[ai][bj][m][0] * sc, v1 = acc[ai][bj][m][1] * sc;
                    const unsigned off = o0 + (unsigned)((ai * HALF + m * 16) * 512 + bj * HALF);
                    if (seg != 1) { *GPTR(f32x4, of + off) = v0; *GPTR(f32x4, of + off + 4) = v1; }
                    if (seg != 0) *GPTR(u32x4, ob + off) = pack8(v0, v1);
                }
            }
    }
};
struct EpiResid {
    float* X; bf16_t* XB; float* rowss_next;
    DEVI void operator()(const f32x4 (&acc)[2][2][4][2], const Unit& u, int wr, int wc, int fr, int fq) const {
        const unsigned row0 = u.pm * BM + wr * 64 + fr, o0 = row0 * D + u.pn * BM + wc * 32 + 8 * fq;
#pragma unroll
        for (int ai = 0; ai < 2; ++ai)
#pragma unroll
            for (int m = 0; m < 4; ++m) {
                float ss = 0.f;
#pragma unroll
                for (int bj = 0; bj < 2; ++bj) {
                    const unsigned off = o0 + (unsigned)((ai * HALF + m * 16) * D + bj * HALF);
                    f32x4 x0 = *GPTR(const f32x4, X + off), x1 = *GPTR(const f32x4, X + off + 4);
                    x0 += acc[ai][bj][m][0]; x1 += acc[ai][bj][m][1];
                    *GPTR(f32x4, X + off) = x0; *GPTR(f32x4, X + off + 4) = x1;
                    *GPTR(u32x4, XB + off) = pack8(x0, x1);
                    ss += (x0[0] * x0[0] + x0[1] * x0[1]) + (x0[2] * x0[2] + x0[3] * x0[3]) + (x1[0] * x1[0] + x1[1] * x1[1]) + (x1[2] * x1[2] + x1[3] * x1[3]);
                }
                ss += __shfl_xor(ss, 16, 64); ss += __shfl_xor(ss, 32, 64);
                if (fq == 0) atomicAdd(rowss_next + (row0 + ai * HALF + m * 16), ss);
                if (m & 1) asm volatile("" ::: "memory");
            }
    }
};
struct EpiSwiglu {
    const float* rowss; bf16_t* HG;
    DEVI void operator()(const f32x4 (&acc)[2][2][4][2], const Unit& u, int wr, int wc, int fr, int fq) const {
        const unsigned row0 = u.pm * BM + wr * 64 + fr, o0 = row0 * DFF + u.pn * 128 + wc * 16 + 4 * fq;
#pragma unroll
        for (int ai = 0; ai < 2; ++ai)
#pragma unroll
            for (int m = 0; m < 4; ++m) {
                const float sc = rs_of(rowss, row0 + ai * HALF + m * 16);
#pragma unroll
                for (int bj = 0; bj < 2; ++bj) {
                    const f32x4 gt = acc[ai][bj][m][0] * sc, up = acc[ai][bj][m][1] * sc;
                    f32x4 o;
#pragma unroll
                    for (int i = 0; i < 4; ++i) o[i] = gt[i] * sigmoidf_(gt[i]) * up[i];
                    u32x2 w; w.x = cvt_pk_bf16(o[0], o[1]); w.y = cvt_pk_bf16(o[2], o[3]);
                    *GPTR(u32x2, HG + (o0 + (unsigned)((ai * HALF + m * 16) * DFF + bj * 64))) = w;
                }
            }
    }
};
}

DEVI void conv_T(const float* W, int K, int N, int ldw, bf16_t* WT, int ldt, int koff, const float* gain, int rmode, float* sm, int bid, int nb) {
    const int TIDX = tid_opaque();
    const int t = TIDX, tk = K >> 6, tn = N >> 6;
    for (int it = bid; it < tk * tn; it += nb) {
        const int k0 = (it / tn) << 6, n0 = (it % tn) << 6;
        __syncthreads();
#pragma unroll
        for (int i = 0; i < 8; ++i) { const int e = t + NT * i, kk = e >> 6, nn = e & 63; float v = W[(size_t)(k0 + kk) * ldw + n0 + nn]; if (gain) v *= gain[k0 + kk]; sm[kk * 65 + nn] = v; }
        __syncthreads();
        { const int nn = t >> 3, k8 = (t & 7) * 8; const int n = n0 + nn; const int row = rmode == 0 ? n : ((n >> 2) * 8 + (n & 3) + (rmode == 2 ? 4 : 0));
          u32x4 w; w.x = cvt_pk_bf16(sm[(k8 + 0) * 65 + nn], sm[(k8 + 1) * 65 + nn]); w.y = cvt_pk_bf16(sm[(k8 + 2) * 65 + nn], sm[(k8 + 3) * 65 + nn]);
          w.z = cvt_pk_bf16(sm[(k8 + 4) * 65 + nn], sm[(k8 + 5) * 65 + nn]); w.w = cvt_pk_bf16(sm[(k8 + 6) * 65 + nn], sm[(k8 + 7) * 65 + nn]);
          *(u32x4*)(WT + (size_t)row * ldt + koff + k0 + k8) = w; }
    }
}
DEVI void conv_small(const float* W, int ldw, int k_valid, int n_valid, bf16_t* WT, int R, int C, int bid, int nb) {
    const int TIDX = tid_opaque();
    const int total = R * C;
    for (int i = bid * NT + TIDX; i < total; i += nb * NT) { const int r = i / C, cc = i % C; float v = 0.f; if (r < n_valid && cc < k_valid) v = W[(size_t)cc * ldw + r];
        WT[i] = (bf16_t)(cvt_pk_bf16(v, 0.f) & 0xffffu); }
}
DEVI void conv_poolw(const Ctx& c, int e, bf16_t* WT, int bid, int nb) {
    const int TIDX = tid_opaque();
    const float* Wg = CIN(I_EPW) + (size_t)e * 4 * 128 * 128; const float* scl = CIN(I_EPS) + e * PW; const float* wo = CIN(I_EWOUT) + (size_t)e * D * D;
    for (int i = bid * NT + TIDX; i < 1024 * 64; i += nb * NT) {
        const int n = i & 1023, kg = i >> 10, k0 = kg * 8, g = k0 >> 7, kk0 = k0 & 127;
        float a[8];
#pragma unroll
        for (int j = 0; j < 8; ++j) a[j] = 0.f;
        for (int jj = 0; jj < 128; ++jj) {
            const float w = wo[(size_t)(g * 128 + jj) * D + n] * scl[g * 128 + jj];
#pragma unroll
            for (int j = 0; j < 8; ++j) a[j] = fmaf(Wg[(size_t)(g * 128 + kk0 + j) * 128 + jj], w, a[j]);
        }
        u32x4 w4; w4.x = cvt_pk_bf16(a[0], a[1]); w4.y = cvt_pk_bf16(a[2], a[3]); w4.z = cvt_pk_bf16(a[4], a[5]); w4.w = cvt_pk_bf16(a[6], a[7]);
        *(u32x4*)(WT + (size_t)n * D + k0) = w4;
    }
}
DEVI void ph_prologue(const Ctx& c, float* sm, int bid, int nb) {
    const int TIDX = tid_opaque();
    unsigned char* ws = CWS;
    for (int e = 0; e < 2; ++e) {
        conv_T(CIN(I_EWIN) + (size_t)e * D * 2048, D, 2048, 2048, (bf16_t*)(ws + B_WIN) + (size_t)e * 2048 * D, D, 0, CIN(I_NMIX) + (2 * e) * D, 0, sm, bid, nb);
        conv_T(CIN(I_EWOUT) + (size_t)e * D * D + (size_t)512 * D, 512, D, D, (bf16_t*)(ws + B_WOUT) + (size_t)e * D * D, D, 512, nullptr, 0, sm, bid, nb);
        conv_poolw(c, e, (bf16_t*)(ws + B_WOUT) + (size_t)e * D * D, bid, nb);
    }
    for (int o = 0; o < 2; ++o) {
        conv_T(CIN(I_WR) + (size_t)o * D * D, D, D, D, (bf16_t*)(ws + B_WR) + (size_t)o * D * D, D, 0, nullptr, 0, sm, bid, nb);
        conv_T(CIN(I_WK) + (size_t)o * D * D, D, D, D, (bf16_t*)(ws + B_WK) + (size_t)o * D * D, D, 0, nullptr, 0, sm, bid, nb);
        conv_T(CIN(I_WV) + (size_t)o * D * D, D, D, D, (bf16_t*)(ws + B_WV) + (size_t)o * D * D, D, 0, nullptr, 0, sm, bid, nb);
        conv_T(CIN(I_WO) + (size_t)o * D * D, D, D, D, (bf16_t*)(ws + B_WO) + (size_t)o * D * D, D, 0, nullptr, 0, sm, bid, nb);
        bf16_t* l1 = (bf16_t*)(ws + B_L1) + (size_t)o * 4 * 256 * D;
        conv_small(CIN(I_W1) + (size_t)o * D * 64, 64, D, 64, l1, 256, D, bid, nb);
        conv_small(CIN(I_A1) + (size_t)o * D * 64, 64, D, 64, l1 + (size_t)256 * D, 256, D, bid, nb);
        conv_small(CIN(I_G1) + (size_t)o * D * 160, 160, D, 160, l1 + (size_t)2 * 256 * D, 256, D, bid, nb);
        if (o > 0) conv_small(CIN(I_V1) + (size_t)(o - 1) * D * 32, 32, D, 32, l1 + (size_t)3 * 256 * D, 256, D, bid, nb);
        conv_small(CIN(I_W2) + (size_t)o * 64 * D, D, 64, D, (bf16_t*)(ws + B_L2W) + (size_t)o * D * 128, D, 128, bid, nb);
        conv_small(CIN(I_A2) + (size_t)o * 64 * D, D, 64, D, (bf16_t*)(ws + B_L2A) + (size_t)o * D * 128, D, 128, bid, nb);
        conv_small(CIN(I_G2) + (size_t)o * 160 * D, D, 160, D, (bf16_t*)(ws + B_L2G) + (size_t)o * D * 256, D, 256, bid, nb);
        if (o > 0) conv_small(CIN(I_V2) + (size_t)(o - 1) * 32 * D, D, 32, D, (bf16_t*)(ws + B_L2V) + (size_t)o * D * 128, D, 128, bid, nb);
    }
    for (int l = 0; l < 4; ++l) {
        conv_T(CIN(I_XWQ) + (size_t)l * D * D, D, D, D, (bf16_t*)(ws + B_XWQ) + (size_t)l * D * D, D, 0, CIN(I_NXA) + l * D, 0, sm, bid, nb);
        conv_T(CIN(I_XWK) + (size_t)l * D * D, D, D, D, (bf16_t*)(ws + B_XWK) + (size_t)l * D * D, D, 0, nullptr, 0, sm, bid, nb);
        conv_T(CIN(I_XWV) + (size_t)l * D * D, D, D, D, (bf16_t*)(ws + B_XWV) + (size_t)l * D * D, D, 0, nullptr, 0, sm, bid, nb);
        conv_T(CIN(I_XWO) + (size_t)l * D * D, D, D, D, (bf16_t*)(ws + B_XWO) + (size_t)l * D * D, D, 0, nullptr, 0, sm, bid, nb);
        conv_T(CIN(I_FWG) + (size_t)l * D * DFF, D, DFF, DFF, (bf16_t*)(ws + B_FGU) + (size_t)l * 5632 * D, D, 0, CIN(I_NFFN) + l * D, 1, sm, bid, nb);
        conv_T(CIN(I_FWU) + (size_t)l * D * DFF, D, DFF, DFF, (bf16_t*)(ws + B_FGU) + (size_t)l * 5632 * D, D, 0, CIN(I_NFFN) + l * D, 2, sm, bid, nb);
        conv_T(CIN(I_FWD) + (size_t)l * DFF * D, DFF, D, D, (bf16_t*)(ws + B_FWD) + (size_t)l * D * DFF, DFF, 0, nullptr, 0, sm, bid, nb);
    }
    {
        const int wave = TIDX >> 6, lane = TIDX & 63;
        float* X = (float*)(ws + B_X); bf16_t* XB = (bf16_t*)(ws + B_XB); float* rowss = (float*)(ws + B_ROWSS);
        for (int r = bid * 8 + wave; r < M + 1024; r += nb * 8) {
            if (r < M) {
                const float4* xr = (const float4*)(r < MP ? CIN(I_XP) + (size_t)r * D : CIN(I_XS) + (size_t)(r - MP) * D);
                float ss = 0.f;
#pragma unroll
                for (int i = 0; i < 4; ++i) { const float4 v = xr[lane + 64 * i]; ss += v.x * v.x + v.y * v.y + v.z * v.z + v.w * v.w;
                    ((float4*)(X + (size_t)r * D))[lane + 64 * i] = v; u32x2 w; w.x = cvt_pk_bf16(v.x, v.y); w.y = cvt_pk_bf16(v.z, v.w); ((u32x2*)(XB + (size_t)r * D))[lane + 64 * i] = w; }
                ss = wave_sum(ss);
                if (lane == 0) rowss[r] = ss;
            } else {
                const int rr = r - M; const float4* xr = (const float4*)(CIN(I_MEMP) + (size_t)rr * D); bf16_t* o = (bf16_t*)(ws + B_MEMB) + (size_t)rr * D;
#pragma unroll
                for (int i = 0; i < 4; ++i) { const float4 v = xr[lane + 64 * i]; u32x2 w; w.x = cvt_pk_bf16(v.x, v.y); w.y = cvt_pk_bf16(v.z, v.w); ((u32x2*)o)[lane + 64 * i] = w; }
            }
        }
    }
}

DEVI float lam_init_of(int layer) { return 0.8f - 0.6f * __expf(-0.3f * (float)layer); }
DEVI float lam_of(const Ctx& c, int e) {
    float s1 = 0.f, s2 = 0.f;
    for (int i = 0; i < 64; ++i) { s1 += CIN(I_LQ1)[e * 64 + i] * CIN(I_LK1)[e * 64 + i]; s2 += CIN(I_LQ2)[e * 64 + i] * CIN(I_LK2)[e * 64 + i]; }
    return __expf(s1) - __expf(s2) + lam_init_of(2 * e);
}
DEVI void ph_pool_prep(const Ctx& c, int e, int bid, int nb) {
    const int TIDX = tid_opaque();
    const float* Uf = (const float*)(CWS + B_U); bf16_t* CAT = (bf16_t*)(CWS + B_CAT);
    const size_t total = (size_t)M * 128;
    for (size_t idx = (size_t)bid * NT + TIDX; idx < total; idx += (size_t)nb * NT) {
        const int row = (int)(idx >> 7), col = (int)(idx & 127) * 4;
        const int w = 2 << (col >> 7);
        const bool prompt = row < MP;
        const int b = prompt ? row / TP : (row - MP) / TS, t = prompt ? row % TP : (row - MP) % TS;
        const float4 u = *(const float4*)(Uf + (size_t)row * PW + col);
        float4 s = make_float4(0.f, 0.f, 0.f, 0.f);
        for (int i = 0; i < w; ++i) {
            const int tt = t - i;
            float4 v = make_float4(0.f, 0.f, 0.f, 0.f);
            if (tt >= 0) v = *(const float4*)(Uf + (size_t)(row - i) * PW + col);
            else if (!prompt) v = *(const float4*)(CIN(I_SPOOL) + ((size_t)(e * NBS + b) * PHIST + (PHIST + tt)) * PW + col);
            s.x += v.x; s.y += v.y; s.z += v.z; s.w += v.w;
        }
        const float ic = 1.f / (prompt ? (float)((t + 1) < w ? (t + 1) : w) : (float)w);
        u32x2 o; o.x = cvt_pk_bf16(s.x * ic - u.x, s.y * ic - u.y); o.y = cvt_pk_bf16(s.z * ic - u.z, s.w * ic - u.w);
        *(u32x2*)(CAT + (size_t)row * D + col) = o;
        if (prompt) { if (t >= TP - PHIST) *(float4*)(COUT + O_PPOOL + ((size_t)(e * NBP + b) * PHIST + (t - (TP - PHIST))) * PW + col) = u; }
        else { if (t >= 1) *(float4*)(COUT + O_SPOOL + ((size_t)(e * NBS + b) * PHIST + (t - 1)) * PW + col) = u; }
    }
}
DEVI void ph_diffattn(const Ctx& c, int e, int bid, int nb, float* sm) {
    const int TIDX = tid_opaque();
    const bf16_t* QB = (const bf16_t*)(CWS + B_QB); const bf16_t* KB = (const bf16_t*)(CWS + B_KB); const bf16_t* VB = (const bf16_t*)(CWS + B_VB); bf16_t* CAT = (bf16_t*)(CWS + B_CAT);
    const int t = TIDX, qi = t & 63, map = (t >> 6) & 1, part = t >> 7;
    float* Ks = sm; float* Vs = sm + 32 * 128;
    const float lam = lam_of(c, e), li = lam_init_of(2 * e);
    for (int item = bid; item < 1152; item += nb) {
        int b, h, nq, qrow0, n_past, n_new, newrow0; const float* pastK = nullptr; const float* pastV = nullptr;
        if (item < 1024) { b = item >> 8; h = (item >> 6) & 3; const int ch = item & 63; nq = 64; qrow0 = b * TP + ch * 64; n_past = 0; n_new = (ch + 1) * 64; newrow0 = b * TP; }
        else { const int it = item - 1024; b = it >> 2; h = it & 3; nq = TS; qrow0 = MP + b * TS; n_past = PAST; n_new = TS; newrow0 = MP + b * TS;
               pastK = CIN(I_CDK) + ((size_t)(e * NBS + b) * PAST) * 512 + h * 128; pastV = CIN(I_CDV) + ((size_t)(e * NBS + b) * PAST) * 512 + h * 128; }
        const bool act = qi < nq;
        float q[64], o[32];
        {
            const bf16_t* qp = QB + (size_t)(qrow0 + (act ? qi : 0)) * 512 + h * 128 + map * 64;
#pragma unroll
            for (int d = 0; d < 64; d += 8) { const u32x4 v = *(const u32x4*)(qp + d);
                q[d] = bflo(v.x) * 0.125f; q[d + 1] = bfhi(v.x) * 0.125f; q[d + 2] = bflo(v.y) * 0.125f; q[d + 3] = bfhi(v.y) * 0.125f;
                q[d + 4] = bflo(v.z) * 0.125f; q[d + 5] = bfhi(v.z) * 0.125f; q[d + 6] = bflo(v.w) * 0.125f; q[d + 7] = bfhi(v.w) * 0.125f; }
        }
#pragma unroll
        for (int d = 0; d < 32; ++d) o[d] = 0.f;
        float mx = -1e30f, l = 0.f;
        const int total = n_past + n_new;
        for (int k0 = 0; k0 < total; k0 += 32) {
            __syncthreads();
            {
                const int key = t >> 4, c8 = (t & 15) * 8, kg = k0 + key;
                float4 k0v = make_float4(0.f, 0.f, 0.f, 0.f), k1v = k0v, v0v = k0v, v1v = k0v;
                if (kg < total) {
                    if (kg < n_past) { const float* kp = pastK + (size_t)kg * 512 + c8; const float* vp = pastV + (size_t)kg * 512 + c8;
                        k0v = *(const float4*)kp; k1v = *(const float4*)(kp + 4); v0v = *(const float4*)vp; v1v = *(const float4*)(vp + 4); }
                    else { const size_t off = (size_t)(newrow0 + kg - n_past) * 512 + h * 128 + c8; const u32x4 kw = *(const u32x4*)(KB + off), vw = *(const u32x4*)(VB + off);
                        k0v = make_float4(bflo(kw.x), bfhi(kw.x), bflo(kw.y), bfhi(kw.y)); k1v = make_float4(bflo(kw.z), bfhi(kw.z), bflo(kw.w), bfhi(kw.w));
                        v0v = make_float4(bflo(vw.x), bfhi(vw.x), bflo(vw.y), bfhi(vw.y)); v1v = make_float4(bflo(vw.z), bfhi(vw.z), bflo(vw.w), bfhi(vw.w)); }
                }
                *(float4*)(Ks + key * 128 + c8) = k0v; *(float4*)(Ks + key * 128 + c8 + 4) = k1v; *(float4*)(Vs + key * 128 + c8) = v0v; *(float4*)(Vs + key * 128 + c8 + 4) = v1v;
            }
            __syncthreads();
            const int nk = (total - k0) < 32 ? (total - k0) : 32;
            for (int kk = 0; kk < nk; ++kk) {
                const float* kr = Ks + kk * 128 + map * 64;
                float s = 0.f;
#pragma unroll
                for (int d = 0; d < 64; d += 4) { const float4 k4 = *(const float4*)(kr + d); s = fmaf(q[d], k4.x, s); s = fmaf(q[d + 1], k4.y, s); s = fmaf(q[d + 2], k4.z, s); s = fmaf(q[d + 3], k4.w, s); }
                if (s > mx) { const float cf = __expf(mx - s); l *= cf;
#pragma unroll
                    for (int d = 0; d < 32; ++d) o[d] *= cf;
                    mx = s; }
                const float p = __expf(s - mx); l += p;
                const float* vr = Vs + kk * 128 + part * 32;
#pragma unroll
                for (int d = 0; d < 32; d += 4) { const float4 v4 = *(const float4*)(vr + d); o[d] = fmaf(p, v4.x, o[d]); o[d + 1] = fmaf(p, v4.y, o[d + 1]); o[d + 2] = fmaf(p, v4.z, o[d + 2]); o[d + 3] = fmaf(p, v4.w, o[d + 3]); }
            }
        }
        __syncthreads();
        const float inv = 1.f / l;
        if (map == 1) {
#pragma unroll
            for (int d = 0; d < 32; ++d) sm[qi * 128 + part * 32 + d] = o[d] * inv;
        }
        __syncthreads();
        float ssq = 0.f;
        if (map == 0) {
#pragma unroll
            for (int d = 0; d < 32; ++d) { o[d] = o[d] * inv - lam * sm[qi * 128 + part * 32 + d]; ssq += o[d] * o[d]; }
        }
        __syncthreads();
        if (map == 0) sm[part * 64 + qi] = ssq;
        __syncthreads();
        if (map == 0 && act) {
            const float tot = sm[qi] + sm[64 + qi] + sm[128 + qi] + sm[192 + qi];
            const float sc = rsqrtf(tot * (1.f / 128.f) + NORM_EPS) * (1.f - li);
            bf16_t* op = CAT + (size_t)(qrow0 + qi) * D + 512 + h * 128 + part * 32;
            const float* gp = CIN(I_SUBG) + e * 128 + part * 32;
#pragma unroll
            for (int d = 0; d < 32; d += 8) { u32x4 w; w.x = cvt_pk_bf16(o[d] * sc * gp[d], o[d + 1] * sc * gp[d + 1]); w.y = cvt_pk_bf16(o[d + 2] * sc * gp[d + 2], o[d + 3] * sc * gp[d + 3]);
                w.z = cvt_pk_bf16(o[d + 4] * sc * gp[d + 4], o[d + 5] * sc * gp[d + 5]); w.w = cvt_pk_bf16(o[d + 6] * sc * gp[d + 6], o[d + 7] * sc * gp[d + 7]); *(u32x4*)(op + d) = w; }
        }
    }
}
DEVI void ph_shiftmix(const Ctx& c, int l, int bid, int nb) {
    const int TIDX = tid_opaque();
    const int o = l >> 1;
    const float* X = (const float*)(CWS + B_X); const float* rowss = (const float*)(CWS + B_ROWSS) + (size_t)(3 * l) * M; bf16_t* XM = (bf16_t*)(CWS + B_XM);
    const float* mu = CIN(I_MU) + (size_t)o * 6 * D; const float* gn = CIN(I_NMIX) + l * D;
    const size_t total = (size_t)M * 256;
    for (size_t idx = (size_t)bid * NT + TIDX; idx < total; idx += (size_t)nb * NT) {
        const int row = (int)(idx >> 8), col = (int)(idx & 255) * 4;
        const bool prompt = row < MP;
        const int b = prompt ? row / TP : (row - MP) / TS, t = prompt ? row % TP : (row - MP) % TS;
        const float4 g4 = *(const float4*)(gn + col);
        const float s = rsqrtf(rowss[row] * (1.f / D) + NORM_EPS);
        const float4 xv = *(const float4*)(X + (size_t)row * D + col);
        const float4 h = make_float4(xv.x * s * g4.x, xv.y * s * g4.y, xv.z * s * g4.z, xv.w * s * g4.w);
        float4 hp = make_float4(0.f, 0.f, 0.f, 0.f);
        if (t > 0) { const float s1 = rsqrtf(rowss[row - 1] * (1.f / D) + NORM_EPS); const float4 xp = *(const float4*)(X + (size_t)(row - 1) * D + col); hp = make_float4(xp.x * s1 * g4.x, xp.y * s1 * g4.y, xp.z * s1 * g4.z, xp.w * s1 * g4.w); }
        else if (!prompt) hp = *(const float4*)(CIN(I_SSHIFT) + ((size_t)o * NBS + b) * D + col);
        const float4 xx = make_float4(hp.x - h.x, hp.y - h.y, hp.z - h.z, hp.w - h.w);
#pragma unroll
        for (int i = 0; i < 6; ++i) {
            const float4 m4 = *(const float4*)(mu + i * D + col);
            u32x2 w; w.x = cvt_pk_bf16(h.x + xx.x * m4.x, h.y + xx.y * m4.y); w.y = cvt_pk_bf16(h.z + xx.z * m4.z, h.w + xx.w * m4.w);
            *(u32x2*)(XM + (size_t)i * M * D + (size_t)row * D + col) = w;
        }
        if (prompt) { if (t == TP - 1) *(float4*)(COUT + O_PSHIFT + ((size_t)o * NBP + b) * D + col) = h; }
        else { if (t == TS - 1) *(float4*)(COUT + O_SSHIFT + ((size_t)o * NBS + b) * D + col) = h; }
    }
}
DEVI void ph_rw_prep(const Ctx& c, int o, int bid, int nb) {
    const int TIDX = tid_opaque();
    float* K = (float*)(CWS + B_K); float* V = (float*)(CWS + B_V); float* W = (float*)(CWS + B_W); float* A = (float*)(CWS + B_A); float* KKb = (float*)(CWS + B_KK); float* VF = (float*)(CWS + B_VF); const float* VG = (const float*)(CWS + B_VG);
    const int wave = TIDX >> 6, lane = TIDX & 63;
    const int items = M * 16;
    for (int it = bid * 8 + wave; it < items; it += nb * 8) {
        const int row = it >> 4, h = it & 15, col = h * 64 + lane; const size_t base = (size_t)row * D + col;
        const float wpre = CIN(I_W0)[o * D + col] + W[base];
        const float x = -wpre; const float sp = x > 20.f ? x : log1pf(__expf(x));
        const float w = -sp - 0.5f; const float decay = __expf(-__expf(w));
        const float a = sigmoidf_(CIN(I_A0)[o * D + col] + A[base]);
        float v = V[base];
        if (o == 0) VF[base] = v; else v = v + (VF[base] - v) * sigmoidf_(CIN(I_V0)[(o - 1) * D + col] + VG[base]);
        const float k = K[base];
        float kk = k * CIN(I_KK)[o * D + col];
        const float nrm = sqrtf(wave_sum(kk * kk));
        kk = kk / fmaxf(nrm, 1e-12f);
        const float k2 = k * (1.f + (a - 1.f) * CIN(I_KA)[o * D + col]);
        W[base] = decay; A[base] = a; V[base] = v; KKb[base] = kk; K[base] = k2;
    }
}
DEVI void ph_rw_scan(const Ctx& c, int o, int bid, int nb, float* sm) {
    const int TIDX = tid_opaque();
    const float* R = (const float*)(CWS + B_R); const float* K = (const float*)(CWS + B_K); const float* V = (const float*)(CWS + B_V); const float* W = (const float*)(CWS + B_W); const float* A = (const float*)(CWS + B_A); const float* KKb = (const float*)(CWS + B_KK); float* Y = (float*)(CWS + B_Y);
    const int wave = TIDX >> 6, lane = TIDX & 63;
    float* sv = sm + wave * 5 * 64;
    for (int grp = bid; grp < 72; grp += nb) {
        const bool prompt = grp < 8;
        const int it = prompt ? grp * 8 + wave : (grp - 8) * 8 + wave;
        const int b = it >> 4, h = it & 15;
        const int T = prompt ? TP : TS, row0 = prompt ? b * TP : MP + b * TS;
        float S[64];
        if (prompt) {
#pragma unroll
            for (int k = 0; k < 64; ++k) S[k] = 0.f;
        } else {
            const float* sp = CIN(I_SWKV) + (((size_t)(o * NBS + b) * 16 + h) * 64 + lane) * 64;
#pragma unroll
            for (int k = 0; k < 64; k += 4) { const float4 v = *(const float4*)(sp + k); S[k] = v.x; S[k + 1] = v.y; S[k + 2] = v.z; S[k + 3] = v.w; }
        }
        size_t base = (size_t)row0 * D + h * 64 + lane;
        float nr = R[base], nd = W[base], nk = K[base], nkk = KKb[base], na = A[base], nv = V[base];
        for (int t = 0; t < T; ++t, base += D) {
            const float rj = nr, dj = nd, kj = nk, kkj = nkk, aj = na, vj = nv;
            if (t + 1 < T) { const size_t b2 = base + D; nr = R[b2]; nd = W[b2]; nk = K[b2]; nkk = KKb[b2]; na = A[b2]; nv = V[b2]; }
            __syncthreads();
            sv[lane] = rj; sv[64 + lane] = dj; sv[128 + lane] = kj; sv[192 + lane] = kkj; sv[256 + lane] = kkj * aj;
            __syncthreads();
            float sa = 0.f;
#pragma unroll
            for (int k = 0; k < 64; k += 4) { const float4 q = *(const float4*)(sv + 192 + k); sa = fmaf(S[k], q.x, sa); sa = fmaf(S[k + 1], q.y, sa); sa = fmaf(S[k + 2], q.z, sa); sa = fmaf(S[k + 3], q.w, sa); }
            sa = -sa;
            float y = 0.f;
#pragma unroll
            for (int k = 0; k < 64; k += 4) {
                const float4 d4 = *(const float4*)(sv + 64 + k), ab = *(const float4*)(sv + 256 + k), k4 = *(const float4*)(sv + 128 + k), r4 = *(const float4*)(sv + k);
                S[k] = fmaf(S[k], d4.x, fmaf(sa, ab.x, vj * k4.x)); y = fmaf(S[k], r4.x, y);
                S[k + 1] = fmaf(S[k + 1], d4.y, fmaf(sa, ab.y, vj * k4.y)); y = fmaf(S[k + 1], r4.y, y);
                S[k + 2] = fmaf(S[k + 2], d4.z, fmaf(sa, ab.z, vj * k4.z)); y = fmaf(S[k + 2], r4.z, y);
                S[k + 3] = fmaf(S[k + 3], d4.w, fmaf(sa, ab.w, vj * k4.w)); y = fmaf(S[k + 3], r4.w, y);
            }
            Y[base] = y;
        }
        float* op = COUT + (prompt ? O_PWKV + (((size_t)(o * NBP + b) * 16 + h) * 64 + lane) * 64 : O_SWKV + (((size_t)(o * NBS + b) * 16 + h) * 64 + lane) * 64);
#pragma unroll
        for (int k = 0; k < 64; k += 4) *(float4*)(op + k) = make_float4(S[k], S[k + 1], S[k + 2], S[k + 3]);
    }
}
DEVI void ph_rw_post(const Ctx& c, int o, int bid, int nb) {
    const int TIDX = tid_opaque();
    const float* R = (const float*)(CWS + B_R); const float* K = (const float*)(CWS + B_K); const float* V = (const float*)(CWS + B_V); const float* G = (const float*)(CWS + B_G); const float* Y = (const float*)(CWS + B_Y); bf16_t* YG = (bf16_t*)(CWS + B_YG);
    const int wave = TIDX >> 6, lane = TIDX & 63;
    const int items = M * 16;
    for (int it = bid * 8 + wave; it < items; it += nb * 8) {
        const int row = it >> 4, h = it & 15, col = h * 64 + lane; const size_t base = (size_t)row * D + col;
        const float y = Y[base];
        const float m = wave_sum(y) * (1.f / 64.f);
        const float dlt = y - m;
        const float var = wave_sum(dlt * dlt) * (1.f / 64.f);
        const float yn = dlt * rsqrtf(var + RW_LN_EPS) * CIN(I_LNG)[o * D + col] + CIN(I_LNB)[o * D + col];
        const float bon = wave_sum(R[base] * K[base] * CIN(I_RK)[o * D + col]) * V[base];
        YG[base] = (bf16_t)(cvt_pk_bf16((yn + bon) * G[base], 0.f) & 0xffffu);
    }
}
DEVI void ph_softmax256(const Ctx& c, int bid, int nb) {
    const int TIDX = tid_opaque();
    const float* S = (const float*)(CWS + B_S); bf16_t* P = (bf16_t*)(CWS + B_P);
    const int wave = TIDX >> 6, lane = TIDX & 63;
    const int items = MP * 4;
    for (int it = bid * 8 + wave; it < items; it += nb * 8) {
        float4 v = *((const float4*)(S + (size_t)it * 256) + lane); v.x *= 0.0625f; v.y *= 0.0625f; v.z *= 0.0625f; v.w *= 0.0625f;
        float mx = fmaxf(fmaxf(v.x, v.y), fmaxf(v.z, v.w));
#pragma unroll
        for (int o = 32; o > 0; o >>= 1) mx = fmaxf(mx, __shfl_xor(mx, o, 64));
        v.x = __expf(v.x - mx); v.y = __expf(v.y - mx); v.z = __expf(v.z - mx); v.w = __expf(v.w - mx);
        const float inv = 1.f / wave_sum(v.x + v.y + v.z + v.w);
        u32x2 w; w.x = cvt_pk_bf16(v.x * inv, v.y * inv); w.y = cvt_pk_bf16(v.z * inv, v.w * inv);
        *((u32x2*)(P + (size_t)it * 256) + lane) = w;
    }
}
DEVI void ph_xattn_sample(const Ctx& c, int l, int bid, int nb, float* sm) {
    const int TIDX = tid_opaque();
    const bf16_t* Q = (const bf16_t*)(CWS + B_Q); bf16_t* O = (bf16_t*)(CWS + B_O);
    float* Qs = sm; float* Ss = sm + 16 * 256;
    const int t = TIDX, wave = t >> 6, lane = t & 63;
    for (int item = bid; item < NBS * 4; item += nb) {
        const int b = item >> 2, h = item & 3;
        const float* Kc = CIN(I_CMK) + ((size_t)(l * NBS + b) * NMEM) * D + h * 256; const float* Vc = CIN(I_CMV) + ((size_t)(l * NBS + b) * NMEM) * D + h * 256;
        __syncthreads();
        for (int i = t; i < 16 * 256; i += NT) Qs[i] = bf2f(Q[(size_t)(MP + b * TS + (i >> 8)) * D + h * 256 + (i & 255)]);
        __syncthreads();
        {
            const int j = t & 255, i0 = (t >> 8) * 8;
            float s[8];
#pragma unroll
            for (int i = 0; i < 8; ++i) s[i] = 0.f;
            const float* kr = Kc + (size_t)j * D;
            for (int d = 0; d < 256; d += 4) { const float4 k4 = *(const float4*)(kr + d);
#pragma unroll
                for (int i = 0; i < 8; ++i) { const float4 q4 = *(const float4*)(Qs + (i0 + i) * 256 + d); s[i] = fmaf(q4.x, k4.x, fmaf(q4.y, k4.y, fmaf(q4.z, k4.z, fmaf(q4.w, k4.w, s[i])))); } }
#pragma unroll
            for (int i = 0; i < 8; ++i) Ss[(i0 + i) * 256 + j] = s[i] * 0.0625f;
        }
        __syncthreads();
        for (int r = wave * 2; r < wave * 2 + 2; ++r) {
            float4 v = *((const float4*)(Ss + r * 256) + lane);
            float mx = fmaxf(fmaxf(v.x, v.y), fmaxf(v.z, v.w));
#pragma unroll
            for (int o = 32; o > 0; o >>= 1) mx = fmaxf(mx, __shfl_xor(mx, o, 64));
            v.x = __expf(v.x - mx); v.y = __expf(v.y - mx); v.z = __expf(v.z - mx); v.w = __expf(v.w - mx);
            const float inv = 1.f / wave_sum(v.x + v.y + v.z + v.w);
            v.x *= inv; v.y *= inv; v.z *= inv; v.w *= inv; *((float4*)(Ss + r * 256) + lane) = v;
        }
        __syncthreads();
        {
            const int d = t & 255, i0 = (t >> 8) * 8;
            float o[8];
#pragma unroll
            for (int i = 0; i < 8; ++i) o[i] = 0.f;
            for (int j = 0; j < 256; ++j) { const float v = Vc[(size_t)j * D + d];
#pragma unroll
                for (int i = 0; i < 8; ++i) o[i] = fmaf(Ss[(i0 + i) * 256 + j], v, o[i]); }
#pragma unroll
            for (int i = 0; i < 8; ++i) O[(size_t)(MP + b * TS + i0 + i) * D + h * 256 + d] = (bf16_t)(cvt_pk_bf16(o[i], 0.f) & 0xffffu);
        }
    }
}
DEVI void ph_final(const Ctx& c, int bid, int nb) {
    const int TIDX = tid_opaque();
    const float* X = (const float*)(CWS + B_X); const float* rowss = (const float*)(CWS + B_ROWSS) + (size_t)12 * M; const float* g = CIN(I_NFIN);
    const int wave = TIDX >> 6, lane = TIDX & 63;
    for (int r = bid * 8 + wave; r < M; r += nb * 8) {
        const float s = rsqrtf(rowss[r] * (1.f / D) + NORM_EPS);
#pragma unroll
        for (int i = 0; i < 4; ++i) { const float4 v = ((const float4*)(X + (size_t)r * D))[lane + 64 * i]; const float4 g4 = ((const float4*)g)[lane + 64 * i];
            ((float4*)(COUT + O_YP + (size_t)r * D))[lane + 64 * i] = make_float4(v.x * s * g4.x, v.y * s * g4.y, v.z * s * g4.z, v.w * s * g4.w); }
    }
}

#define XB_TMO      128
#define XB_XCNT(j)  (256  + 64 * (j))
#define XB_XSUB(j)  (1280 + 64 * (j))
#define XB_XGEN(j)  (2304 + 64 * (j))
#define XB_TOP      3328
#define XB_TOPGEN   3392
#define XCD_BAR_WORDS 3456
#define XB_SPIN_CAP (1u << 22)
DEVI unsigned xb_ld(unsigned* p)              { return __hip_atomic_load(p, __ATOMIC_RELAXED, __HIP_MEMORY_SCOPE_AGENT); }
DEVI unsigned xb_add(unsigned* p, unsigned v) { return __hip_atomic_fetch_add(p, v, __ATOMIC_RELAXED, __HIP_MEMORY_SCOPE_AGENT); }
DEVI unsigned xb_xcc_id() { return (unsigned)__builtin_amdgcn_s_getreg((3 << 11) | 20) & 0xFu; }
#define XB_SPIN(cond, bar) do { unsigned _sp = 0; while (cond) { __builtin_amdgcn_s_sleep(1); \
    if ((++_sp & 255u) == 0u) { if (xb_ld(&(bar)[XB_TMO])) break; if (_sp > XB_SPIN_CAP) { atomicAdd(&(bar)[XB_TMO], 1u); break; } } } } while (0)
struct XcdBarrier { unsigned* bar; unsigned x; volatile LAS unsigned* st; };
DEVI XcdBarrier xcd_barrier_post(unsigned* bar, volatile LAS unsigned* st) {
    XcdBarrier b; b.bar = bar; b.x = xb_xcc_id(); b.st = st;
    if (threadIdx.x == 0) (void)xb_add(&bar[XB_XCNT(b.x)], 1u);
    return b;
}
DEVI void xcd_barrier_complete(unsigned* bar, unsigned x, unsigned& nloc, unsigned& nx) {
    const unsigned G = gridDim.x * gridDim.y * gridDim.z;
    unsigned sum, cnt, mine, sp = 0u;
    for (;;) {
        sum = 0u; cnt = 0u; mine = 0u;
#pragma unroll
        for (unsigned j = 0; j < 16; ++j) { const unsigned cc = xb_ld(&bar[XB_XCNT(j)]); sum += cc; cnt += (cc > 0u) ? 1u : 0u; mine = (j == x) ? cc : mine; }
        if (sum == G) break;
        __builtin_amdgcn_s_sleep(1);
        if ((++sp & 255u) == 0u) { if (xb_ld(&bar[XB_TMO])) break; if (sp > XB_SPIN_CAP) { atomicAdd(&bar[XB_TMO], 1u); break; } }
    }
    nloc = mine > 0u ? mine : 1u; nx = cnt > 0u ? cnt : 1u;
}
template <bool FIRST> DEVI void xcd_barrier_t(const XcdBarrier& b) {
    asm volatile("s_waitcnt vmcnt(0)" ::: "memory");
    __syncthreads();
    if (tid_opaque() == 0) {
        unsigned* bar = b.bar; asm volatile("" : "+s"(bar)); unsigned bx = b.x; asm volatile("" : "+s"(bx));
        __builtin_amdgcn_s_waitcnt(0);
        unsigned nloc = b.st[0], nx = b.st[1];
        if (FIRST) { if (nloc == 0u) { xcd_barrier_complete(bar, bx, nloc, nx); b.st[0] = nloc; b.st[1] = nx; } }
        const unsigned old = xb_add(&bar[XB_XSUB(bx)], 1u);
        const unsigned gen = old / nloc;
        if (old + 1u == (gen + 1u) * nloc) {
            __builtin_amdgcn_fence(__ATOMIC_RELEASE, "agent");
            asm volatile("s_waitcnt vmcnt(0)" ::: "memory");
            const unsigned og = xb_add(&bar[XB_TOP], 1u);
            const unsigned tg = og / nx;
            if (og + 1u == (tg + 1u) * nx) xb_add(&bar[XB_TOPGEN], 1u);
            else XB_SPIN(xb_ld(&bar[XB_TOPGEN]) == tg, bar);
            __builtin_amdgcn_fence(__ATOMIC_ACQUIRE, "agent");
            xb_add(&bar[XB_XGEN(bx)], 1u);
            asm volatile("s_waitcnt vmcnt(0)" ::: "memory");
        } else {
            XB_SPIN(xb_ld(&bar[XB_XGEN(bx)]) == gen, bar);
            __builtin_amdgcn_fence(__ATOMIC_ACQUIRE, "agent");
            asm volatile("s_waitcnt vmcnt(0)" ::: "memory");
        }
    }
    __syncthreads();
}

constexpr int LDS_BYTES = 147456;
constexpr int MISC_OFF = 131072;

typedef pg8::EpiStore<true, false, 0, false, D, 256, 256, false> EpiF32;
typedef pg8::EpiStore<true, true, 0, false, D, 256, 256, false> EpiF32B16;
typedef pg8::EpiStore<false, true, 0, true, D, 256, 256, false> EpiQ;
typedef pg8::EpiStore<false, true, 0, false, 256, 256, 1024u * 256u, false> EpiVT;
typedef pg8::EpiStore<false, true, 1, false, 128, 128, 0, false> EpiLoraTanh;
typedef pg8::EpiStore<false, true, 0, false, 128, 128, 0, false> EpiLora128;
typedef pg8::EpiStore<false, true, 2, false, 256, 256, 0, false> EpiLoraSig;
typedef pg8::EpiStore<true, false, 0, false, D, 256, 0, true> EpiScore;
typedef pg8::EpiStore<false, true, 0, false, D, 256, 0, true> EpiPV;

__global__ void __launch_bounds__(NT, 2) mega_fwd(Ctx c) {
    extern __shared__ __attribute__((aligned(16))) unsigned char lds_raw[];
    LAS unsigned char* lds = (LAS unsigned char*)lds_raw;
    float* sm = (float*)lds_raw;
    if (threadIdx.x < 4) ((volatile LAS unsigned*)(lds + MISC_OFF))[threadIdx.x] = 0u;
    __syncthreads();
    XcdBarrier xb = xcd_barrier_post((unsigned*)(CWS + B_CTL), (volatile LAS unsigned*)(lds + MISC_OFF));
    const int bid0 = blockIdx.x, nb0 = gridDim.x;
#define bid opaque_s(bid0)
#define nb opaque_s(nb0)
#define BAR() xcd_barrier_t<false>(xb)
#define ws CWS
#define rowss ((float*)(CWS + B_ROWSS))
#define X ((float*)(CWS + B_X))
#define XB ((bf16_t*)(CWS + B_XB))
#define WSB(off) ((bf16_t*)(CWS + (off)))
#define WSF(off) ((float*)(CWS + (off)))
#define GEMM(LDA_, LDB_, K_, EPI_T, Aptr, Bptr, nM_, nN_, Eobj, rot) do { pg8::Order<LDA_, LDB_, false> S_; { const int nb_ = nb; S_.init((nM_), (nN_), nb_, (bid + (rot)) % nb_); } \
        pg8::gemm_phase<LDA_, LDB_, K_, false, EPI_T>(lds, (Aptr), (Bptr), S_, (Eobj)); } while (0)

    ph_prologue(c, sm, bid, nb);
    xcd_barrier_t<true>(xb);
    for (int l = 0; l < 4; ++l) {
        { EpiF32B16 E{COUT + O_PMK + (size_t)l * 1024 * D, WSB(B_PMKB) + (size_t)l * 1024 * D, nullptr, 0, 0}; GEMM(D, D, D, EpiF32B16, WSB(B_MEMB), WSB(B_XWK) + (size_t)l * D * D, 4, 4, E, 48 * l); }
        { EpiF32 E{COUT + O_PMV + (size_t)l * 1024 * D, nullptr, nullptr, 0, 0}; GEMM(D, D, D, EpiF32, WSB(B_MEMB), WSB(B_XWV) + (size_t)l * D * D, 4, 4, E, 48 * l + 16); }
        { EpiVT E{nullptr, WSB(B_PMVT) + (size_t)l * 4 * 1024 * 256, nullptr, 0, 0}; GEMM(D, D, D, EpiVT, WSB(B_XWV) + (size_t)l * D * D, WSB(B_MEMB), 4, 4, E, 48 * l + 32); }
    }
    BAR();
    for (int l = 0; l < 4; ++l) {
        const int e = l >> 1, o = l >> 1;
        if ((l & 1) == 0) {
            {
                pg8::EpiEvIn E{rowss + (size_t)(3 * l) * M, COUT, CWS, e};
                GEMM(D, D, D, pg8::EpiEvIn, XB, WSB(B_WIN) + (size_t)e * 2048 * D, 66, 8, E, 0);
            }
            BAR();
            ph_pool_prep(c, e, bid, nb);
            ph_diffattn(c, e, bid, nb, sm);
            BAR();
            { pg8::EpiResid E{X, XB, rowss + (size_t)(3 * l + 1) * M}; GEMM(D, D, D, pg8::EpiResid, WSB(B_CAT), WSB(B_WOUT) + (size_t)e * D * D, 66, 4, E, 0); }
            BAR();
        } else {
            ph_shiftmix(c, l, bid, nb);
            BAR();
            {
                { EpiF32 E{WSF(B_R), nullptr, nullptr, 0, 0}; GEMM(D, D, D, EpiF32, WSB(B_XM) + (size_t)0 * M * D, WSB(B_WR) + (size_t)o * D * D, 66, 4, E, 0); }
                { EpiF32 E{WSF(B_K), nullptr, nullptr, 0, 0}; GEMM(D, D, D, EpiF32, WSB(B_XM) + (size_t)2 * M * D, WSB(B_WK) + (size_t)o * D * D, 66, 4, E, 8); }
                { EpiF32 E{WSF(B_V), nullptr, nullptr, 0, 0}; GEMM(D, D, D, EpiF32, WSB(B_XM) + (size_t)3 * M * D, WSB(B_WV) + (size_t)o * D * D, 66, 4, E, 16); }
                { EpiLoraTanh E{nullptr, WSB(B_LW), nullptr, 0, 0}; GEMM(D, D, D, EpiLoraTanh, WSB(B_XM) + (size_t)1 * M * D, WSB(B_L1) + (size_t)(o * 4 + 0) * 256 * D, 66, 1, E, 24); }
                { EpiLora128 E{nullptr, WSB(B_LA), nullptr, 0, 0}; GEMM(D, D, D, EpiLora128, WSB(B_XM) + (size_t)4 * M * D, WSB(B_L1) + (size_t)(o * 4 + 1) * 256 * D, 66, 1, E, 90); }
                { EpiLoraSig E{nullptr, WSB(B_LG), nullptr, 0, 0}; GEMM(D, D, D, EpiLoraSig, WSB(B_XM) + (size_t)5 * M * D, WSB(B_L1) + (size_t)(o * 4 + 2) * 256 * D, 66, 1, E, 156); }
                if (o > 0) { EpiLora128 E{nullptr, WSB(B_LV), nullptr, 0, 0}; GEMM(D, D, D, EpiLora128, WSB(B_XM) + (size_t)3 * M * D, WSB(B_L1) + (size_t)(o * 4 + 3) * 256 * D, 66, 1, E, 222); }
            }
            BAR();
            {
                { EpiF32 E{WSF(B_W), nullptr, nullptr, 0, 0}; GEMM(128, 128, 128, EpiF32, WSB(B_LW), WSB(B_L2W) + (size_t)o * D * 128, 66, 4, E, 0); }
                { EpiF32 E{WSF(B_A), nullptr, nullptr, 0, 0}; GEMM(128, 128, 128, EpiF32, WSB(B_LA), WSB(B_L2A) + (size_t)o * D * 128, 66, 4, E, 8); }
                { EpiF32 E{WSF(B_G), nullptr, nullptr, 0, 0}; GEMM(256, 256, 256, EpiF32, WSB(B_LG), WSB(B_L2G) + (size_t)o * D * 256, 66, 4, E, 16); }
                if (o > 0) { EpiF32 E{WSF(B_VG), nullptr, nullptr, 0, 0}; GEMM(128, 128, 128, EpiF32, WSB(B_LV), WSB(B_L2V) + (size_t)o * D * 128, 66, 4, E, 24); }
            }
            BAR();
            ph_rw_prep(c, o, bid, nb);
            BAR();
            ph_rw_scan(c, o, bid, nb, sm);
            BAR();
            ph_rw_post(c, o, bid, nb);
            BAR();
            { pg8::EpiResid E{X, XB, rowss + (size_t)(3 * l + 1) * M}; GEMM(D, D, D, pg8::EpiResid, WSB(B_YG), WSB(B_WO) + (size_t)o * D * D, 66, 4, E, 0); }
            BAR();
        }
        { EpiQ E{nullptr, WSB(B_Q), rowss + (size_t)(3 * l + 1) * M, 0, 0}; GEMM(D, D, D, EpiQ, XB, WSB(B_XWQ) + (size_t)l * D * D, 66, 4, E, 0); }
        BAR();
        {
            pg8::Order<D, D, true> S_; S_.init(16, 1, nb, bid); S_.nz = 16; S_.aZ1 = (unsigned)TP * D * 2; S_.aZ2 = 256 * 2; S_.bZ1 = (unsigned)NMEM * D * 2; S_.bZ2 = 256 * 2;
            EpiScore E{WSF(B_S), nullptr, nullptr, (unsigned)TP * D, 256};
            pg8::gemm_phase<D, D, 256, true, EpiScore>(lds, WSB(B_Q), WSB(B_PMKB) + (size_t)l * 1024 * D, S_, E);
            ph_xattn_sample(c, l, bid, nb, sm);
        }
        BAR();
        ph_softmax256(c, bid, nb);
        BAR();
        {
            pg8::Order<D, 256, true> S_; S_.init(16, 1, nb, bid); S_.nz = 16; S_.aZ1 = (unsigned)TP * D * 2; S_.aZ2 = 256 * 2; S_.bZ1 = (unsigned)1024 * 256 * 2; S_.bZ2 = (unsigned)256 * 256 * 2;
            EpiPV E{nullptr, WSB(B_O), nullptr, (unsigned)TP * D, 256};
            pg8::gemm_phase<D, 256, 256, true, EpiPV>(lds, WSB(B_P), WSB(B_PMVT) + (size_t)l * 4 * 1024 * 256, S_, E);
        }
        BAR();
        { pg8::EpiResid E{X, XB, rowss + (size_t)(3 * l + 2) * M}; GEMM(D, D, D, pg8::EpiResid, WSB(B_O), WSB(B_XWO) + (size_t)l * D * D, 66, 4, E, 0); }
        BAR();
        { pg8::EpiSwiglu E{rowss + (size_t)(3 * l + 2) * M, WSB(B_HG)}; GEMM(D, D, D, pg8::EpiSwiglu, XB, WSB(B_FGU) + (size_t)l * 5632 * D, 66, 22, E, 0); }
        BAR();
        { pg8::EpiResid E{X, XB, rowss + (size_t)(3 * l + 3) * M}; GEMM(DFF, DFF, DFF, pg8::EpiResid, WSB(B_HG), WSB(B_FWD) + (size_t)l * D * DFF, 66, 4, E, 0); }
        BAR();
    }
    ph_final(c, bid, nb);
#undef ws
#undef rowss
#undef X
#undef XB
#undef bid
#undef nb
}
}

extern "C" void kernel_launch(void* const* d_in, const int* in_sizes, int n_in, void* d_out, int out_size, void* d_ws, size_t ws_size, hipStream_t stream) {
    if (n_in != N_IN || (size_t)out_size != O_END || ws_size < B_END) return;
    Ctx c; for (int i = 0; i < N_IN; ++i) c.in[i] = (const float*)d_in[i];
    c.out = (float*)d_out; c.ws = (unsigned char*)d_ws;
    static int grid = 0;
    if (!grid) {
        int dev = 0, cus = 0;
        (void)hipGetDevice(&dev);
        (void)hipDeviceGetAttribute(&cus, hipDeviceAttributeMultiprocessorCount, dev);
        (void)hipFuncSetAttribute((const void*)mega_fwd, hipFuncAttributeMaxDynamicSharedMemorySize, LDS_BYTES);
        grid = cus > 0 ? cus : 256;
    }
    (void)hipMemsetAsync(d_ws, 0, CTL_BYTES, stream);
    hipLaunchKernelGGL(mega_fwd, dim3(grid), dim3(NT), LDS_BYTES, stream, c);
}
```

```cpp
#include <hip/hip_runtime.h>
#include <hip/hip_bf16.h>
#include <stdint.h>

#define DEVI __device__ __forceinline__
#define LAS __attribute__((address_space(3)))

namespace {
typedef unsigned short bf16_t;
typedef short bf16x8 __attribute__((ext_vector_type(8)));
typedef float f32x4 __attribute__((ext_vector_type(4)));
typedef unsigned u32x4 __attribute__((ext_vector_type(4)));
typedef unsigned u32x2 __attribute__((ext_vector_type(2)));

constexpr int D = 1024, NBP = 4, TP = 4096, NBS = 32, TS = 16, PAST = 4096;
constexpr int MP = NBP * TP, MS = NBS * TS, M = MP + MS;
constexpr int PW = 512, PHIST = 15;
constexpr int NMEM = 256;
constexpr int DFF = 2816;
constexpr float NORM_EPS = 1e-6f, RW_LN_EPS = 64e-5f;
constexpr int NT = 512;

constexpr size_t O_YP = 0;
constexpr size_t O_YS = O_YP + (size_t)MP * D;
constexpr size_t O_PDK = O_YS + (size_t)MS * D;
constexpr size_t O_PDV = O_PDK + (size_t)2 * MP * 512;
constexpr size_t O_PPOOL = O_PDV + (size_t)2 * MP * 512;
constexpr size_t O_PSHIFT = O_PPOOL + (size_t)2 * NBP * PHIST * PW;
constexpr size_t O_PWKV = O_PSHIFT + (size_t)2 * NBP * D;
constexpr size_t O_PMK = O_PWKV + (size_t)2 * NBP * 16 * 4096;
constexpr size_t O_PMV = O_PMK + (size_t)4 * NBP * NMEM * D;
constexpr size_t O_SDK = O_PMV + (size_t)4 * NBP * NMEM * D;
constexpr size_t O_SDV = O_SDK + (size_t)2 * MS * 512;
constexpr size_t O_SPOOL = O_SDV + (size_t)2 * MS * 512;
constexpr size_t O_SSHIFT = O_SPOOL + (size_t)2 * NBS * PHIST * PW;
constexpr size_t O_SWKV = O_SSHIFT + (size_t)2 * NBS * D;
constexpr size_t O_END = O_SWKV + (size_t)2 * NBS * 16 * 4096;

enum { I_XP = 0, I_XS, I_CDK, I_CDV, I_SPOOL, I_SSHIFT, I_SWKV, I_CMK, I_CMV, I_MEMP, I_NMIX, I_NXA, I_NFFN, I_NFIN,
       I_EWIN, I_EPW, I_EPS, I_LQ1, I_LK1, I_LQ2, I_LK2, I_SUBG, I_EWOUT, I_MU, I_WR, I_WK, I_WV, I_WO, I_W0, I_W1, I_W2,
       I_A0, I_A1, I_A2, I_V0, I_V1, I_V2, I_G1, I_G2, I_KK, I_KA, I_RK, I_LNG, I_LNB, I_XWQ, I_XWK, I_XWV, I_XWO,
       I_FWG, I_FWU, I_FWD, N_IN };

constexpr size_t MiB = 1u << 20;
constexpr size_t B_CTL = 0;
constexpr size_t B_ROWSS = 65536;
constexpr size_t CTL_BYTES = 2 * MiB;
constexpr size_t UB2 = (size_t)M * D * 2, UB4 = (size_t)M * D * 4;
constexpr size_t B_WIN = CTL_BYTES;
constexpr size_t B_WOUT = B_WIN + (size_t)2 * 2048 * 1024 * 2;
constexpr size_t B_WR = B_WOUT + (size_t)2 * 1024 * 1024 * 2;
constexpr size_t B_WK = B_WR + (size_t)2 * 1024 * 1024 * 2;
constexpr size_t B_WV = B_WK + (size_t)2 * 1024 * 1024 * 2;
constexpr size_t B_WO = B_WV + (size_t)2 * 1024 * 1024 * 2;
constexpr size_t B_L1 = B_WO + (size_t)2 * 1024 * 1024 * 2;
constexpr size_t B_L2W = B_L1 + (size_t)2 * 4 * 256 * 1024 * 2;
constexpr size_t B_L2A = B_L2W + (size_t)2 * 1024 * 128 * 2;
constexpr size_t B_L2G = B_L2A + (size_t)2 * 1024 * 128 * 2;
constexpr size_t B_L2V = B_L2G + (size_t)2 * 1024 * 256 * 2;
constexpr size_t B_XWQ = B_L2V + (size_t)2 * 1024 * 128 * 2;
constexpr size_t B_XWK = B_XWQ + (size_t)4 * 1024 * 1024 * 2;
constexpr size_t B_XWV = B_XWK + (size_t)4 * 1024 * 1024 * 2;
constexpr size_t B_XWO = B_XWV + (size_t)4 * 1024 * 1024 * 2;
constexpr size_t B_FGU = B_XWO + (size_t)4 * 1024 * 1024 * 2;
constexpr size_t B_FWD = B_FGU + (size_t)4 * 5632 * 1024 * 2;
constexpr size_t B_MEMB = B_FWD + (size_t)4 * 1024 * 2816 * 2;
constexpr size_t B_PMKB = B_MEMB + (size_t)1024 * 1024 * 2;
constexpr size_t B_PMVT = B_PMKB + (size_t)4 * 1024 * 1024 * 2;
constexpr size_t B_X = ((B_PMVT + (size_t)4 * 1024 * 1024 * 2 + 255) / 256) * 256;
constexpr size_t B_XB = B_X + UB4;
constexpr size_t B_S0 = B_XB + UB2;
constexpr size_t B_U = B_S0;
constexpr size_t B_QB = B_U + (size_t)M * 512 * 4;
constexpr size_t B_KB = B_QB + (size_t)M * 512 * 2;
constexpr size_t B_VB = B_KB + (size_t)M * 512 * 2;
constexpr size_t B_CAT = B_VB + (size_t)M * 512 * 2;
constexpr size_t B_QV = B_CAT + UB2;
constexpr size_t B_KV = B_QV + UB2;
constexpr size_t B_VV = B_KV + UB2;
constexpr size_t B_OV = B_VV + UB2;
constexpr size_t B_XM = B_S0;
constexpr size_t B_R = B_XM + 6 * UB2;
constexpr size_t B_K = B_R + UB4;
constexpr size_t B_V = B_K + UB4;
constexpr size_t B_W = B_V + UB4;
constexpr size_t B_A = B_W + UB4;
constexpr size_t B_G = B_A + UB4;
constexpr size_t B_VG = B_G + UB4;
constexpr size_t B_KK = B_VG + UB4;
constexpr size_t B_Y = B_KK + UB4;
constexpr size_t B_LW = B_Y + UB4;
constexpr size_t B_LA = B_LW + (size_t)M * 128 * 2;
constexpr size_t B_LG = B_LA + (size_t)M * 128 * 2;
constexpr size_t B_LV = B_LG + (size_t)M * 256 * 2;
constexpr size_t B_YG = B_LV + (size_t)M * 128 * 2;
constexpr size_t B_ODD_END = B_YG + UB2;
constexpr size_t CHB = (size_t)4096 * 4096 * 4;

constexpr size_t B_Q = B_S0;
constexpr size_t B_S = B_Q + UB2;
constexpr size_t B_P = B_S + UB4;
constexpr size_t B_O = B_P + UB2;
constexpr size_t B_HG = B_S0;
constexpr size_t B_VF = B_ODD_END;
constexpr size_t B_TC = B_VF + UB4, B_UC = B_TC + CHB, B_GH = B_UC + CHB, B_SC = B_GH + CHB;
constexpr size_t B_YL = B_SC + CHB;
constexpr size_t B_ROWP = B_YL + UB4;
constexpr size_t ROWP_N = (size_t)M * 16;
constexpr size_t B_DPART = B_ROWP + 13 * ROWP_N * 4;
constexpr size_t B_SMP = B_DPART + (size_t)256 * 2 * 16 * 132 * 4;
constexpr size_t SMPN = (size_t)MS * D;
constexpr size_t B_XWQN = B_SMP + 5 * SMPN * 4;
constexpr size_t B_WKT = B_XWQN + (size_t)4 * 1024 * 1024 * 2;
constexpr size_t B_VWT = B_WKT + (size_t)16 * 1024 * 1024 * 2;
constexpr size_t B_END = B_VWT + (size_t)16 * 1024 * 1024 * 2;

struct Ctx { const float* in[N_IN]; float* out; unsigned char* ws; };

template <int OFF> DEVI const void* karg_ptr() {
    unsigned long long p;
    asm volatile("s_load_dwordx2 %0, %1, %2\n\ts_waitcnt lgkmcnt(0)" : "=s"(p) : "s"(__builtin_amdgcn_kernarg_segment_ptr()), "n"(OFF) : "memory");
    return (const void*)(const __attribute__((address_space(1))) void*)p;
}
#define CIN(I) ((const float*)karg_ptr<(I) * 8>())
#define COUT ((float*)karg_ptr<N_IN * 8>())
#define CWS ((unsigned char*)karg_ptr<(N_IN + 1) * 8>())
DEVI float wave_sum(float v) {
#pragma unroll
    for (int o = 32; o > 0; o >>= 1) v += __shfl_xor(v, o, 64);
    return v;
}
DEVI int tid_opaque() { int t = threadIdx.x; asm volatile("" : "+v"(t)); return t; }
DEVI int opaque_s(int v) { asm volatile("" : "+s"(v)); return v; }
DEVI float sigmoidf_(float x) { return __builtin_amdgcn_rcpf(1.f + __expf(-x)); }
DEVI float softplusf_(float x) { return fmaxf(x, 0.f) + __logf(1.f + __expf(-fabsf(x))); }
typedef float f32x2_t_ __attribute__((ext_vector_type(2))); typedef __bf16 bf16x2_t_ __attribute__((ext_vector_type(2)));
DEVI unsigned cvt_pk_bf16(float lo, float hi) { const f32x2_t_ v = {lo, hi}; const bf16x2_t_ b = __builtin_convertvector(v, bf16x2_t_); return __builtin_bit_cast(unsigned, b); }
DEVI float bf2f(unsigned short b) { return __uint_as_float((unsigned)b << 16); }
DEVI float bflo(unsigned w) { return __uint_as_float(w << 16); }
DEVI float bfhi(unsigned w) { return __uint_as_float(w & 0xffff0000u); }
DEVI f32x4 ld4bf(const bf16_t* p) { const u32x2 w = *(const __attribute__((address_space(1))) u32x2*)p; return (f32x4){bflo(w.x), bfhi(w.x), bflo(w.y), bfhi(w.y)}; }
DEVI f32x4 cv4bf(const u32x2 w) { return (f32x4){bflo(w.x), bfhi(w.x), bflo(w.y), bfhi(w.y)}; }
DEVI void st4bf(bf16_t* p, const f32x4& v) { u32x2 w; w.x = cvt_pk_bf16(v[0], v[1]); w.y = cvt_pk_bf16(v[2], v[3]); *(__attribute__((address_space(1))) u32x2*)p = w; }
DEVI u32x4 pack8(const f32x4& a, const f32x4& b) { u32x4 w; w.x = cvt_pk_bf16(a[0], a[1]); w.y = cvt_pk_bf16(a[2], a[3]); w.z = cvt_pk_bf16(b[0], b[1]); w.w = cvt_pk_bf16(b[2], b[3]); return w; }

namespace pg8 {
constexpr int BM = 256, BK = 64, HALF = 128, HTB = HALF * BK * 2, STAGE_BYTES = 8 * HTB, NXCD = 8, WGM = 8;
__host__ __device__ __forceinline__ int lds_byte(int r, int c) { const int st = (r >> 4) * 2 + (c >> 5), rr = r & 15, cc = c & 31, ob = rr * 64 + cc * 2; return st * 1024 + (ob ^ (((ob >> 9) & 1) << 5)); }
__host__ __device__ __forceinline__ void stage_rc(int b, int& R, int& C) { const int st = b / 1024, sb = b % 1024, swz = sb ^ (((sb >> 9) & 1) << 5); R = (st >> 1) * 16 + swz / 64; C = (st & 1) * 32 + (swz % 64) / 2; }
__host__ __device__ __forceinline__ int perm32(int rho) { const int n = rho >> 4, i = rho & 15; return 8 * (i >> 2) + 4 * n + (i & 3); }

struct Unit { int pm, pn, z; };

template <int LDA, int LDB, bool BATCH> struct Order {
    int nM, nN, nz, per, G, c; unsigned aZ1, aZ2, bZ1, bZ2;
    DEVI void init(int nM_, int nN_, int G_, int c_) { nM = nM_; nN = nN_; nz = 1; per = nM * nN; G = G_; c = c_; aZ1 = aZ2 = bZ1 = bZ2 = 0; }
    DEVI bool next(int i, Unit& u) const {
        const int L = i * G + c; if (L >= per * nz) return false;
        int wgid = L % per; u.z = L / per;
        if (!BATCH) { const int q = per / NXCD, r = per % NXCD, xcd = wgid % NXCD, off = wgid / NXCD; wgid = (xcd < r ? xcd * (q + 1) : r * (q + 1) + (xcd - r) * q) + off; }
        const int nig = WGM * nN, gid = wgid / nig, fm = gid * WGM, gsz = (nM - fm) < WGM ? (nM - fm) : WGM;
        u.pm = fm + ((wgid % nig) % gsz); u.pn = (wgid % nig) / gsz; return true;
    }
    DEVI unsigned a_off(const Unit& u) const { return (BATCH ? (unsigned)(u.z >> 2) * aZ1 + (unsigned)(u.z & 3) * aZ2 : 0u) + (unsigned)u.pm * (256u * LDA * 2u); }
    DEVI unsigned b_off(const Unit& u) const { return (BATCH ? (unsigned)(u.z >> 2) * bZ1 + (unsigned)(u.z & 3) * bZ2 : 0u) + (unsigned)u.pn * (256u * LDB * 2u); }
};

template <int LDA, int LDB, int KDIM, bool BATCH, class Epi>
DEVI void gemm_phase(LAS unsigned char* lds, const bf16_t* Ag, const bf16_t* Bg, const Order<LDA, LDB, BATCH>& S, const Epi& E) {
    const int tid = tid_opaque(), wid = __builtin_amdgcn_readfirstlane(tid >> 6), lane = tid & 63, wr = wid >> 2, wc = wid & 3, fr = lane & 15, fq = lane >> 4;
    const int nt = opaque_s(KDIM / BK);
    unsigned voffA[2], voffB[2];
#pragma unroll
    for (int i = 0; i < 2; ++i) { int R, C; stage_rc(tid * 16 + i * 8192, R, C); const int Rb = (R & ~31) + perm32(R & 31);
        voffA[i] = (unsigned)(R * LDA + C) * 2u; voffB[i] = (unsigned)(Rb * LDB + C) * 2u; }
    constexpr unsigned kstep = BK * 2, hstepA = HALF * LDA * 2, hstepB = HALF * LDB * 2;
    const unsigned ldsw = (unsigned)wid * 1024u;
    const int aoff = lds_byte(wr * 64 + fr, fq * 8), boff = lds_byte(wc * 32 + fr, fq * 8);
#define PG8_SA(b, h) (((b) * 2 + (h)) * HTB)
#define PG8_SB(b, h) ((4 + (b) * 2 + (h)) * HTB)
#define PG8_STAGE(bufoff, gbase, voff) do { _Pragma("unroll") for (int _i = 0; _i < 2; ++_i) \
        __builtin_amdgcn_global_load_lds((const __attribute__((address_space(1))) unsigned*)((const __attribute__((address_space(1))) char*)(gbase) + (voff)[_i]), (LAS unsigned*)(lds + (bufoff) + ldsw + _i * 8192), 16, 0, 0); } while (0)
#define PG8_LDA(dst, b, h) do { _Pragma("unroll") for (int m = 0; m < 4; ++m) _Pragma("unroll") for (int k = 0; k < 2; ++k) dst[m][k] = *(const LAS bf16x8*)(lds + PG8_SA(b, h) + aoff + m * 2048 + k * 1024); } while (0)
#define PG8_LDB(dst, b, h) do { _Pragma("unroll") for (int n = 0; n < 2; ++n) _Pragma("unroll") for (int k = 0; k < 2; ++k) dst[n][k] = *(const LAS bf16x8*)(lds + PG8_SB(b, h) + boff + n * 2048 + k * 1024); } while (0)
#define PG8_MMA(ai, bj, At, Bt) do { __builtin_amdgcn_s_setprio(1); _Pragma("unroll") for (int m = 0; m < 4; ++m) _Pragma("unroll") for (int n = 0; n < 2; ++n) _Pragma("unroll") for (int k = 0; k < 2; ++k) \
        acc[ai][bj][m][n] = __builtin_amdgcn_mfma_f32_16x16x32_bf16(Bt[n][k], At[m][k], acc[ai][bj][m][n], 0, 0, 0); __builtin_amdgcn_s_setprio(0); } while (0)
#define PG8_WAIT_V(n) asm volatile("s_waitcnt vmcnt(" #n ")" ::: "memory")
#define PG8_WAIT_L(n) asm volatile("s_waitcnt lgkmcnt(" #n ")" ::: "memory")
#define PG8_BAR __builtin_amdgcn_s_barrier()
#define PG8_SCHED __builtin_amdgcn_sched_barrier(0)
    typedef const __attribute__((address_space(1))) char* gptr;
    Unit cur, nxt; int ui = 0;
    if (!S.next(0, cur)) return;
    f32x4 acc[2][2][4][2];
#pragma unroll
    for (int a = 0; a < 2; ++a)
#pragma unroll
        for (int b = 0; b < 2; ++b)
#pragma unroll
            for (int m = 0; m < 4; ++m)
#pragma unroll
                for (int n = 0; n < 2; ++n) acc[a][b][m][n] = (f32x4){0.f, 0.f, 0.f, 0.f};
    bf16x8 At[4][2], B0[2][2], B1[2][2];
    const gptr A0 = (gptr)Ag, B0p = (gptr)Bg;
    gptr cA = A0 + S.a_off(cur); gptr cB = B0p + S.b_off(cur);
    PG8_STAGE(PG8_SB(0, 0), cB, voffB); PG8_STAGE(PG8_SB(0, 1), cB + hstepB, voffB); PG8_STAGE(PG8_SA(0, 0), cA, voffA); PG8_STAGE(PG8_SA(0, 1), cA + hstepA, voffA);
    if (wr == 1) PG8_BAR;
    PG8_WAIT_V(2); PG8_BAR;
    PG8_STAGE(PG8_SB(1, 0), cB + kstep, voffB); PG8_STAGE(PG8_SA(1, 0), cA + kstep, voffA); PG8_STAGE(PG8_SB(1, 1), cB + hstepB + kstep, voffB);
    PG8_WAIT_V(6); PG8_BAR;
    for (;;) {
        const bool has_next = S.next(ui + 1, nxt);
        gptr nA = has_next ? A0 + S.a_off(nxt) : cA; gptr nB = has_next ? B0p + S.b_off(nxt) : cB;
        for (int t = 0; t < nt; t += 2) {
            const bool last = (t == nt - 2);
            gptr a1 = cA + (unsigned)(t + 1) * kstep;
            gptr a2 = last ? nA : cA + (unsigned)(t + 2) * kstep; gptr b2 = last ? nB : cB + (unsigned)(t + 2) * kstep;
            gptr a3 = a2 + kstep; gptr b3 = b2 + kstep;
            PG8_LDB(B0, 0, 0); PG8_LDB(B1, 0, 1); PG8_SCHED; PG8_LDA(At, 0, 0); PG8_STAGE(PG8_SA(1, 1), a1 + hstepA, voffA);
            PG8_WAIT_V(8); PG8_WAIT_L(0); PG8_BAR; PG8_MMA(0, 0, At, B0); PG8_MMA(0, 1, At, B1); PG8_BAR; PG8_SCHED;
            PG8_LDA(At, 0, 1); PG8_STAGE(PG8_SB(0, 0), b2, voffB); PG8_STAGE(PG8_SB(0, 1), b2 + hstepB, voffB); PG8_STAGE(PG8_SA(0, 0), a2, voffA);
            PG8_WAIT_V(8); PG8_WAIT_L(0); PG8_BAR; PG8_MMA(1, 0, At, B0); PG8_MMA(1, 1, At, B1); PG8_BAR; PG8_SCHED;
            PG8_LDB(B0, 1, 0); PG8_LDB(B1, 1, 1); PG8_SCHED; PG8_LDA(At, 1, 0); PG8_STAGE(PG8_SA(0, 1), a2 + hstepA, voffA);
            PG8_WAIT_V(8); PG8_WAIT_L(0); PG8_BAR; PG8_MMA(0, 0, At, B0); PG8_MMA(0, 1, At, B1); PG8_BAR; PG8_SCHED;
            PG8_LDA(At, 1, 1); PG8_STAGE(PG8_SB(1, 0), b3, voffB); PG8_STAGE(PG8_SB(1, 1), b3 + hstepB, voffB); PG8_STAGE(PG8_SA(1, 0), a3, voffA);
            PG8_WAIT_V(8); PG8_WAIT_L(0); PG8_BAR; PG8_MMA(1, 0, At, B0); PG8_MMA(1, 1, At, B1); PG8_BAR; PG8_SCHED;
        }
        if (wr == 0) PG8_BAR;
        E(acc, cur, wr, wc, fr, fq);
        if (!has_next) break;
#pragma unroll
        for (int a = 0; a < 2; ++a)
#pragma unroll
            for (int b = 0; b < 2; ++b)
#pragma unroll
                for (int m = 0; m < 4; ++m)
#pragma unroll
                    for (int n = 0; n < 2; ++n) acc[a][b][m][n] = (f32x4){0.f, 0.f, 0.f, 0.f};
        cur = nxt; cA = nA; cB = nB; ++ui;
        if (wr == 1) PG8_BAR;
    }
    PG8_WAIT_V(0);
    PG8_BAR;
#undef PG8_SA
#undef PG8_SB
#undef PG8_STAGE
#undef PG8_LDA
#undef PG8_LDB
#undef PG8_MMA
#undef PG8_WAIT_V
#undef PG8_WAIT_L
#undef PG8_BAR
#undef PG8_SCHED
}

#define GPTR(T, p) ((__attribute__((address_space(1))) T*)(p))
DEVI float rs_of(const float* rowp, unsigned row) {
    const f32x4 a = *GPTR(const f32x4, rowp + row * 16), b = *GPTR(const f32x4, rowp + row * 16 + 4), c = *GPTR(const f32x4, rowp + row * 16 + 8), d = *GPTR(const f32x4, rowp + row * 16 + 12);
    const float s = (((a[0] + a[1]) + (a[2] + a[3])) + ((b[0] + b[1]) + (b[2] + b[3]))) + (((c[0] + c[1]) + (c[2] + c[3])) + ((d[0] + d[1]) + (d[2] + d[3])));
    return rsqrtf(s * (1.f / D) + NORM_EPS);
}
template <bool F32, bool BF16, int ACT, bool RS, int LDC, int NCOL, unsigned PNS, bool BATCH> struct EpiStore {
    float* Of; bf16_t* Ob; const float* rowss; unsigned zs1, zs2;
    DEVI void operator()(const f32x4 (&acc)[2][2][4][2], const Unit& u, int wr, int wc, int fr, int fq) const {
        const unsigned row0 = u.pm * BM + wr * 64 + fr;
        const unsigned o0 = (unsigned)u.pn * PNS + (BATCH ? (unsigned)(u.z >> 2) * zs1 + (unsigned)(u.z & 3) * zs2 : 0u) + row0 * LDC + wc * 32 + 8 * fq;
#pragma unroll
        for (int ai = 0; ai < 2; ++ai)
#pragma unroll
            for (int m = 0; m < 4; ++m) {
                float sc = 1.f; if (RS) sc = rs_of(rowss, row0 + ai * HALF + m * 16);
#pragma unroll
                for (int bj = 0; bj < 2; ++bj) {
                    if (bj * HALF < NCOL) {
                        f32x4 v0 = acc[ai][bj][m][0], v1 = acc[ai][bj][m][1];
                        if (RS) { v0 *= sc; v1 *= sc; }
                        if (ACT == 1) {
#pragma unroll
                            for (int i = 0; i < 4; ++i) { v0[i] = 1.f - 2.f / (__expf(2.f * v0[i]) + 1.f); v1[i] = 1.f - 2.f / (__expf(2.f * v1[i]) + 1.f); }
                        } else if (ACT == 2) {
#pragma unroll
                            for (int i = 0; i < 4; ++i) { v0[i] = sigmoidf_(v0[i]); v1[i] = sigmoidf_(v1[i]); }
                        }
                        const unsigned off = o0 + (unsigned)((ai * HALF + m * 16) * LDC + bj * HALF);
                        if (NCOL == 256 || wc * 32 + 8 * fq + bj * HALF < NCOL) {
                            if (F32) { *GPTR(f32x4, Of + off) = v0; *GPTR(f32x4, Of + off + 4) = v1; }
                            if (BF16) *GPTR(u32x4, Ob + off) = pack8(v0, v1);
                        }
                    }
                }
            }
    }
};
struct EpiEvIn {
    const float* rowss; float* out; unsigned char* wsb; int e;
    DEVI void operator()(const f32x4 (&acc)[2][2][4][2], const Unit& u, int wr, int wc, int fr, int fq) const {
        const int seg = u.pn >> 1; const unsigned row0 = u.pm * BM + wr * 64 + fr;
        const unsigned o0 = row0 * 512 + (u.pn & 1) * 256 + wc * 32 + 8 * fq;
        const bool prompt = u.pm < (MP / 256);
        const size_t fo = (seg == 2 ? (prompt ? O_PDK : O_SDK) : (prompt ? O_PDV : O_SDV)) + (size_t)e * (prompt ? (size_t)MP : (size_t)MS) * 512 - (prompt ? (size_t)0 : (size_t)MP * 512);
        float* of = seg == 0 ? (float*)(wsb + B_U) : out + fo;
        bf16_t* ob = (bf16_t*)(wsb + (seg == 1 ? B_QB : (seg == 2 ? B_KB : B_VB)));
#pragma unroll
        for (int ai = 0; ai < 2; ++ai)
#pragma unroll
            for (int m = 0; m < 4; ++m) {
                const float sc = rs_of(rowss, row0 + ai * HALF + m * 16);
#pragma unroll
                for (int bj = 0; bj < 2; ++bj) {
                    const f32x4 v0 = acc[ai][bj][m][0] * sc, v1 = acc[ai][bj][m][1] * sc;
                    const unsigned off = o0 + (unsigned)((ai * HALF + m * 16) * 512 + bj * HALF);
                    if (seg != 1) { *GPTR(f32x4, of + off) = v0; *GPTR(f32x4, of + off + 4) = v1; }
                    if (seg != 0) {
                        if (prompt && seg == 1) { const float c2 = 0.125f * 1.4426950408889634f; *GPTR(u32x4, ob + off) = pack8(v0 * c2, v1 * c2); }
                        else if (prompt || seg == 1) *GPTR(u32x4, ob + off) = pack8(v0, v1);
                    }
                }
            }
    }
};
template <bool ZB> struct EpiResidT {
    float* X; bf16_t* XB; float* rowss_next;
    DEVI void operator()(const f32x4 (&acc)[2][2][4][2], const Unit& u, int wr, int wc, int fr, int fq) const {
        const unsigned row0 = (ZB ? (unsigned)u.z * 16u + (unsigned)u.pm : (unsigned)u.pm) * BM + wr * 64 + fr, o0 = row0 * D + u.pn * BM + wc * 32 + 8 * fq;
#pragma unroll
        for (int ai = 0; ai < 2; ++ai) {
            u32x4 xw[4][2];
#pragma unroll
            for (int m = 0; m < 4; ++m)
#pragma unroll
                for (int bj = 0; bj < 2; ++bj) xw[m][bj] = *GPTR(const u32x4, XB + (o0 + (unsigned)((ai * HALF + m * 16) * D + bj * HALF)));
#pragma unroll
            for (int m = 0; m < 4; ++m) {
                float ss = 0.f;
#pragma unroll
                for (int bj = 0; bj < 2; ++bj) {
                    const unsigned off = o0 + (unsigned)((ai * HALF + m * 16) * D + bj * HALF);
                    const u32x4 w = xw[m][bj];
                    f32x4 x0 = {bflo(w.x), bfhi(w.x), bflo(w.y), bfhi(w.y)}, x1 = {bflo(w.z), bfhi(w.z), bflo(w.w), bfhi(w.w)};
                    x0 += acc[ai][bj][m][0]; x1 += acc[ai][bj][m][1];
                    *GPTR(u32x4, XB + off) = pack8(x0, x1);
                    ss += (x0[0] * x0[0] + x0[1] * x0[1]) + (x0[2] * x0[2] + x0[3] * x0[3]) + (x1[0] * x1[0] + x1[1] * x1[1]) + (x1[2] * x1[2] + x1[3] * x1[3]);
                }
                ss += __shfl_xor(ss, 16, 64); ss += __shfl_xor(ss, 32, 64);
                if (fq == 0) *GPTR(float, rowss_next + (row0 + ai * HALF + m * 16) * 16 + u.pn * 4 + wc) = ss;
            }
            asm volatile("" ::: "memory");
        }
    }
};
typedef EpiResidT<false> EpiResid;
struct EpiSwiglu {
    const float* rowss; bf16_t* HG;
    DEVI void operator()(const f32x4 (&acc)[2][2][4][2], const Unit& u, int wr, int wc, int fr, int fq) const {
        const unsigned row0 = u.pm * BM + wr * 64 + fr, o0 = row0 * DFF + u.pn * 128 + wc * 16 + 4 * fq;
#pragma unroll
        for (int ai = 0; ai < 2; ++ai)
#pragma unroll
            for (int m = 0; m < 4; ++m) {
                const float sc = rs_of(rowss, row0 + ai * HALF + m * 16);
#pragma unroll
                for (int bj = 0; bj < 2; ++bj) {
                    const f32x4 gt = acc[ai][bj][m][0] * sc, up = acc[ai][bj][m][1] * sc;
                    f32x4 o;
#pragma unroll
                    for (int i = 0; i < 4; ++i) o[i] = gt[i] * sigmoidf_(gt[i]) * up[i];
                    u32x2 w; w.x = cvt_pk_bf16(o[0], o[1]); w.y = cvt_pk_bf16(o[2], o[3]);
                    *GPTR(u32x2, HG + (o0 + (unsigned)((ai * HALF + m * 16) * DFF + bj * 64))) = w;
                }
            }
    }
};
struct EpiSoftmax {
    bf16_t* Pb; unsigned zs1, zs2; LAS float* xl; const float* rowss;
    DEVI void operator()(const f32x4 (&acc)[2][2][4][2], const Unit& u, int wr, int wc, int fr, int fq) const {
        const float C2 = 0.0625f * 1.4426950408889634f;
        const unsigned row0 = u.pm * BM + wr * 64 + fr;
        const unsigned o0 = (unsigned)(u.z >> 2) * zs1 + (unsigned)(u.z & 3) * zs2 + row0 * D + wc * 32 + 8 * fq;
        const unsigned grow = (unsigned)(u.z >> 2) * (unsigned)TP + row0;
        float mrow[2][4];
        f32x4 (&A_)[2][2][4][2] = const_cast<f32x4 (&)[2][2][4][2]>(acc);
#pragma unroll
        for (int ai = 0; ai < 2; ++ai)
#pragma unroll
            for (int m = 0; m < 4; ++m) {
                { const float sc_ = C2 * rs_of(rowss, grow + ai * HALF + m * 16);
#pragma unroll
                  for (int bj = 0; bj < 2; ++bj)
#pragma unroll
                      for (int n = 0; n < 2; ++n) A_[ai][bj][m][n] *= sc_; }
                float mx = -3.0e38f;
#pragma unroll
                for (int bj = 0; bj < 2; ++bj)
#pragma unroll
                    for (int n = 0; n < 2; ++n) { const f32x4 v = acc[ai][bj][m][n]; mx = fmaxf(mx, fmaxf(fmaxf(v[0], v[1]), fmaxf(v[2], v[3]))); }
                mx = fmaxf(mx, __shfl_xor(mx, 16, 64)); mx = fmaxf(mx, __shfl_xor(mx, 32, 64));
                if (fq == 0) xl[(ai * HALF + wr * 64 + m * 16 + fr) * 4 + wc] = mx;
            }
        asm volatile("s_waitcnt lgkmcnt(0)\n\ts_barrier" ::: "memory");
#pragma unroll
        for (int ai = 0; ai < 2; ++ai)
#pragma unroll
            for (int m = 0; m < 4; ++m) {
                const f32x4 q = *(const LAS f32x4*)(xl + (ai * HALF + wr * 64 + m * 16 + fr) * 4);
                const float M_ = fmaxf(fmaxf(q[0], q[1]), fmaxf(q[2], q[3]));
                mrow[ai][m] = M_;
                float sm_ = 0.f;
#pragma unroll
                for (int bj = 0; bj < 2; ++bj)
#pragma unroll
                    for (int n = 0; n < 2; ++n) { const f32x4 v = acc[ai][bj][m][n];
#pragma unroll
                        for (int i = 0; i < 4; ++i) sm_ += __builtin_amdgcn_exp2f(v[i] - M_); }
                sm_ += __shfl_xor(sm_, 16, 64); sm_ += __shfl_xor(sm_, 32, 64);
                if (fq == 0) xl[1024 + (ai * HALF + wr * 64 + m * 16 + fr) * 4 + wc] = sm_;
            }
        asm volatile("s_waitcnt lgkmcnt(0)\n\ts_barrier" ::: "memory");
#pragma unroll
        for (int ai = 0; ai < 2; ++ai)
#pragma unroll
            for (int m = 0; m < 4; ++m) {
                const f32x4 q = *(const LAS f32x4*)(xl + 1024 + (ai * HALF + wr * 64 + m * 16 + fr) * 4);
                const float inv = 1.f / ((q[0] + q[1]) + (q[2] + q[3])), M_ = mrow[ai][m];
#pragma unroll
                for (int bj = 0; bj < 2; ++bj) {
                    f32x4 p0, p1;
#pragma unroll
                    for (int i = 0; i < 4; ++i) { p0[i] = __builtin_amdgcn_exp2f(acc[ai][bj][m][0][i] - M_) * inv; p1[i] = __builtin_amdgcn_exp2f(acc[ai][bj][m][1][i] - M_) * inv; }
                    *GPTR(u32x4, Pb + (o0 + (unsigned)((ai * HALF + m * 16) * D + bj * HALF))) = pack8(p0, p1);
                }
            }
    }
};
}


template <int LDA, int KDIM, int MODE>
DEVI void gemm_sample(LAS float* L, const bf16_t* A, const bf16_t* Bt, float* Xp, bf16_t* XBp, float* rowp_next, const float* rowp_cur, bf16_t* Qo, int bid, int nb) {
    const int tid = tid_opaque(), wave = __builtin_amdgcn_readfirstlane(tid >> 6), lane = tid & 63, i15 = lane & 15, kq = lane >> 4, rt = wave >> 2, ct = wave & 3;
    constexpr int KS = KDIM / 8, NS = KS / 32;
    static_assert(KS % 32 == 0, "K slice");
    LAS float* red = L + 16384;
    for (int tile = bid; tile < 256; tile += nb) {
        const int tm = tile >> 4, tn = tile & 15;
        const unsigned row = MP + tm * 32 + rt * 16 + i15;
        const unsigned off = row * D + tn * 64 + ct * 16 + 4 * kq;
        f32x4 xres = {0.f, 0.f, 0.f, 0.f}; float rsc = 1.f;
        if (MODE == 0) xres = ld4bf(XBp + off); else rsc = pg8::rs_of(rowp_cur, row);
        f32x4 acc;
        {
            const bf16_t* ap = A + (size_t)(MP + tm * 32 + i15) * LDA + wave * KS + 8 * kq; const bf16_t* bp = Bt + (size_t)(tn * 64 + i15) * KDIM + wave * KS + 8 * kq;
            f32x4 pacc[2][4];
#pragma unroll
            for (int i = 0; i < 2; ++i)
#pragma unroll
                for (int j = 0; j < 4; ++j) pacc[i][j] = (f32x4){0.f, 0.f, 0.f, 0.f};
#pragma unroll 4
            for (int s2 = 0; s2 < NS; ++s2) {
                bf16x8 af[2], bfr[4];
#pragma unroll
                for (int i = 0; i < 2; ++i) af[i] = __builtin_bit_cast(bf16x8, *GPTR(const u32x4, ap + (size_t)(i * 16) * LDA + 32 * s2));
#pragma unroll
                for (int j = 0; j < 4; ++j) bfr[j] = __builtin_bit_cast(bf16x8, *GPTR(const u32x4, bp + (size_t)(j * 16) * KDIM + 32 * s2));
#pragma unroll
                for (int i = 0; i < 2; ++i)
#pragma unroll
                    for (int j = 0; j < 4; ++j) pacc[i][j] = __builtin_amdgcn_mfma_f32_16x16x32_bf16(bfr[j], af[i], pacc[i][j], 0, 0, 0);
            }
            __syncthreads();
#pragma unroll
            for (int i = 0; i < 2; ++i)
#pragma unroll
                for (int j = 0; j < 4; ++j) *(LAS f32x4*)(L + ((wave * 8 + i * 4 + j) * 64 + lane) * 4) = pacc[i][j];
            __syncthreads();
            acc = *(const LAS f32x4*)(L + ((0 * 8 + wave) * 64 + lane) * 4);
#pragma unroll
            for (int w2 = 1; w2 < 8; ++w2) acc += *(const LAS f32x4*)(L + ((w2 * 8 + wave) * 64 + lane) * 4);
        }
        if (MODE == 0) {
            f32x4 x = xres; x += acc; (void)Xp;
            u32x2 w; w.x = cvt_pk_bf16(x[0], x[1]); w.y = cvt_pk_bf16(x[2], x[3]); *GPTR(u32x2, XBp + off) = w;
            float ss = (x[0] * x[0] + x[1] * x[1]) + (x[2] * x[2] + x[3] * x[3]);
            ss += __shfl_xor(ss, 16, 64); ss += __shfl_xor(ss, 32, 64);
            __syncthreads();
            if (kq == 0) red[(rt * 4 + ct) * 16 + i15] = ss;
            __syncthreads();
            if (ct == 0 && kq == 0) *GPTR(float, rowp_next + row * 16 + tn) = (red[(rt * 4 + 0) * 16 + i15] + red[(rt * 4 + 1) * 16 + i15]) + (red[(rt * 4 + 2) * 16 + i15] + red[(rt * 4 + 3) * 16 + i15]);
        } else {
            const f32x4 v = acc * rsc; u32x2 w; w.x = cvt_pk_bf16(v[0], v[1]); w.y = cvt_pk_bf16(v[2], v[3]); *GPTR(u32x2, Qo + off) = w;
        }
    }
}

namespace attn_body {
using bf16=__hip_bfloat16;
using bf16x8=__attribute__((ext_vector_type(8)))short;
using s16x4=__attribute__((ext_vector_type(4)))short;
using f32x16=__attribute__((ext_vector_type(16)))float;
using u32x4=__attribute__((ext_vector_type(4)))unsigned;
constexpr int BATCH=4,NHEAD=16,SEQ=4096,D=64,DM=NHEAD*D;
constexpr int NW=8,QBLK=32,QB=QBLK*NW,KVBLK=64,NQB=SEQ/QB;
constexpr int ATTN_PITCH=DM, ATTN_UNIT_ROWS=QB;
__device__ __forceinline__ int crow(int r,int hi){return (r&3)+8*(r>>2)+4*hi;}
#define SBAR() __builtin_amdgcn_sched_barrier(0)
__device__ __forceinline__ void cmask(f32x16&p0,f32x16&p1,int jb,int qrel,int hi){
  const float NEG=-INFINITY; (void)hi;
  if(jb>(qrel>>6)){
  #pragma unroll
  for(int r=0;r<16;++r){p0[r]=NEG;p1[r]=NEG;} }
}

constexpr int NSLOT=3, SLOTB=8192;
constexpr int LDS_K=0, LDS_V=NSLOT*SLOTB, LDS_WS=2*NSLOT*SLOTB, LDS_OST=LDS_WS+NW*64*4, LDS_BYTES=LDS_OST+NW*4096;
constexpr float C2=0.125f*1.4426950408889634f;
__device__ __forceinline__ void glds16(const void*gsrc,unsigned lds_dst){unsigned keep;
  asm volatile("s_mov_b32 %0, m0\n\ts_mov_b32 m0, %2\n\ts_nop 0\n\tglobal_load_lds_dwordx4 %1, off\n\ts_mov_b32 m0, %0":"=&s"(keep):"v"(gsrc),"s"(lds_dst):"memory");}
__device__ __forceinline__ float max3f(float a,float b,float c){float r;asm("v_max3_f32 %0, %1, %2, %3":"=v"(r):"v"(a),"v"(b),"v"(c));return r;}
__device__ __forceinline__ float max2f(float a,float b){float r;asm("v_max_f32_e32 %0, %1, %2":"=v"(r):"v"(a),"v"(b));return r;}
__device__ __forceinline__ float fadd_s(float a,float b){float r;asm("v_add_f32_e32 %0, %1, %2":"=v"(r):"v"(a),"v"(b));return r;}
__device__ __forceinline__ float fsub_s(float a,float b){float r;asm("v_sub_f32_e32 %0, %1, %2":"=v"(r):"v"(a),"v"(b));return r;}
typedef float f32x2_t __attribute__((ext_vector_type(2))); typedef __bf16 bf16x2_t __attribute__((ext_vector_type(2)));
__device__ __forceinline__ unsigned cvtpk_s(float lo,float hi){f32x2_t v={lo,hi};bf16x2_t b=__builtin_convertvector(v,bf16x2_t);return __builtin_bit_cast(unsigned,b);}
#define WAIT_BAR(N) asm volatile("s_waitcnt vmcnt(" #N ") lgkmcnt(0)\n\ts_barrier":::"memory")

__device__ __forceinline__ void qkt(f32x16&p0,f32x16&p1,const char*Kslot,const bf16x8*qr,const f32x16&negm,int r32,int hi){
  const char*kb=Kslot+hi*1024+r32*16;
  #pragma unroll
  for(int d0=0;d0<4;++d0){
    const bf16x8 b0=*reinterpret_cast<const bf16x8*>(kb+d0*2048);
    const bf16x8 b1=*reinterpret_cast<const bf16x8*>(kb+d0*2048+512);
    if(d0==0){p0=__builtin_amdgcn_mfma_f32_32x32x16_bf16(b0,qr[0],negm,0,0,0);p1=__builtin_amdgcn_mfma_f32_32x32x16_bf16(b1,qr[0],negm,0,0,0);}
    else{p0=__builtin_amdgcn_mfma_f32_32x32x16_bf16(b0,qr[d0],p0,0,0,0);p1=__builtin_amdgcn_mfma_f32_32x32x16_bf16(b1,qr[d0],p1,0,0,0);}}
}
typedef __attribute__((address_space(3))) const char* lds_cptr;
typedef short v4i16_t __attribute__((ext_vector_type(4)));
__device__ __forceinline__ void kload8(bf16x8*kf,lds_cptr kp){
  kf[0]=*(const __attribute__((address_space(3))) bf16x8*)(kp);      kf[1]=*(const __attribute__((address_space(3))) bf16x8*)(kp+512);
  kf[2]=*(const __attribute__((address_space(3))) bf16x8*)(kp+2048); kf[3]=*(const __attribute__((address_space(3))) bf16x8*)(kp+2560);
  kf[4]=*(const __attribute__((address_space(3))) bf16x8*)(kp+4096); kf[5]=*(const __attribute__((address_space(3))) bf16x8*)(kp+4608);
  kf[6]=*(const __attribute__((address_space(3))) bf16x8*)(kp+6144); kf[7]=*(const __attribute__((address_space(3))) bf16x8*)(kp+6656);
}
__device__ __forceinline__ void kload2(bf16x8*kf,lds_cptr kp,int j){ kf[2*j]=*(const __attribute__((address_space(3))) bf16x8*)(kp+j*2048); kf[2*j+1]=*(const __attribute__((address_space(3))) bf16x8*)(kp+j*2048+512); }
__device__ __forceinline__ s16x4 vtr(lds_cptr p){ return __builtin_bit_cast(s16x4,__builtin_amdgcn_ds_read_tr16_b64_v4i16((__attribute__((address_space(3))) v4i16_t*)p)); }
__device__ __forceinline__ float rowmax(const f32x16&p0,const f32x16&p1){
  float a=max3f(p0[0],p0[1],p1[0]),b=max3f(p0[2],p0[3],p1[1]);a=max3f(a,p1[2],p1[3]);
  #pragma unroll
  for(int r=4;r<16;r+=4){a=max3f(a,p0[r],p0[r+1]);b=max3f(b,p0[r+2],p0[r+3]);a=max3f(a,p1[r],p1[r+1]);b=max3f(b,p1[r+2],p1[r+3]);}
  const float m=max2f(a,b);
  auto rr=__builtin_amdgcn_permlane32_swap(__float_as_uint(m),__float_as_uint(m),false,false);
  return max2f(__uint_as_float(rr[0]),__uint_as_float(rr[1]));
}
__device__ __forceinline__ void pv(f32x16*o,int vb,bf16x8 pa0,bf16x8 pa1,bf16x8 pa2,bf16x8 pa3){
  #pragma unroll
  for(int d0=0;d0<2;++d0){s16x4 lo[4],hi[4];
    #pragma unroll
    for(int ks=0;ks<4;++ks){
      asm volatile("ds_read_b64_tr_b16 %0,%1 offset:%c2":"=&v"(lo[ks]):"v"(vb),"i"(d0*4096+ks*1024):"memory");
      asm volatile("ds_read_b64_tr_b16 %0,%1 offset:%c2":"=&v"(hi[ks]):"v"(vb),"i"(d0*4096+ks*1024+512):"memory");}
    asm volatile("s_waitcnt lgkmcnt(0)":::"memory");SBAR();
    #define PK(k) (bf16x8){lo[k][0],lo[k][1],lo[k][2],lo[k][3],hi[k][0],hi[k][1],hi[k][2],hi[k][3]}
    o[d0]=__builtin_amdgcn_mfma_f32_32x32x16_bf16(pa0,PK(0),o[d0],0,0,0);
    o[d0]=__builtin_amdgcn_mfma_f32_32x32x16_bf16(pa1,PK(1),o[d0],0,0,0);
    o[d0]=__builtin_amdgcn_mfma_f32_32x32x16_bf16(pa2,PK(2),o[d0],0,0,0);
    o[d0]=__builtin_amdgcn_mfma_f32_32x32x16_bf16(pa3,PK(3),o[d0],0,0,0);
    #undef PK
  }
}

#ifndef ATTN_STORE16
#define ATTN_STORE16(p,v) (*(u32x4*)(p)=(v))
#endif
template<int THRL> __device__ __forceinline__ void attn_unit(int b,int h,int qb,const bf16*Q,const bf16*__restrict__ K,const bf16*__restrict__ V,bf16*O,char*shm){
  const int tid=tid_opaque(),lane=tid&63,r32=lane&31,hi=lane>>5; const int wid=__builtin_amdgcn_readfirstlane(tid>>6);
  const long rowbase=(long)b*SEQ; const int q0=qb*QB;
  constexpr int PIN=512;
  const bf16*Qw=Q+(rowbase+q0+wid*QBLK)*PIN+(h>>1)*D;
  const bf16*Kh=K+rowbase*PIN+(h>>1)*D,*Vh=V+rowbase*PIN+((h>>2)*2+(h&1))*D;
  const unsigned lds0=(unsigned)(uintptr_t)shm;
  float*wsf=(float*)(shm+LDS_WS)+wid*64;
  const bf16*ksrc=Kh+(long)lane*PIN+wid*8;
  const bf16*vsrc=Vh+(long)(16*(wid&3)+(lane>>2))*PIN+(wid>>2)*32+(lane&3)*8;
  const unsigned kdst=lds0+LDS_K+wid*1024, vdst=lds0+LDS_V+wid*1024;
  #define DMA_K(t,slot) glds16(ksrc+(long)(t)*KVBLK*PIN,(unsigned)__builtin_amdgcn_readfirstlane(kdst+(slot)))
  #define DMA_V(t,slot) glds16(vsrc+(long)(t)*KVBLK*PIN,(unsigned)__builtin_amdgcn_readfirstlane(vdst+(slot)))
  const int vb0=(int)(lds0+LDS_V)+((lane>>4)&1)*32+(lane&3)*8+(4*hi+((lane&15)>>2))*64;
  const char*Kbase=shm+LDS_K; bf16x8 kf[8];
  const lds_cptr shm3=(lds_cptr)shm; const lds_cptr kp0=shm3+LDS_K+hi*1024+r32*16; const lds_cptr vp0=shm3+LDS_V+((lane>>4)&1)*32+(lane&3)*8+(4*hi+((lane&15)>>2))*64;
  const int NT=(q0+QB)/KVBLK;
  DMA_K(0,0);DMA_V(0,0);DMA_K(1,SLOTB);
  bf16x8 qr[4];
  #pragma unroll
  for(int d0=0;d0<4;++d0)qr[d0]=*reinterpret_cast<const bf16x8*>(&Qw[(long)r32*PIN+d0*16+hi*8]);
  float mhat=0.f,l_reg=0.f;f32x16 o[2];o[0]=f32x16{};o[1]=f32x16{};f32x16 negm=f32x16{};asm volatile("":"+v"(negm));
  const int qrel=wid*QBLK+r32;
  #define CMASK(P0,P1,t) do{int jb_=(t)-(NT-4); if(jb_>=0)cmask(P0,P1,jb_,qrel,hi);}while(0)
  bool resc=false;
  #define START(P0,P1) do{ const float rm=rowmax(P0,P1); resc=false; \
    { const float dl=rm; mhat=fadd_s(mhat,dl); \
      _Pragma("unroll") for(int r=0;r<16;++r){P0[r]=fsub_s(P0[r],dl);P1[r]=fsub_s(P1[r],dl);} \
      _Pragma("unroll") for(int r=0;r<16;++r)negm[r]=-mhat; asm volatile("":"+v"(negm)); } \
    _Pragma("unroll") for(int r=0;r<16;++r)P0[r]=__builtin_amdgcn_exp2f(P0[r]); }while(0)
  #define RESC() do{ if(resc){ asm volatile("s_waitcnt lgkmcnt(0)":::"memory"); \
      _Pragma("unroll") for(int d_=0;d_<2;++d_) _Pragma("unroll") for(int r=0;r<16;++r)o[d_][r]*=wsf[crow(r,hi)]; } }while(0)
  f32x16 pA0,pA1,pB0,pB1;
  int sl_prev=0,sl_cur=0,sl_next=SLOTB;
  #define ROT() do{sl_prev=sl_cur;sl_cur=sl_next;sl_next=(sl_next==(NSLOT-1)*SLOTB)?0:sl_next+SLOTB;}while(0)
  DMA_K(2,2*SLOTB);
  WAIT_BAR(3);
  qkt(pA0,pA1,Kbase,qr,negm,r32,hi);asm volatile("s_nop 15\n\ts_nop 7":"+v"(pA0),"+v"(pA1));CMASK(pA0,pA1,0);
  START(pA0,pA1);
  _Pragma("unroll") for(int r=0;r<16;++r)pA1[r]=__builtin_amdgcn_exp2f(pA1[r]);
  WAIT_BAR(0);
  DMA_K(3,0);DMA_V(1,SLOTB);
  ROT();
  kload8(kf,kp0+sl_cur);
  WAIT_BAR(2);
  s16x4 vlo[8],vhi[8]; u32x4 pw0,pw1,pw2,pw3;
  #define PKW(P,B) cvtpk_s(P[B],P[B+1])
  #define PAF(k) __builtin_bit_cast(bf16x8,pw##k)
  #define VFR(i) (bf16x8){vlo[i][0],vlo[i][1],vlo[i][2],vlo[i][3],vhi[i][0],vhi[i][1],vhi[i][2],vhi[i][3]}
  #define PIN(x) asm volatile("":"+v"(x))
  #define MX3(a,b,c) __builtin_fmaxf(__builtin_fmaxf((a),(b)),(c))
  #define GAPA(MF,A0,A1,A2,A3,W0,W1,PW) do{ MF; sacc+=A0; sacc+=A1; sacc+=A2; sacc+=A3; PIN(sacc); W0; W1; PIN(PW); SBAR(); }while(0)
  #define EX(v) __builtin_amdgcn_exp2f(v)
  #define GAPB(MF,X,B) do{ MF; X[B]=EX(X[B]); X[B+1]=EX(X[B+1]); X[B+2]=EX(X[B+2]); X[B+3]=EX(X[B+3]); PIN(X); SBAR(); }while(0)
  #define VRD(i) do{ vlo[i]=vtr(vp_+(((i)>>2)*4096+((i)&3)*1024)); vhi[i]=vtr(vp_+(((i)>>2)*4096+((i)&3)*1024+512)); }while(0)
  #define KRD(G,j) do{ if(G){ kload2(kf,kp0+sl_next,j); SBAR(); } }while(0)
  #define STEP(C0,C1,P0,P1,t,GK,GV,GL) do{ SBAR(); \
    const lds_cptr vp_=vp0+sl_prev; \
    VRD(0); SBAR(); float sacc=(P0[0]+P0[1]); \
    GAPA(C0=__builtin_amdgcn_mfma_f32_32x32x16_bf16(kf[0],qr[0],negm,0,0,0), P0[2],P0[3],P0[4],P0[5],     pw0[0]=PKW(P0,0), pw0[1]=PKW(P0,2), pw0); \
    VRD(4); SBAR(); GAPA(C1=__builtin_amdgcn_mfma_f32_32x32x16_bf16(kf[1],qr[0],negm,0,0,0), P0[6],P0[7],P0[8],P0[9],     pw0[2]=PKW(P0,4), pw0[3]=PKW(P0,6), pw0); \
    VRD(1); SBAR(); GAPA(C0=__builtin_amdgcn_mfma_f32_32x32x16_bf16(kf[2],qr[1],C0,0,0,0),   P0[10],P0[11],P0[12],P0[13], pw1[0]=PKW(P0,8), pw1[1]=PKW(P0,10), pw1); \
    VRD(5); SBAR(); GAPA(C1=__builtin_amdgcn_mfma_f32_32x32x16_bf16(kf[3],qr[1],C1,0,0,0),   P0[14],P0[15],P1[0],P1[1],   pw1[2]=PKW(P0,12),pw1[3]=PKW(P0,14), pw1); \
    VRD(2); SBAR(); GAPA(C0=__builtin_amdgcn_mfma_f32_32x32x16_bf16(kf[4],qr[2],C0,0,0,0),   P1[2],P1[3],P1[4],P1[5],     pw2[0]=PKW(P1,0), pw2[1]=PKW(P1,2), pw2); \
    VRD(6); SBAR(); GAPA(C1=__builtin_amdgcn_mfma_f32_32x32x16_bf16(kf[5],qr[2],C1,0,0,0),   P1[6],P1[7],P1[8],P1[9],     pw2[2]=PKW(P1,4), pw2[3]=PKW(P1,6), pw2); \
    VRD(3); SBAR(); GAPA(C0=__builtin_amdgcn_mfma_f32_32x32x16_bf16(kf[6],qr[3],C0,0,0,0),   P1[10],P1[11],P1[12],P1[13], pw3[0]=PKW(P1,8), pw3[1]=PKW(P1,10), pw3); \
    VRD(7); SBAR(); GAPA(C1=__builtin_amdgcn_mfma_f32_32x32x16_bf16(kf[7],qr[3],C1,0,0,0),   P1[14],P1[15],0.f,0.f,       pw3[2]=PKW(P1,12),pw3[3]=PKW(P1,14), pw3); \
    l_reg+=sacc; \
    if(GK){DMA_K((t)+3,sl_cur);} if(GV){DMA_V((t)+1,sl_next);} \
    CMASK(C0,C1,t); \
    { float a=MX3(C0[0],C0[1],C1[0]),b=MX3(C0[2],C0[3],C1[1]); a=MX3(a,C1[2],C1[3]); \
      _Pragma("unroll") for(int r=4;r<16;r+=4){a=MX3(a,C0[r],C0[r+1]);b=MX3(b,C0[r+2],C0[r+3]);a=MX3(a,C1[r],C1[r+1]);b=MX3(b,C1[r+2],C1[r+3]);} \
      float rm=__builtin_fmaxf(a,b); { auto rr=__builtin_amdgcn_permlane32_swap(__float_as_uint(rm),__float_as_uint(rm),false,false); rm=__builtin_fmaxf(__uint_as_float(rr[0]),__uint_as_float(rr[1])); } \
      resc=false; \
      if(__builtin_expect(__any(rm>(float)THRL),0)){ const float dl=__builtin_fmaxf(rm,0.f); mhat+=dl; \
        _Pragma("unroll") for(int r=0;r<16;++r){C0[r]-=dl;C1[r]-=dl;} \
        _Pragma("unroll") for(int r=0;r<16;++r)negm[r]=-mhat; asm volatile("":"+v"(negm)); \
        const float f=__builtin_amdgcn_exp2f(-dl); l_reg*=f; if(hi==0)wsf[r32]=f; resc=true; } } \
    SBAR(); \
    GAPB(o[0]=__builtin_amdgcn_mfma_f32_32x32x16_bf16(PAF(0),VFR(0),o[0],0,0,0), C0,0); \
    GAPB(o[1]=__builtin_amdgcn_mfma_f32_32x32x16_bf16(PAF(0),VFR(4),o[1],0,0,0), C0,4); \
    KRD(GL,0); GAPB(o[0]=__builtin_amdgcn_mfma_f32_32x32x16_bf16(PAF(1),VFR(1),o[0],0,0,0), C0,8); \
    KRD(GL,1); GAPB(o[1]=__builtin_amdgcn_mfma_f32_32x32x16_bf16(PAF(1),VFR(5),o[1],0,0,0), C0,12); \
    KRD(GL,2); GAPB(o[0]=__builtin_amdgcn_mfma_f32_32x32x16_bf16(PAF(2),VFR(2),o[0],0,0,0), C1,0); \
    KRD(GL,3); GAPB(o[1]=__builtin_amdgcn_mfma_f32_32x32x16_bf16(PAF(2),VFR(6),o[1],0,0,0), C1,4); \
    GAPB(o[0]=__builtin_amdgcn_mfma_f32_32x32x16_bf16(PAF(3),VFR(3),o[0],0,0,0), C1,8); \
    GAPB(o[1]=__builtin_amdgcn_mfma_f32_32x32x16_bf16(PAF(3),VFR(7),o[1],0,0,0), C1,12); \
    }while(0)
  int t=1;
  #undef CMASK
  #define CMASK(P0,P1,t) do{}while(0)
  for(;t+5<NT;t+=2){
    STEP(pB0,pB1,pA0,pA1,t,true,true,true);     WAIT_BAR(2); RESC(); ROT();
    STEP(pA0,pA1,pB0,pB1,t+1,true,true,true);   WAIT_BAR(2); RESC(); ROT();
  }
  #undef CMASK
  #define CMASK(P0,P1,t) do{int jb_=(t)-(NT-4); if(jb_>=0)cmask(P0,P1,jb_,qrel,hi);}while(0)
  #define ENDW(tt) do{ if((tt)+3<NT){WAIT_BAR(2);} else if((tt)+2<NT){WAIT_BAR(1);} else {WAIT_BAR(0);} }while(0)
  for(;t+1<NT;t+=2){
    STEP(pB0,pB1,pA0,pA1,t,(t+3<NT),(t+1<NT),(t+1<NT));       ENDW(t);   RESC(); ROT();
    STEP(pA0,pA1,pB0,pB1,t+1,(t+4<NT),(t+2<NT),(t+2<NT));     ENDW(t+1); RESC(); ROT();
  }
  STEP(pB0,pB1,pA0,pA1,NT-1,false,false,false); RESC();
  { float sacc=pB0[0]+pB0[1]; _Pragma("unroll") for(int r=2;r<16;++r)sacc+=pB0[r]; _Pragma("unroll") for(int r=0;r<16;++r)sacc+=pB1[r]; l_reg+=sacc;
    pw0=(u32x4){PKW(pB0,0),PKW(pB0,2),PKW(pB0,4),PKW(pB0,6)};pw1=(u32x4){PKW(pB0,8),PKW(pB0,10),PKW(pB0,12),PKW(pB0,14)};pw2=(u32x4){PKW(pB1,0),PKW(pB1,2),PKW(pB1,4),PKW(pB1,6)};pw3=(u32x4){PKW(pB1,8),PKW(pB1,10),PKW(pB1,12),PKW(pB1,14)};
    SBAR(); pv(o,vb0+sl_cur,PAF(0),PAF(1),PAF(2),PAF(3)); }
  #undef PKW
  #undef PAF
  #undef VFR
  #undef PIN
  #undef MX3
  #undef GAPA
  #undef GAPB
  #undef EX
  #undef VRD
  #undef KRD
  #undef STEP
  #undef ENDW
  {auto rr=__builtin_amdgcn_permlane32_swap(__float_as_uint(l_reg),__float_as_uint(l_reg),false,false);l_reg=__uint_as_float(rr[0])+__uint_as_float(rr[1]);}
  if(hi==0)wsf[32+r32]=l_reg;asm volatile("s_waitcnt lgkmcnt(0)":::"memory");
  float rli[16];
  #pragma unroll
  for(int r=0;r<16;++r)rli[r]=__builtin_amdgcn_rcpf(wsf[32+crow(r,hi)]);
  bf16*Ow=O+(rowbase+q0+wid*QBLK)*DM+h*D;
  { bf16*stg=(bf16*)(shm+LDS_OST)+wid*2048;
    #pragma unroll
    for(int r=0;r<16;++r){const int orow=crow(r,hi);
      #pragma unroll
      for(int d0=0;d0<2;++d0)stg[orow*64+d0*32+r32]=__float2bfloat16(o[d0][r]*rli[r]);}
    asm volatile("s_waitcnt lgkmcnt(0)":::"memory");
    #pragma unroll
    for(int i=0;i<4;++i){const int row=i*8+(lane>>3),ch=lane&7; const u32x4 v=*(const u32x4*)(stg+row*64+ch*8); ATTN_STORE16(Ow+(long)row*DM+ch*8,v);} }
  asm volatile("s_waitcnt lgkmcnt(0)\n\ts_barrier":::"memory");
  #undef DMA_K
  #undef DMA_V
  #undef CMASK
  #undef START
  #undef RESC
  #undef ROT
}
constexpr int ATTN_LDS_BYTES=LDS_BYTES;
struct AttnTensors { const bf16* Q; const bf16* K; const bf16* V; bf16* O; };
struct AttnUnit { int bh; int qb; };
struct StaticOrder {
  int vcu;
  __device__ __forceinline__ explicit StaticOrder(int grid,int block):vcu((block%8)*(grid/8)+block/8){}
  __device__ __forceinline__ bool next(int i,AttnUnit&u)const{ if(i>=4)return false; const int s=vcu&3; u.bh=vcu>>2; u.qb=(i==0)?s:(i==1)?7-s:(i==2)?8+s:15-s; return true; }
  __device__ __forceinline__ void a_ready(const AttnUnit&)const{}
  __device__ __forceinline__ void done(const AttnUnit&)const{}
};
template<class Sched,int THRL=8> __device__ __forceinline__ void attn_phase(char*lds,const AttnTensors&T,const Sched&S){
  AttnUnit u;
  for(int i=0;S.next(i,u);++i){ S.a_ready(u); attn_unit<THRL>(u.bh/NHEAD,u.bh%NHEAD,u.qb,T.Q,T.K,T.V,T.O,lds); S.done(u); }
}
#undef SBAR
#undef WAIT_BAR
}


DEVI void conv_T(const float* W, int K, int N, int ldw, bf16_t* WT, int ldt, int koff, const float* gain, int rmode, int rot, int bid, int nb) {
    bid = (bid + rot) % nb;
    const int TIDX = tid_opaque();
    const int wave = TIDX >> 6, lane = TIDX & 63, nblk = N >> 4, total = (K >> 6) * nblk;
#pragma unroll 2
    for (int st = bid * 8 + wave; st < total; st += nb * 8) {
        const int k = (st / nblk) * 64 + lane, n0 = (st % nblk) * 16;
        const float g = gain ? gain[k] : 1.f;
        const float* wp = W + (size_t)k * ldw + n0;
        const f32x4 v0 = *GPTR(const f32x4, wp), v1 = *GPTR(const f32x4, wp + 4), v2 = *GPTR(const f32x4, wp + 8), v3 = *GPTR(const f32x4, wp + 12);
        const float vv[16] = {v0[0], v0[1], v0[2], v0[3], v1[0], v1[1], v1[2], v1[3], v2[0], v2[1], v2[2], v2[3], v3[0], v3[1], v3[2], v3[3]};
#pragma unroll
        for (int j = 0; j < 16; ++j) {
            const int n = n0 + j; const int row = rmode == 0 ? n : ((n >> 2) * 8 + (n & 3) + (rmode == 2 ? 4 : 0));
            *GPTR(bf16_t, WT + (size_t)row * ldt + koff + k) = (bf16_t)(cvt_pk_bf16(vv[j] * g, 0.f) & 0xffffu);
        }
    }
}
DEVI void conv_small(const float* W, int ldw, int k_valid, int n_valid, bf16_t* WT, int R, int C, int bid, int nb) {
    const int TIDX = tid_opaque();
    const int total = R * C;
#pragma unroll 4
    for (int i = bid * NT + TIDX; i < total; i += nb * NT) { const int r = i / C, cc = i % C; float v = 0.f; if (r < n_valid && cc < k_valid) v = W[(size_t)cc * ldw + r];
        WT[i] = (bf16_t)(cvt_pk_bf16(v, 0.f) & 0xffffu); }
}
DEVI void conv_poolw(const Ctx& c, int e, bf16_t* WT, int bid, int nb) {
    const int TIDX = tid_opaque();
    const float* Wg = CIN(I_EPW) + (size_t)e * 4 * 128 * 128; const float* scl = CIN(I_EPS) + e * PW; const float* wo = CIN(I_EWOUT) + (size_t)e * D * D;
    for (int i = bid * NT + TIDX; i < 1024 * 128; i += nb * NT) {
        const int n = i & 1023, kg = __builtin_amdgcn_readfirstlane(i >> 10), k0 = kg * 4, g = k0 >> 7, kk0 = k0 & 127;
        const float* wgp = Wg + (size_t)(g * 128 + kk0) * 128; const float* sp = scl + g * 128; const float* wop = wo + (size_t)(g * 128) * D + n;
        float a[4] = {0.f, 0.f, 0.f, 0.f};
#pragma unroll 16
        for (int jj = 0; jj < 128; ++jj) {
            const float w = wop[(size_t)jj * D] * sp[jj];
#pragma unroll
            for (int j = 0; j < 4; ++j) a[j] = fmaf(wgp[j * 128 + jj], w, a[j]);
        }
        u32x2 w2; w2.x = cvt_pk_bf16(a[0], a[1]); w2.y = cvt_pk_bf16(a[2], a[3]);
        *(u32x2*)(WT + (size_t)n * D + k0) = w2;
    }
}
DEVI float cs_ld(const float* W, int ldw, int kv, int nv, int C, int total, int i) { float v = 0.f; if (i < total) { const int r = i / C, cc = i % C; if (r < nv && cc < kv) v = W[(size_t)cc * ldw + r]; } return v; }
DEVI void cs_st(bf16_t* WT, int total, int i, float v) { if (i < total) WT[i] = (bf16_t)(cvt_pk_bf16(v, 0.f) & 0xffffu); }
DEVI void conv_rowgain(const float* W, const float* gain, bf16_t* O, int bid, int nb) {
    const int TIDX = tid_opaque();
    for (int i = bid * NT + TIDX; i < 1024 * 1024 / 8; i += nb * NT) {
        const float g = gain[i >> 7];
        const f32x4 a = *GPTR(const f32x4, W + (size_t)i * 8), b = *GPTR(const f32x4, W + (size_t)i * 8 + 4);
        *GPTR(u32x4, O + (size_t)i * 8) = pack8(a * g, b * g);
    }
}
DEVI void conv_late(const Ctx& c, int l, int bid, int nb) {
    unsigned char* ws = CWS;
    conv_T(CIN(I_XWQ) + (size_t)l * D * D, D, D, D, (bf16_t*)(ws + B_XWQ) + (size_t)l * D * D, D, 0, CIN(I_NXA) + l * D, 0, 0, bid, nb);
    conv_rowgain(CIN(I_XWQ) + (size_t)l * D * D, CIN(I_NXA) + l * D, (bf16_t*)(ws + B_XWQN) + (size_t)l * D * D, bid, nb);
    conv_T(CIN(I_XWO) + (size_t)l * D * D, D, D, D, (bf16_t*)(ws + B_XWO) + (size_t)l * D * D, D, 0, nullptr, 0, 0, bid, nb);
    conv_T(CIN(I_FWG) + (size_t)l * D * DFF, D, DFF, DFF, (bf16_t*)(ws + B_FGU) + (size_t)l * 5632 * D, D, 0, CIN(I_NFFN) + l * D, 1, 0, bid, nb);
    conv_T(CIN(I_FWU) + (size_t)l * D * DFF, D, DFF, DFF, (bf16_t*)(ws + B_FGU) + (size_t)l * 5632 * D, D, 0, CIN(I_NFFN) + l * D, 2, 0, bid, nb);
    conv_T(CIN(I_FWD) + (size_t)l * DFF * D, DFF, D, D, (bf16_t*)(ws + B_FWD) + (size_t)l * D * DFF, DFF, 0, nullptr, 0, 0, bid, nb);
}
DEVI void ph_prologue(const Ctx& c, float* sm, int bid, int nb) {
    const int TIDX = tid_opaque();
    unsigned char* ws = CWS;
    for (int e = 0; e < 2; ++e) {
        conv_T(CIN(I_EWIN) + (size_t)e * D * 2048, D, 2048, 2048, (bf16_t*)(ws + B_WIN) + (size_t)e * 2048 * D, D, 0, CIN(I_NMIX) + (2 * e) * D, 0, 0, bid, nb);
        conv_T(CIN(I_EWOUT) + (size_t)e * D * D + (size_t)512 * D, 512, D, D, (bf16_t*)(ws + B_WOUT) + (size_t)e * D * D, D, 512, nullptr, 0, 0, bid, nb);
        conv_poolw(c, e, (bf16_t*)(ws + B_WOUT) + (size_t)e * D * D, bid, nb);
    }
    for (int o = 0; o < 2; ++o) {
        conv_T(CIN(I_WR) + (size_t)o * D * D, D, D, D, (bf16_t*)(ws + B_WR) + (size_t)o * D * D, D, 0, nullptr, 0, 64, bid, nb);
        conv_T(CIN(I_WK) + (size_t)o * D * D, D, D, D, (bf16_t*)(ws + B_WK) + (size_t)o * D * D, D, 0, nullptr, 0, 192, bid, nb);
        conv_T(CIN(I_WV) + (size_t)o * D * D, D, D, D, (bf16_t*)(ws + B_WV) + (size_t)o * D * D, D, 0, nullptr, 0, 64, bid, nb);
        conv_T(CIN(I_WO) + (size_t)o * D * D, D, D, D, (bf16_t*)(ws + B_WO) + (size_t)o * D * D, D, 0, nullptr, 0, 192, bid, nb);
        bf16_t* l1 = (bf16_t*)(ws + B_L1) + (size_t)o * 4 * 256 * D;
        {
            const int i0 = bid * NT + TIDX, i1 = i0 + nb * NT;
#define CS_JOB(name, W_, ldw_, kv_, nv_, WT_, R_, C_) const float* name##w = (W_); bf16_t* name##t = (WT_); const int name##l = (ldw_), name##k = (kv_), name##n = (nv_), name##c = (C_), name##tot = (R_) * (C_); \
            const float name##0 = cs_ld(name##w, name##l, name##k, name##n, name##c, name##tot, i0), name##1 = cs_ld(name##w, name##l, name##k, name##n, name##c, name##tot, i1)
#define CS_PUT(name) do { cs_st(name##t, name##tot, i0, name##0); cs_st(name##t, name##tot, i1, name##1); } while (0)
            const int ov = o > 0 ? o - 1 : 0; const int vv = o > 0 ? 32 : 0;
            CS_JOB(jw1, CIN(I_W1) + (size_t)o * D * 64, 64, D, 64, l1, 256, D);
            CS_JOB(ja1, CIN(I_A1) + (size_t)o * D * 64, 64, D, 64, l1 + (size_t)256 * D, 256, D);
            CS_JOB(jg1, CIN(I_G1) + (size_t)o * D * 160, 160, D, 160, l1 + (size_t)2 * 256 * D, 256, D);
            CS_JOB(jv1, CIN(I_V1) + (size_t)ov * D * 32, 32, D, vv, l1 + (size_t)3 * 256 * D, 256, D);
            CS_JOB(jw2, CIN(I_W2) + (size_t)o * 64 * D, D, 64, D, (bf16_t*)(ws + B_L2W) + (size_t)o * D * 128, D, 128);
            CS_JOB(ja2, CIN(I_A2) + (size_t)o * 64 * D, D, 64, D, (bf16_t*)(ws + B_L2A) + (size_t)o * D * 128, D, 128);
            CS_JOB(jg2, CIN(I_G2) + (size_t)o * 160 * D, D, 160, D, (bf16_t*)(ws + B_L2G) + (size_t)o * D * 256, D, 256);
            CS_JOB(jv2, CIN(I_V2) + (size_t)ov * 32 * D, D, vv, D, (bf16_t*)(ws + B_L2V) + (size_t)o * D * 128, D, 128);
            CS_PUT(jw1); CS_PUT(ja1); CS_PUT(jg1); if (o > 0) CS_PUT(jv1);
            CS_PUT(jw2); CS_PUT(ja2); CS_PUT(jg2); if (o > 0) CS_PUT(jv2);
#undef CS_JOB
#undef CS_PUT
        }
    }
    for (int l = 0; l < 4; ++l) {
        if (l < 2) { conv_T(CIN(I_XWQ) + (size_t)l * D * D, D, D, D, (bf16_t*)(ws + B_XWQ) + (size_t)l * D * D, D, 0, CIN(I_NXA) + l * D, 0, 64, bid, nb);
                     conv_rowgain(CIN(I_XWQ) + (size_t)l * D * D, CIN(I_NXA) + l * D, (bf16_t*)(ws + B_XWQN) + (size_t)l * D * D, bid, nb); }
        conv_T(CIN(I_XWK) + (size_t)l * D * D, D, D, D, (bf16_t*)(ws + B_XWK) + (size_t)l * D * D, D, 0, nullptr, 0, 192, bid, nb);
        conv_T(CIN(I_XWV) + (size_t)l * D * D, D, D, D, (bf16_t*)(ws + B_XWV) + (size_t)l * D * D, D, 0, nullptr, 0, 64, bid, nb);
        if (l >= 2) continue;
        conv_T(CIN(I_XWO) + (size_t)l * D * D, D, D, D, (bf16_t*)(ws + B_XWO) + (size_t)l * D * D, D, 0, nullptr, 0, 192, bid, nb);
        conv_T(CIN(I_FWG) + (size_t)l * D * DFF, D, DFF, DFF, (bf16_t*)(ws + B_FGU) + (size_t)l * 5632 * D, D, 0, CIN(I_NFFN) + l * D, 1, 64, bid, nb);
        conv_T(CIN(I_FWU) + (size_t)l * D * DFF, D, DFF, DFF, (bf16_t*)(ws + B_FGU) + (size_t)l * 5632 * D, D, 0, CIN(I_NFFN) + l * D, 2, 160, bid, nb);
        conv_T(CIN(I_FWD) + (size_t)l * DFF * D, DFF, D, D, (bf16_t*)(ws + B_FWD) + (size_t)l * D * DFF, DFF, 0, nullptr, 0, 0, bid, nb);
    }
    {
        const int wave = TIDX >> 6, lane = TIDX & 63;
        bf16_t* XB = (bf16_t*)(ws + B_XB); float* rowss = (float*)(ws + B_ROWP);
        const int step = nb * 8;
        for (int r0 = bid * 8 + wave; r0 < M + 1024; r0 += 3 * step) {
            f32x4 v[3][4];
#pragma unroll
            for (int j = 0; j < 3; ++j) { const int r = r0 + j * step;
                if (r < M + 1024) { const float* xr = r < MP ? CIN(I_XP) + (size_t)r * D : (r < M ? CIN(I_XS) + (size_t)(r - MP) * D : CIN(I_MEMP) + (size_t)(r - M) * D);
#pragma unroll
                    for (int i = 0; i < 4; ++i) v[j][i] = *GPTR(const f32x4, xr + 4 * (lane + 64 * i)); } }
#pragma unroll
            for (int j = 0; j < 3; ++j) { const int r = r0 + j * step;
                if (r < M + 1024) { bf16_t* o = r < M ? XB + (size_t)r * D : (bf16_t*)(ws + B_MEMB) + (size_t)(r - M) * D;
                    float ss = 0.f;
#pragma unroll
                    for (int i = 0; i < 4; ++i) { const f32x4 x = v[j][i]; ss += (x[0] * x[0] + x[1] * x[1]) + (x[2] * x[2] + x[3] * x[3]);
                        u32x2 w; w.x = cvt_pk_bf16(x[0], x[1]); w.y = cvt_pk_bf16(x[2], x[3]); *GPTR(u32x2, o + 4 * (lane + 64 * i)) = w; }
                    if (r < M) { ss = wave_sum(ss); if (lane < 16) rowss[(size_t)r * 16 + lane] = lane == 0 ? ss : 0.f; } } }
        }
    }
}

DEVI float lam_init_of(int layer) { return 0.8f - 0.6f * __expf(-0.3f * (float)layer); }
DEVI float lam_of(const Ctx& c, int e) {
    float s1 = 0.f, s2 = 0.f;
    for (int i = 0; i < 64; ++i) { s1 += CIN(I_LQ1)[e * 64 + i] * CIN(I_LK1)[e * 64 + i]; s2 += CIN(I_LQ2)[e * 64 + i] * CIN(I_LK2)[e * 64 + i]; }
    return __expf(s1) - __expf(s2) + lam_init_of(2 * e);
}
DEVI void ph_pool_prep(const Ctx& c, int e, int bid, int nb) {
    const int TIDX = tid_opaque();
    const float* Uf = (const float*)(CWS + B_U); bf16_t* CAT = (bf16_t*)(CWS + B_CAT);
    const size_t total = (size_t)M * 128;
    for (size_t idx = (size_t)bid * NT + TIDX; idx < total; idx += (size_t)nb * NT) {
        const int row = (int)(idx >> 7), col = (int)(idx & 127) * 4;
        const int w = 2 << (col >> 7);
        const bool prompt = row < MP;
        const int b = prompt ? row / TP : (row - MP) / TS, t = prompt ? row % TP : (row - MP) % TS;
        const float4 u = *(const float4*)(Uf + (size_t)row * PW + col);
        float4 s = make_float4(0.f, 0.f, 0.f, 0.f);
        for (int i = 0; i < w; ++i) {
            const int tt = t - i;
            float4 v = make_float4(0.f, 0.f, 0.f, 0.f);
            if (tt >= 0) v = *(const float4*)(Uf + (size_t)(row - i) * PW + col);
            else if (!prompt) v = *(const float4*)(CIN(I_SPOOL) + ((size_t)(e * NBS + b) * PHIST + (PHIST + tt)) * PW + col);
            s.x += v.x; s.y += v.y; s.z += v.z; s.w += v.w;
        }
        const float ic = 1.f / (prompt ? (float)((t + 1) < w ? (t + 1) : w) : (float)w);
        u32x2 o; o.x = cvt_pk_bf16(s.x * ic - u.x, s.y * ic - u.y); o.y = cvt_pk_bf16(s.z * ic - u.z, s.w * ic - u.w);
        *(u32x2*)(CAT + (size_t)row * D + col) = o;
        if (prompt) { if (t >= TP - PHIST) *(float4*)(COUT + O_PPOOL + ((size_t)(e * NBP + b) * PHIST + (t - (TP - PHIST))) * PW + col) = u; }
        else { if (t >= 1) *(float4*)(COUT + O_SPOOL + ((size_t)(e * NBS + b) * PHIST + (t - 1)) * PW + col) = u; }
    }
}
DEVI void ph_diffattn(const Ctx& c, int e, int item0, int bid, int nb, float* sm) {
    const int TIDX = tid_opaque();
    const bf16_t* QB = (const bf16_t*)(CWS + B_QB); const bf16_t* KB = (const bf16_t*)(CWS + B_KB); const bf16_t* VB = (const bf16_t*)(CWS + B_VB); bf16_t* CAT = (bf16_t*)(CWS + B_CAT);
    const int t = TIDX, qi = t & 63, map = (t >> 6) & 1, part = t >> 7;
    float* Ks = sm; float* Vs = sm + 32 * 128;
    const float lam = lam_of(c, e), li = lam_init_of(2 * e);
    for (int item = item0 + bid; item < 1152; item += nb) {
        int b, h, nq, qrow0, n_past, n_new, newrow0; const float* pastK = nullptr; const float* pastV = nullptr;
        if (item < 1024) { b = item >> 8; h = (item >> 6) & 3; const int ch = item & 63; nq = 64; qrow0 = b * TP + ch * 64; n_past = 0; n_new = (ch + 1) * 64; newrow0 = b * TP; }
        else { const int it = item - 1024; b = it >> 2; h = it & 3; nq = TS; qrow0 = MP + b * TS; n_past = PAST; n_new = TS; newrow0 = MP + b * TS;
               pastK = CIN(I_CDK) + ((size_t)(e * NBS + b) * PAST) * 512 + h * 128; pastV = CIN(I_CDV) + ((size_t)(e * NBS + b) * PAST) * 512 + h * 128; }
        const bool act = qi < nq;
        float q[64], o[32];
        {
            const bf16_t* qp = QB + (size_t)(qrow0 + (act ? qi : 0)) * 512 + h * 128 + map * 64;
#pragma unroll
            for (int d = 0; d < 64; d += 8) { const u32x4 v = *(const u32x4*)(qp + d);
                q[d] = bflo(v.x) * 0.125f; q[d + 1] = bfhi(v.x) * 0.125f; q[d + 2] = bflo(v.y) * 0.125f; q[d + 3] = bfhi(v.y) * 0.125f;
                q[d + 4] = bflo(v.z) * 0.125f; q[d + 5] = bfhi(v.z) * 0.125f; q[d + 6] = bflo(v.w) * 0.125f; q[d + 7] = bfhi(v.w) * 0.125f; }
        }
#pragma unroll
        for (int d = 0; d < 32; ++d) o[d] = 0.f;
        float mx = -1e30f, l = 0.f;
        const int total = n_past + n_new;
        for (int k0 = 0; k0 < total; k0 += 32) {
            __syncthreads();
            {
                const int key = t >> 4, c8 = (t & 15) * 8, kg = k0 + key;
                float4 k0v = make_float4(0.f, 0.f, 0.f, 0.f), k1v = k0v, v0v = k0v, v1v = k0v;
                if (kg < total) {
                    if (kg < n_past) { const float* kp = pastK + (size_t)kg * 512 + c8; const float* vp = pastV + (size_t)kg * 512 + c8;
                        k0v = *(const float4*)kp; k1v = *(const float4*)(kp + 4); v0v = *(const float4*)vp; v1v = *(const float4*)(vp + 4); }
                    else { const size_t off = (size_t)(newrow0 + kg - n_past) * 512 + h * 128 + c8; const u32x4 kw = *(const u32x4*)(KB + off), vw = *(const u32x4*)(VB + off);
                        k0v = make_float4(bflo(kw.x), bfhi(kw.x), bflo(kw.y), bfhi(kw.y)); k1v = make_float4(bflo(kw.z), bfhi(kw.z), bflo(kw.w), bfhi(kw.w));
                        v0v = make_float4(bflo(vw.x), bfhi(vw.x), bflo(vw.y), bfhi(vw.y)); v1v = make_float4(bflo(vw.z), bfhi(vw.z), bflo(vw.w), bfhi(vw.w)); }
                }
                *(float4*)(Ks + key * 128 + c8) = k0v; *(float4*)(Ks + key * 128 + c8 + 4) = k1v; *(float4*)(Vs + key * 128 + c8) = v0v; *(float4*)(Vs + key * 128 + c8 + 4) = v1v;
            }
            __syncthreads();
            const int nk = (total - k0) < 32 ? (total - k0) : 32;
            for (int kk = 0; kk < nk; ++kk) {
                const float* kr = Ks + kk * 128 + map * 64;
                float s = 0.f;
#pragma unroll
                for (int d = 0; d < 64; d += 4) { const float4 k4 = *(const float4*)(kr + d); s = fmaf(q[d], k4.x, s); s = fmaf(q[d + 1], k4.y, s); s = fmaf(q[d + 2], k4.z, s); s = fmaf(q[d + 3], k4.w, s); }
                if (s > mx) { const float cf = __expf(mx - s); l *= cf;
#pragma unroll
                    for (int d = 0; d < 32; ++d) o[d] *= cf;
                    mx = s; }
                const float p = __expf(s - mx); l += p;
                const float* vr = Vs + kk * 128 + part * 32;
#pragma unroll
                for (int d = 0; d < 32; d += 4) { const float4 v4 = *(const float4*)(vr + d); o[d] = fmaf(p, v4.x, o[d]); o[d + 1] = fmaf(p, v4.y, o[d + 1]); o[d + 2] = fmaf(p, v4.z, o[d + 2]); o[d + 3] = fmaf(p, v4.w, o[d + 3]); }
            }
        }
        __syncthreads();
        const float inv = 1.f / l;
        if (map == 1) {
#pragma unroll
            for (int d = 0; d < 32; ++d) sm[qi * 128 + part * 32 + d] = o[d] * inv;
        }
        __syncthreads();
        float ssq = 0.f;
        if (map == 0) {
#pragma unroll
            for (int d = 0; d < 32; ++d) { o[d] = o[d] * inv - lam * sm[qi * 128 + part * 32 + d]; ssq += o[d] * o[d]; }
        }
        __syncthreads();
        if (map == 0) sm[part * 64 + qi] = ssq;
        __syncthreads();
        if (map == 0 && act) {
            const float tot = sm[qi] + sm[64 + qi] + sm[128 + qi] + sm[192 + qi];
            const float sc = rsqrtf(tot * (1.f / 128.f) + NORM_EPS) * (1.f - li);
            bf16_t* op = CAT + (size_t)(qrow0 + qi) * D + 512 + h * 128 + part * 32;
            const float* gp = CIN(I_SUBG) + e * 128 + part * 32;
#pragma unroll
            for (int d = 0; d < 32; d += 8) { u32x4 w; w.x = cvt_pk_bf16(o[d] * sc * gp[d], o[d + 1] * sc * gp[d + 1]); w.y = cvt_pk_bf16(o[d + 2] * sc * gp[d + 2], o[d + 3] * sc * gp[d + 3]);
                w.z = cvt_pk_bf16(o[d + 4] * sc * gp[d + 4], o[d + 5] * sc * gp[d + 5]); w.w = cvt_pk_bf16(o[d + 6] * sc * gp[d + 6], o[d + 7] * sc * gp[d + 7]); *(u32x4*)(op + d) = w; }
        }
    }
}
DEVI void ph_diff_combine(const Ctx& c, int e, int bid, int nb) {
    const int TIDX = tid_opaque();
    const bf16_t* OV = (const bf16_t*)(CWS + B_OV); bf16_t* CAT = (bf16_t*)(CWS + B_CAT);
    const int wave = TIDX >> 6, lane = TIDX & 63, hh = lane >> 4, i16 = lane & 15;
    const float lam = lam_of(c, e), li = lam_init_of(2 * e);
    const float* gp = CIN(I_SUBG) + e * 128 + 8 * i16;
    const f32x4 g0 = *GPTR(const f32x4, gp), g1 = *GPTR(const f32x4, gp + 4);
    const int vcol = (hh * 4 + (i16 >> 3)) * 64 + ((8 * i16) & 63);
    const int step = nb * 8;
    for (int row0 = bid * 8 + wave; row0 < MP; row0 += 4 * step) {
        u32x4 w0[4], w1[4];
#pragma unroll
        for (int j = 0; j < 4; ++j) { const int row = row0 + j * step;
            if (row < MP) { w0[j] = *GPTR(const u32x4, OV + (size_t)row * 1024 + vcol); w1[j] = *GPTR(const u32x4, OV + (size_t)row * 1024 + vcol + 128); } }
#pragma unroll
        for (int j = 0; j < 4; ++j) { const int row = row0 + j * step;
            if (row < MP) {
                f32x4 a0 = {bflo(w0[j].x) - lam * bflo(w1[j].x), bfhi(w0[j].x) - lam * bfhi(w1[j].x), bflo(w0[j].y) - lam * bflo(w1[j].y), bfhi(w0[j].y) - lam * bfhi(w1[j].y)};
                f32x4 a1 = {bflo(w0[j].z) - lam * bflo(w1[j].z), bfhi(w0[j].z) - lam * bfhi(w1[j].z), bflo(w0[j].w) - lam * bflo(w1[j].w), bfhi(w0[j].w) - lam * bfhi(w1[j].w)};
                float ss = ((a0[0] * a0[0] + a0[1] * a0[1]) + (a0[2] * a0[2] + a0[3] * a0[3])) + ((a1[0] * a1[0] + a1[1] * a1[1]) + (a1[2] * a1[2] + a1[3] * a1[3]));
                ss += __shfl_xor(ss, 1, 64); ss += __shfl_xor(ss, 2, 64); ss += __shfl_xor(ss, 4, 64); ss += __shfl_xor(ss, 8, 64);
                const float sc = rsqrtf(ss * (1.f / 128.f) + NORM_EPS) * (1.f - li);
                a0 = a0 * g0 * sc; a1 = a1 * g1 * sc;
                *GPTR(u32x4, CAT + (size_t)row * D + 512 + hh * 128 + 8 * i16) = pack8(a0, a1); } }
    }
}
DEVI void ph_diffattn_sample(const Ctx& c, int e, LAS float* L, int bid, int nb) {
    const int tid = tid_opaque(), wave = __builtin_amdgcn_readfirstlane(tid >> 6), lane = tid & 63, i15 = lane & 15, kq = lane >> 4;
    const bf16_t* QB = (const bf16_t*)(CWS + B_QB);
    float* PART = (float*)(CWS + B_DPART);
    const float C2 = 0.125f * 1.4426950408889634f;
    for (int unit = bid; unit < 256; unit += nb) {
        const int half = unit & 1, bh = unit >> 1, b = bh >> 2, h = bh & 3;
        const float* Kc = CIN(I_CDK) + ((size_t)(e * NBS + b) * PAST) * 512 + h * 128;
        const float* Vc = CIN(I_CDV) + ((size_t)(e * NBS + b) * PAST) * 512 + h * 128;
        bf16x8 qf[2][2];
#pragma unroll
        for (int mp = 0; mp < 2; ++mp)
#pragma unroll
            for (int s2 = 0; s2 < 2; ++s2) {
                const u32x4 w = *GPTR(const u32x4, QB + (size_t)(MP + b * TS + i15) * 512 + h * 128 + mp * 64 + 32 * s2 + 8 * kq);
                const f32x4 a = {bflo(w.x) * C2, bfhi(w.x) * C2, bflo(w.y) * C2, bfhi(w.y) * C2}, bq = {bflo(w.z) * C2, bfhi(w.z) * C2, bflo(w.w) * C2, bfhi(w.w) * C2};
                qf[mp][s2] = __builtin_bit_cast(bf16x8, pack8(a, bq));
            }
        float mx[2] = {-1e30f, -1e30f}, ls[2] = {0.f, 0.f};
        f32x4 o[2][8];
#pragma unroll
        for (int mp = 0; mp < 2; ++mp)
#pragma unroll
            for (int db = 0; db < 8; ++db) o[mp][db] = (f32x4){0.f, 0.f, 0.f, 0.f};
        const int key0 = half * 2048 + wave * 256;
        const int ngrp = (half == 1 && wave == 7) ? 9 : 8;
        const float* Kn = COUT + O_SDK + ((size_t)e * MS + b * TS) * 512 + h * 128;
        const float* Vn = COUT + O_SDV + ((size_t)e * MS + b * TS) * 512 + h * 128;
        for (int g = 0; g < ngrp; ++g) {
            const bool newk = g == 8;
            const float* kb = (newk ? Kn : Kc + (size_t)(key0 + g * 32) * 512) + (size_t)i15 * 512 + 8 * kq;
            const float* vb = (newk ? Vn : Vc + (size_t)(key0 + g * 32) * 512) + (size_t)(4 * kq) * 512 + i15;
            f32x4 sc[2][2];
            float vr[4][8];
            {
                f32x4 kr[2][2][2][2];
#pragma unroll
                for (int mp = 0; mp < 2; ++mp)
#pragma unroll
                    for (int bl = 0; bl < 2; ++bl)
#pragma unroll
                        for (int s2 = 0; s2 < 2; ++s2) { const float* p = kb + (size_t)bl * 16 * 512 + mp * 64 + 32 * s2; kr[mp][bl][s2][0] = *GPTR(const f32x4, p); kr[mp][bl][s2][1] = *GPTR(const f32x4, p + 4); }
#pragma unroll
                for (int db = 0; db < 4; ++db)
#pragma unroll
                    for (int j = 0; j < 8; ++j) vr[db][j] = *GPTR(const float, vb + (size_t)((j < 4 ? 0 : 16) + (j & 3)) * 512 + db * 16);
#pragma unroll
                for (int mp = 0; mp < 2; ++mp)
#pragma unroll
                    for (int bl = 0; bl < 2; ++bl) {
                        f32x4 a = {0.f, 0.f, 0.f, 0.f};
#pragma unroll
                        for (int s2 = 0; s2 < 2; ++s2) a = __builtin_amdgcn_mfma_f32_16x16x32_bf16(__builtin_bit_cast(bf16x8, pack8(kr[mp][bl][s2][0], kr[mp][bl][s2][1])), qf[mp][s2], a, 0, 0, 0);
                        sc[mp][bl] = a;
                    }
            }
            if (newk) { sc[0][1] = (f32x4){-1e30f, -1e30f, -1e30f, -1e30f}; sc[1][1] = sc[0][1]; }
            asm volatile("" ::: "memory");
            float vr2[4][8];
#pragma unroll
            for (int db = 0; db < 4; ++db)
#pragma unroll
                for (int j = 0; j < 8; ++j) vr2[db][j] = *GPTR(const float, vb + (size_t)((j < 4 ? 0 : 16) + (j & 3)) * 512 + (db + 4) * 16);
            bf16x8 pf[2];
#pragma unroll
            for (int mp = 0; mp < 2; ++mp) {
                float tm = fmaxf(fmaxf(fmaxf(sc[mp][0][0], sc[mp][0][1]), fmaxf(sc[mp][0][2], sc[mp][0][3])), fmaxf(fmaxf(sc[mp][1][0], sc[mp][1][1]), fmaxf(sc[mp][1][2], sc[mp][1][3])));
                tm = fmaxf(tm, __shfl_xor(tm, 16, 64)); tm = fmaxf(tm, __shfl_xor(tm, 32, 64));
                const float mn = fmaxf(mx[mp], tm), al = __builtin_amdgcn_exp2f(mx[mp] - mn);
                f32x4 p0, p1;
#pragma unroll
                for (int r = 0; r < 4; ++r) { p0[r] = __builtin_amdgcn_exp2f(sc[mp][0][r] - mn); p1[r] = __builtin_amdgcn_exp2f(sc[mp][1][r] - mn); }
                ls[mp] = ls[mp] * al + ((p0[0] + p0[1]) + (p0[2] + p0[3])) + ((p1[0] + p1[1]) + (p1[2] + p1[3]));
                mx[mp] = mn;
                pf[mp] = __builtin_bit_cast(bf16x8, pack8(p0, p1));
#pragma unroll
                for (int db = 0; db < 8; ++db) o[mp][db] *= al;
            }
#pragma unroll
            for (int db = 0; db < 4; ++db) {
                const f32x4 a = {vr[db][0], vr[db][1], vr[db][2], vr[db][3]}, bq = {vr[db][4], vr[db][5], vr[db][6], vr[db][7]}; const bf16x8 vf = __builtin_bit_cast(bf16x8, pack8(a, bq));
                o[0][db] = __builtin_amdgcn_mfma_f32_16x16x32_bf16(vf, pf[0], o[0][db], 0, 0, 0);
                o[1][db] = __builtin_amdgcn_mfma_f32_16x16x32_bf16(vf, pf[1], o[1][db], 0, 0, 0);
            }
#pragma unroll
            for (int db = 0; db < 4; ++db) {
                const f32x4 a = {vr2[db][0], vr2[db][1], vr2[db][2], vr2[db][3]}, bq = {vr2[db][4], vr2[db][5], vr2[db][6], vr2[db][7]}; const bf16x8 vf = __builtin_bit_cast(bf16x8, pack8(a, bq));
                o[0][db + 4] = __builtin_amdgcn_mfma_f32_16x16x32_bf16(vf, pf[0], o[0][db + 4], 0, 0, 0);
                o[1][db + 4] = __builtin_amdgcn_mfma_f32_16x16x32_bf16(vf, pf[1], o[1][db + 4], 0, 0, 0);
            }
        }
#pragma unroll
        for (int mp = 0; mp < 2; ++mp) {
            float lt = ls[mp]; lt += __shfl_xor(lt, 16, 64); lt += __shfl_xor(lt, 32, 64);
            __syncthreads();
            LAS float* wq = L + (wave * 16 + i15) * 132;
#pragma unroll
            for (int db = 0; db < 8; ++db) *(LAS f32x4*)(wq + db * 16 + 4 * kq) = o[mp][db];
            if (kq == 0) { wq[128] = mx[mp]; wq[129] = lt; }
            __syncthreads();
            {
                const int q = tid >> 5, d4 = (tid & 31) * 4;
                float M_ = -1e30f;
#pragma unroll
                for (int w = 0; w < 8; ++w) M_ = fmaxf(M_, L[(w * 16 + q) * 132 + 128]);
                float Ls = 0.f; f32x4 acc = {0.f, 0.f, 0.f, 0.f};
#pragma unroll
                for (int w = 0; w < 8; ++w) { const float f = __builtin_amdgcn_exp2f(L[(w * 16 + q) * 132 + 128] - M_); Ls += L[(w * 16 + q) * 132 + 129] * f; acc += *(const LAS f32x4*)(L + (w * 16 + q) * 132 + d4) * f; }
                float* po = PART + ((size_t)((bh * 2 + half) * 2 + mp) * 16 + q) * 132;
                *GPTR(f32x4, po + d4) = acc;
                if ((tid & 31) == 0) { po[128] = M_; po[129] = Ls; }
            }
        }
        __syncthreads();
    }
}
DEVI void ph_diff_combine_sample(const Ctx& c, int e, int bid, int nb) {
    const int TIDX = tid_opaque();
    const float* PART = (const float*)(CWS + B_DPART); bf16_t* CAT = (bf16_t*)(CWS + B_CAT);
    const int wave = TIDX >> 6, lane = TIDX & 63;
    const float lam = lam_of(c, e), li = lam_init_of(2 * e);
    const float* gp = CIN(I_SUBG) + e * 128;
    const float g0 = gp[2 * lane], g1 = gp[2 * lane + 1];
    for (int it = bid * 8 + wave; it < 128 * 16; it += nb * 8) {
        const int bh = it >> 4, q = it & 15, b = bh >> 2, h = bh & 3;
        float a0 = 0.f, a1 = 0.f;
#pragma unroll
        for (int mp = 0; mp < 2; ++mp) {
            const float* p0 = PART + ((size_t)((bh * 2 + 0) * 2 + mp) * 16 + q) * 132; const float* p1 = PART + ((size_t)((bh * 2 + 1) * 2 + mp) * 16 + q) * 132;
            const float m0 = p0[128], m1 = p1[128], mm = fmaxf(m0, m1), f0 = __builtin_amdgcn_exp2f(m0 - mm), f1 = __builtin_amdgcn_exp2f(m1 - mm);
            const float inv = 1.f / (p0[129] * f0 + p1[129] * f1);
            const float x0 = (p0[2 * lane] * f0 + p1[2 * lane] * f1) * inv, x1 = (p0[2 * lane + 1] * f0 + p1[2 * lane + 1] * f1) * inv;
            if (mp == 0) { a0 = x0; a1 = x1; } else { a0 -= lam * x0; a1 -= lam * x1; }
        }
        const float ss = wave_sum(a0 * a0 + a1 * a1);
        const float sc = rsqrtf(ss * (1.f / 128.f) + NORM_EPS) * (1.f - li);
        *(unsigned*)(CAT + (size_t)(MP + b * TS + q) * D + 512 + h * 128 + 2 * lane) = cvt_pk_bf16(a0 * sc * g0, a1 * sc * g1);
    }
}
DEVI void ph_shiftmix(const Ctx& c, int l, int bid, int nb) {
    const int TIDX = tid_opaque();
    const int o = l >> 1;
    const bf16_t* X = (const bf16_t*)(CWS + B_XB); const float* rowss = (const float*)(CWS + B_ROWP) + (size_t)(3 * l) * ROWP_N; bf16_t* XM = (bf16_t*)(CWS + B_XM);
    const float* mu = CIN(I_MU) + (size_t)o * 6 * D; const float* gn = CIN(I_NMIX) + l * D;
    const unsigned total = (unsigned)M * 128u;
    for (unsigned idx = (unsigned)bid * NT + TIDX; idx < total; idx += (unsigned)nb * NT) {
        const int row = (int)(idx >> 7), col = (int)(idx & 127) * 8;
        const bool prompt = row < MP;
        const int b = prompt ? row / TP : (row - MP) / TS, t = prompt ? row % TP : (row - MP) % TS;
        const f32x4 g0 = *GPTR(const f32x4, gn + col), g1 = *GPTR(const f32x4, gn + col + 4);
        const float s = pg8::rs_of(rowss, row);
        const u32x4 xw = *GPTR(const u32x4, X + (size_t)row * D + col);
        const f32x4 h0 = (f32x4){bflo(xw.x), bfhi(xw.x), bflo(xw.y), bfhi(xw.y)} * s * g0, h1 = (f32x4){bflo(xw.z), bfhi(xw.z), bflo(xw.w), bfhi(xw.w)} * s * g1;
        f32x4 p0 = {0.f, 0.f, 0.f, 0.f}, p1 = p0;
        if (t > 0) { const float s1 = pg8::rs_of(rowss, row - 1); const u32x4 pw = *GPTR(const u32x4, X + (size_t)(row - 1) * D + col);
            p0 = (f32x4){bflo(pw.x), bfhi(pw.x), bflo(pw.y), bfhi(pw.y)} * s1 * g0; p1 = (f32x4){bflo(pw.z), bfhi(pw.z), bflo(pw.w), bfhi(pw.w)} * s1 * g1; }
        else if (!prompt) { const float* sp = CIN(I_SSHIFT) + ((size_t)o * NBS + b) * D + col; p0 = *GPTR(const f32x4, sp); p1 = *GPTR(const f32x4, sp + 4); }
        const f32x4 d0 = p0 - h0, d1 = p1 - h1;
#pragma unroll
        for (int i = 0; i < 6; ++i) {
            const f32x4 m0 = *GPTR(const f32x4, mu + i * D + col), m1 = *GPTR(const f32x4, mu + i * D + col + 4);
            *GPTR(u32x4, XM + (size_t)i * M * D + (size_t)row * D + col) = pack8(h0 + d0 * m0, h1 + d1 * m1);
        }
        if (prompt) { if (t == TP - 1) { float* op = COUT + O_PSHIFT + ((size_t)o * NBP + b) * D + col; *GPTR(f32x4, op) = h0; *GPTR(f32x4, op + 4) = h1; } }
        else { if (t == TS - 1) { float* op = COUT + O_SSHIFT + ((size_t)o * NBS + b) * D + col; *GPTR(f32x4, op) = h0; *GPTR(f32x4, op + 4) = h1; } }
    }
}
DEVI float sum16(float v) { v += __shfl_xor(v, 1, 64); v += __shfl_xor(v, 2, 64); v += __shfl_xor(v, 4, 64); v += __shfl_xor(v, 8, 64); return v; }
DEVI void ph_rw_prep(const Ctx& c, int o, int bid, int nb) {
    const int TIDX = tid_opaque();
    bf16_t* K = (bf16_t*)(CWS + B_K); bf16_t* V = (bf16_t*)(CWS + B_V); const bf16_t* W = (const bf16_t*)(CWS + B_W); const bf16_t* A = (const bf16_t*)(CWS + B_A); bf16_t* VF = (bf16_t*)(CWS + B_VF); const bf16_t* VG = (const bf16_t*)(CWS + B_VG);
    float* SMP = (float*)(CWS + B_SMP);
    const int wave = TIDX >> 6, lane = TIDX & 63;
    const float* w0p = CIN(I_W0) + o * D; const float* a0p = CIN(I_A0) + o * D; const float* v0p = CIN(I_V0) + (o > 0 ? o - 1 : 0) * D; const float* kkp = CIN(I_KK) + o * D; const float* kap = CIN(I_KA) + o * D;
    const int items = MS * 4;
    for (int it = bid * 8 + wave; it < items; it += nb * 8) {
        const int row = MP + (it >> 2), col = (it & 3) * 256 + lane * 4; const size_t base = (size_t)row * D + col, sb = (size_t)(it >> 2) * D + col;
        const f32x4 wl = ld4bf(W + base), al = ld4bf(A + base), kl = ld4bf(K + base); f32x4 vl = ld4bf(V + base);
        const f32x4 w0 = *GPTR(const f32x4, w0p + col), a0 = *GPTR(const f32x4, a0p + col), kk0 = *GPTR(const f32x4, kkp + col), ka0 = *GPTR(const f32x4, kap + col);
        f32x4 lw, av, kk, k2;
        if (o > 0) {
            const f32x4 vf = ld4bf(VF + base), vg = ld4bf(VG + base), v0 = *GPTR(const f32x4, v0p + col);
#pragma unroll
            for (int i = 0; i < 4; ++i) vl[i] = vl[i] + (vf[i] - vl[i]) * sigmoidf_(v0[i] + vg[i]);
        } else st4bf(VF + base, vl);
        float n2 = 0.f;
#pragma unroll
        for (int i = 0; i < 4; ++i) {
            const float x = -(w0[i] + wl[i]); const float sp = softplusf_(x);
            lw[i] = -__expf(-sp - 0.5f);
            av[i] = sigmoidf_(a0[i] + al[i]);
            kk[i] = kl[i] * kk0[i]; n2 += kk[i] * kk[i];
            k2[i] = kl[i] * (1.f + (av[i] - 1.f) * ka0[i]);
        }
        const float inv = 1.f / fmaxf(sqrtf(sum16(n2)), 1e-12f);
        kk *= inv;
        *GPTR(f32x4, SMP + 0 * SMPN + sb) = lw; *GPTR(f32x4, SMP + 1 * SMPN + sb) = av; *GPTR(f32x4, SMP + 2 * SMPN + sb) = kk; *GPTR(f32x4, SMP + 3 * SMPN + sb) = k2; *GPTR(f32x4, SMP + 4 * SMPN + sb) = vl;
        st4bf(K + base, k2); st4bf(V + base, vl);
    }
}
DEVI void ph_rw_scan(const Ctx& c, int o, int bid, int nb, LAS float* L) {
    const int TIDX = tid_opaque();
    const bf16_t* R = (const bf16_t*)(CWS + B_R); const float* SMP = (const float*)(CWS + B_SMP); bf16_t* Y = (bf16_t*)(CWS + B_Y);
    const float* W = SMP; const float* A = SMP + SMPN; const float* KKb = SMP + 2 * SMPN; const float* K = SMP + 3 * SMPN; const float* V = SMP + 4 * SMPN;
    const int wave = __builtin_amdgcn_readfirstlane(TIDX >> 6), lane = TIDX & 63, grp = wave >> 2, w4 = wave & 3, k0 = 16 * w4;
    LAS float* red = L + grp * 256;
    LAS float* yred = L + 1024 + grp * 256;
#define RL(x, k_) __builtin_bit_cast(float, __builtin_amdgcn_readlane(__builtin_bit_cast(int, (x)), (k_)))
    for (int it0 = bid; it0 < NBS * 16; it0 += 2 * nb) {
        const int it = it0 + grp * nb; const bool act = it < NBS * 16; const int itc = act ? it : it0;
        const int b = itc >> 4, h = itc & 15, row0 = MP + b * TS;
        float S[16];
        {
            const float* sp = CIN(I_SWKV) + (((size_t)(o * NBS + b) * 16 + h) * 64 + lane) * 64 + k0;
#pragma unroll
            for (int k = 0; k < 16; k += 4) { const f32x4 v = *GPTR(const f32x4, sp + k); S[k] = v[0]; S[k + 1] = v[1]; S[k + 2] = v[2]; S[k + 3] = v[3]; }
        }
        const size_t base0 = (size_t)row0 * D + h * 64 + lane, sbase0 = (size_t)(b * TS) * D + h * 64 + lane;
        float pr[TS], pd[TS], pk[TS], pkk[TS], pab[TS], pv[TS];
#pragma unroll
        for (int t = 0; t < TS; ++t) { const size_t bb = base0 + (size_t)t * D, sb = sbase0 + (size_t)t * D;
            pr[t] = bf2f(R[bb]); pd[t] = W[sb]; pk[t] = K[sb]; pkk[t] = KKb[sb]; pab[t] = A[sb]; pv[t] = V[sb]; }
#pragma unroll
        for (int t = 0; t < TS; ++t) { pd[t] = __expf(pd[t]); pab[t] = pkk[t] * pab[t]; }
        {
            float s0 = 0.f, s1 = 0.f;
#pragma unroll
            for (int k = 0; k < 16; k += 2) { s0 = fmaf(S[k], RL(pkk[0], k0 + k), s0); s1 = fmaf(S[k + 1], RL(pkk[0], k0 + k + 1), s1); }
            red[w4 * 64 + lane] = s0 + s1;
        }
        __syncthreads();
#pragma unroll
        for (int t = 0; t < TS; ++t) {
            const int slot = (t & 1) * 512;
            const float sa = -((red[slot + lane] + red[slot + 64 + lane]) + (red[slot + 128 + lane] + red[slot + 192 + lane]));
            const float vj = pv[t];
            float y0 = 0.f, y1 = 0.f;
#pragma unroll
            for (int k = 0; k < 16; k += 2) {
                S[k] = fmaf(S[k], RL(pd[t], k0 + k), fmaf(sa, RL(pab[t], k0 + k), vj * RL(pk[t], k0 + k))); y0 = fmaf(S[k], RL(pr[t], k0 + k), y0);
                S[k + 1] = fmaf(S[k + 1], RL(pd[t], k0 + k + 1), fmaf(sa, RL(pab[t], k0 + k + 1), vj * RL(pk[t], k0 + k + 1))); y1 = fmaf(S[k + 1], RL(pr[t], k0 + k + 1), y1);
            }
            yred[slot + w4 * 64 + lane] = y0 + y1;
            if (t + 1 < TS) {
                float s0 = 0.f, s1 = 0.f;
#pragma unroll
                for (int k = 0; k < 16; k += 2) { s0 = fmaf(S[k], RL(pkk[t + 1 < TS ? t + 1 : t], k0 + k), s0); s1 = fmaf(S[k + 1], RL(pkk[t + 1 < TS ? t + 1 : t], k0 + k + 1), s1); }
                red[(512 - slot) + w4 * 64 + lane] = s0 + s1;
            }
            __syncthreads();
            if (w4 == 0 && act) Y[base0 + (size_t)t * D] = (bf16_t)(cvt_pk_bf16((yred[slot + lane] + yred[slot + 64 + lane]) + (yred[slot + 128 + lane] + yred[slot + 192 + lane]), 0.f) & 0xffffu);
        }
        if (act) {
            float* op = COUT + O_SWKV + (((size_t)(o * NBS + b) * 16 + h) * 64 + lane) * 64 + k0;
#pragma unroll
            for (int k = 0; k < 16; k += 4) *GPTR(f32x4, op + k) = (f32x4){S[k], S[k + 1], S[k + 2], S[k + 3]};
        }
        __syncthreads();
    }
#undef RL
}
DEVI void ph_rw_post(const Ctx& c, int o, int bid, int nb) {
    const int TIDX = tid_opaque();
    const bf16_t* R = (const bf16_t*)(CWS + B_R); const bf16_t* K = (const bf16_t*)(CWS + B_K); const bf16_t* V = (const bf16_t*)(CWS + B_V); const bf16_t* G = (const bf16_t*)(CWS + B_G); const bf16_t* Y = (const bf16_t*)(CWS + B_Y); bf16_t* YG = (bf16_t*)(CWS + B_YG);
    const int wave = TIDX >> 6, lane = TIDX & 63;
    const float* lgp = CIN(I_LNG) + o * D; const float* lbp = CIN(I_LNB) + o * D; const float* rkp = CIN(I_RK) + o * D;
    const int items = M * 4;
    for (int it = bid * 8 + wave; it < items; it += nb * 8) {
        const int row = it >> 2, col = (it & 3) * 256 + lane * 4; const size_t base = (size_t)row * D + col;
        f32x4 y = ld4bf(Y + base); const f32x4 r = ld4bf(R + base), k = ld4bf(K + base), v = ld4bf(V + base), g = ld4bf(G + base);
        if (row < MP) y += ld4bf((const bf16_t*)(CWS + B_YL) + base);
        const f32x4 lg = *GPTR(const f32x4, lgp + col), lb = *GPTR(const f32x4, lbp + col), rk = *GPTR(const f32x4, rkp + col);
        const float mean = sum16((y[0] + y[1]) + (y[2] + y[3])) * (1.f / 64.f);
        const f32x4 dl = y - mean;
        const float var = sum16((dl[0] * dl[0] + dl[1] * dl[1]) + (dl[2] * dl[2] + dl[3] * dl[3])) * (1.f / 64.f);
        const float rstd = rsqrtf(var + RW_LN_EPS);
        const float bon = sum16((r[0] * k[0] * rk[0] + r[1] * k[1] * rk[1]) + (r[2] * k[2] * rk[2] + r[3] * k[3] * rk[3]));
        f32x4 ov;
#pragma unroll
        for (int i = 0; i < 4; ++i) ov[i] = (dl[i] * rstd * lg[i] + lb[i] + bon * v[i]) * g[i];
        u32x2 w; w.x = cvt_pk_bf16(ov[0], ov[1]); w.y = cvt_pk_bf16(ov[2], ov[3]);
        *GPTR(u32x2, YG + base) = w;
    }
}
DEVI void ph_softmax256(const Ctx& c, int bid, int nb) {
    const int TIDX = tid_opaque();
    const float* S = (const float*)(CWS + B_S); bf16_t* P = (bf16_t*)(CWS + B_P);
    const int wave = TIDX >> 6, lane = TIDX & 63;
    const int items = MP * 4;
    for (int it = bid * 8 + wave; it < items; it += nb * 8) {
        float4 v = *((const float4*)(S + (size_t)it * 256) + lane); v.x *= 0.0625f; v.y *= 0.0625f; v.z *= 0.0625f; v.w *= 0.0625f;
        float mx = fmaxf(fmaxf(v.x, v.y), fmaxf(v.z, v.w));
#pragma unroll
        for (int o = 32; o > 0; o >>= 1) mx = fmaxf(mx, __shfl_xor(mx, o, 64));
        v.x = __expf(v.x - mx); v.y = __expf(v.y - mx); v.z = __expf(v.z - mx); v.w = __expf(v.w - mx);
        const float inv = 1.f / wave_sum(v.x + v.y + v.z + v.w);
        u32x2 w; w.x = cvt_pk_bf16(v.x * inv, v.y * inv); w.y = cvt_pk_bf16(v.z * inv, v.w * inv);
        *((u32x2*)(P + (size_t)it * 256) + lane) = w;
    }
}
DEVI void ph_xattn_sample(const Ctx& c, int l, LAS float* L, int bid, int nb) {
    const int tid = tid_opaque(), wave = __builtin_amdgcn_readfirstlane(tid >> 6), lane = tid & 63, i15 = lane & 15, kq = lane >> 4;
    const bf16_t* Q = (const bf16_t*)(CWS + B_Q); bf16_t* O = (bf16_t*)(CWS + B_O);
    LAS float* rmax = L; LAS float* rsum = L + 128;
    LAS bf16_t* Pl = (LAS bf16_t*)(L + 256);
    constexpr int PP = 264;
    const float C2 = 0.0625f * 1.4426950408889634f;
    for (int item = bid; item < NBS * 4; item += nb) {
        const int b = item >> 2, h = item & 3;
        const float* Kc = CIN(I_CMK) + ((size_t)(l * NBS + b) * NMEM) * D + h * 256; const float* Vc = CIN(I_CMV) + ((size_t)(l * NBS + b) * NMEM) * D + h * 256;
        bf16x8 qf[8];
#pragma unroll
        for (int s2 = 0; s2 < 8; ++s2) {
            const u32x4 w = *GPTR(const u32x4, Q + (size_t)(MP + b * TS + i15) * D + h * 256 + 32 * s2 + 8 * kq);
            const f32x4 a = {bflo(w.x) * C2, bfhi(w.x) * C2, bflo(w.y) * C2, bfhi(w.y) * C2}, bq = {bflo(w.z) * C2, bfhi(w.z) * C2, bflo(w.w) * C2, bfhi(w.w) * C2};
            qf[s2] = __builtin_bit_cast(bf16x8, pack8(a, bq));
        }
        f32x4 sc[2];
#pragma unroll
        for (int bl = 0; bl < 2; ++bl) {
            const float* kb = Kc + (size_t)(32 * wave + 16 * bl + i15) * D + 8 * kq;
            f32x4 kr[8][2];
#pragma unroll
            for (int s2 = 0; s2 < 8; ++s2) { kr[s2][0] = *GPTR(const f32x4, kb + 32 * s2); kr[s2][1] = *GPTR(const f32x4, kb + 32 * s2 + 4); }
            f32x4 a = {0.f, 0.f, 0.f, 0.f};
#pragma unroll
            for (int s2 = 0; s2 < 8; ++s2) a = __builtin_amdgcn_mfma_f32_16x16x32_bf16(__builtin_bit_cast(bf16x8, pack8(kr[s2][0], kr[s2][1])), qf[s2], a, 0, 0, 0);
            sc[bl] = a;
        }
        float tm = fmaxf(fmaxf(fmaxf(sc[0][0], sc[0][1]), fmaxf(sc[0][2], sc[0][3])), fmaxf(fmaxf(sc[1][0], sc[1][1]), fmaxf(sc[1][2], sc[1][3])));
        tm = fmaxf(tm, __shfl_xor(tm, 16, 64)); tm = fmaxf(tm, __shfl_xor(tm, 32, 64));
        __syncthreads();
        if (kq == 0) rmax[wave * 16 + i15] = tm;
        __syncthreads();
        float M_ = rmax[i15];
#pragma unroll
        for (int w = 1; w < 8; ++w) M_ = fmaxf(M_, rmax[w * 16 + i15]);
        f32x4 p0, p1;
#pragma unroll
        for (int r = 0; r < 4; ++r) { p0[r] = __builtin_amdgcn_exp2f(sc[0][r] - M_); p1[r] = __builtin_amdgcn_exp2f(sc[1][r] - M_); }
        float lt = ((p0[0] + p0[1]) + (p0[2] + p0[3])) + ((p1[0] + p1[1]) + (p1[2] + p1[3]));
        lt += __shfl_xor(lt, 16, 64); lt += __shfl_xor(lt, 32, 64);
        if (kq == 0) rsum[wave * 16 + i15] = lt;
        { u32x2 w0; w0.x = cvt_pk_bf16(p0[0], p0[1]); w0.y = cvt_pk_bf16(p0[2], p0[3]); *(LAS u32x2*)(Pl + i15 * PP + 32 * wave + 4 * kq) = w0;
          u32x2 w1; w1.x = cvt_pk_bf16(p1[0], p1[1]); w1.y = cvt_pk_bf16(p1[2], p1[3]); *(LAS u32x2*)(Pl + i15 * PP + 32 * wave + 16 + 4 * kq) = w1; }
        __syncthreads();
        float Ls = rsum[i15];
#pragma unroll
        for (int w = 1; w < 8; ++w) Ls += rsum[w * 16 + i15];
        const float inv = 1.f / Ls;
        f32x4 o[2] = {{0.f, 0.f, 0.f, 0.f}, {0.f, 0.f, 0.f, 0.f}};
#pragma unroll
        for (int g = 0; g < 8; ++g) {
            const bf16x8 pf = __builtin_bit_cast(bf16x8, *(const LAS u32x4*)(Pl + i15 * PP + 32 * g + 8 * kq));
#pragma unroll
            for (int db = 0; db < 2; ++db) {
                const float* vb = Vc + (size_t)(32 * g + 8 * kq) * D + (2 * wave + db) * 16 + i15;
                f32x4 a, bq;
#pragma unroll
                for (int j = 0; j < 4; ++j) { a[j] = *GPTR(const float, vb + (size_t)j * D); bq[j] = *GPTR(const float, vb + (size_t)(j + 4) * D); }
                o[db] = __builtin_amdgcn_mfma_f32_16x16x32_bf16(__builtin_bit_cast(bf16x8, pack8(a, bq)), pf, o[db], 0, 0, 0);
            }
        }
#pragma unroll
        for (int db = 0; db < 2; ++db) {
            const f32x4 v = o[db] * inv; u32x2 w; w.x = cvt_pk_bf16(v[0], v[1]); w.y = cvt_pk_bf16(v[2], v[3]);
            *GPTR(u32x2, O + (size_t)(MP + b * TS + i15) * D + h * 256 + (2 * wave + db) * 16 + 4 * kq) = w;
        }
    }
}
DEVI void ph_final(const Ctx& c, int bid, int nb) {
    const int TIDX = tid_opaque();
    const bf16_t* X = (const bf16_t*)(CWS + B_XB); const float* rowss = (const float*)(CWS + B_ROWP) + (size_t)12 * ROWP_N; const float* g = CIN(I_NFIN);
    const int wave = TIDX >> 6, lane = TIDX & 63, step = nb * 8;
    f32x4 g4[4];
#pragma unroll
    for (int i = 0; i < 4; ++i) g4[i] = *GPTR(const f32x4, g + 4 * (lane + 64 * i));
    for (int r0 = bid * 8 + wave; r0 < M; r0 += 3 * step) {
        u32x2 xw[3][4]; float sc[3];
#pragma unroll
        for (int j = 0; j < 3; ++j) { const int r = r0 + j * step;
            if (r < M) { sc[j] = pg8::rs_of(rowss, r);
#pragma unroll
                for (int i = 0; i < 4; ++i) xw[j][i] = *GPTR(const u32x2, X + (size_t)r * D + 4 * (lane + 64 * i)); } }
#pragma unroll
        for (int j = 0; j < 3; ++j) { const int r = r0 + j * step;
            if (r < M) {
#pragma unroll
                for (int i = 0; i < 4; ++i) *GPTR(f32x4, COUT + O_YP + (size_t)r * D + 4 * (lane + 64 * i)) = cv4bf(xw[j][i]) * sc[j] * g4[i]; } }
    }
}


namespace rwk {
typedef float f32x16 __attribute__((ext_vector_type(16)));
constexpr int LP = 68, IMGF = 64 * LP;
enum { G_AT = 0, G_RT, G_BT, G_KT, G_VV, G_MAB, G_MAK, G_MRK, N_IMG };
DEVI int crow(int r, int hi) { return (r & 3) + 8 * (r >> 2) + 4 * hi; }
DEVI bf16x8 frag_row(const LAS float* img, int row, int s, int hi) {
    const LAS float* p = img + row * LP + 16 * s + 8 * hi;
    const f32x4 a = *(const LAS f32x4*)p, b = *(const LAS f32x4*)(p + 4);
    return __builtin_bit_cast(bf16x8, pack8(a, b));
}
DEVI bf16x8 frag_col(const LAS float* img, int col, int s, int hi, float scale) {
    const LAS float* p = img + (16 * s + 8 * hi) * LP + col;
    f32x4 a, b;
    a[0] = p[0]; a[1] = p[LP]; a[2] = p[2 * LP]; a[3] = p[3 * LP]; b[0] = p[4 * LP]; b[1] = p[5 * LP]; b[2] = p[6 * LP]; b[3] = p[7 * LP];
    a *= scale; b *= scale;
    return __builtin_bit_cast(bf16x8, pack8(a, b));
}
#define LDS_BARRIER() asm volatile("s_waitcnt lgkmcnt(0)\n\ts_barrier" ::: "memory")
#define RWK_MMA(acc, Afr, Bfr) acc = __builtin_amdgcn_mfma_f32_32x32x16_bf16((Afr), (Bfr), acc, 0, 0, 0)

DEVI void sub_solve32(const LAS float* Mb, LAS float* ib) {
    float x[32];
#pragma unroll
    for (int tt = 0; tt < 32; ++tt) x[tt] = ib[tt * LP];
#define SUB_LOAD(buf, t_, n_) do { _Pragma("unroll") for (int j4 = 0; j4 < (n_); ++j4) buf[j4] = *(const LAS f32x4*)(Mb + (t_) * LP + 4 * j4); } while (0)
#define SUB_ACC(buf, t_, n_) do { _Pragma("unroll") for (int j4 = 0; j4 < (n_); ++j4) { const int jb = 4 * j4; \
        if (jb + 0 < (t_)) s0 = fmaf(buf[j4][0], x[jb + 0], s0); if (jb + 1 < (t_)) s1 = fmaf(buf[j4][1], x[jb + 1], s1); \
        if (jb + 2 < (t_)) s2 = fmaf(buf[j4][2], x[jb + 2], s2); if (jb + 3 < (t_)) s3 = fmaf(buf[j4][3], x[jb + 3], s3); } } while (0)
    f32x4 pa[8], pb[8]; float s0 = 0.f, s1 = 0.f, s2 = 0.f, s3 = 0.f;
    SUB_LOAD(pa, 1, 1);
    SUB_LOAD(pb, 2, 1); s0 = x[1]; s1 = 0.f; s2 = 0.f; s3 = 0.f; SUB_ACC(pa, 1, 1); x[1] = (s0 + s1) + (s2 + s3);
    SUB_LOAD(pa, 3, 1); s0 = x[2]; s1 = 0.f; s2 = 0.f; s3 = 0.f; SUB_ACC(pb, 2, 1); x[2] = (s0 + s1) + (s2 + s3);
    SUB_LOAD(pb, 4, 1); s0 = x[3]; s1 = 0.f; s2 = 0.f; s3 = 0.f; SUB_ACC(pa, 3, 1); x[3] = (s0 + s1) + (s2 + s3);
    SUB_LOAD(pa, 5, 2); s0 = x[4]; s1 = 0.f; s2 = 0.f; s3 = 0.f; SUB_ACC(pb, 4, 1); x[4] = (s0 + s1) + (s2 + s3);
    SUB_LOAD(pb, 6, 2); s0 = x[5]; s1 = 0.f; s2 = 0.f; s3 = 0.f; SUB_ACC(pa, 5, 2); x[5] = (s0 + s1) + (s2 + s3);
    SUB_LOAD(pa, 7, 2); s0 = x[6]; s1 = 0.f; s2 = 0.f; s3 = 0.f; SUB_ACC(pb, 6, 2); x[6] = (s0 + s1) + (s2 + s3);
    SUB_LOAD(pb, 8, 2); s0 = x[7]; s1 = 0.f; s2 = 0.f; s3 = 0.f; SUB_ACC(pa, 7, 2); x[7] = (s0 + s1) + (s2 + s3);
    SUB_LOAD(pa, 9, 3); s0 = x[8]; s1 = 0.f; s2 = 0.f; s3 = 0.f; SUB_ACC(pb, 8, 2); x[8] = (s0 + s1) + (s2 + s3);
    SUB_LOAD(pb, 10, 3); s0 = x[9]; s1 = 0.f; s2 = 0.f; s3 = 0.f; SUB_ACC(pa, 9, 3); x[9] = (s0 + s1) + (s2 + s3);
    SUB_LOAD(pa, 11, 3); s0 = x[10]; s1 = 0.f; s2 = 0.f; s3 = 0.f; SUB_ACC(pb, 10, 3); x[10] = (s0 + s1) + (s2 + s3);
    SUB_LOAD(pb, 12, 3); s0 = x[11]; s1 = 0.f; s2 = 0.f; s3 = 0.f; SUB_ACC(pa, 11, 3); x[11] = (s0 + s1) + (s2 + s3);
    SUB_LOAD(pa, 13, 4); s0 = x[12]; s1 = 0.f; s2 = 0.f; s3 = 0.f; SUB_ACC(pb, 12, 3); x[12] = (s0 + s1) + (s2 + s3);
    SUB_LOAD(pb, 14, 4); s0 = x[13]; s1 = 0.f; s2 = 0.f; s3 = 0.f; SUB_ACC(pa, 13, 4); x[13] = (s0 + s1) + (s2 + s3);
    SUB_LOAD(pa, 15, 4); s0 = x[14]; s1 = 0.f; s2 = 0.f; s3 = 0.f; SUB_ACC(pb, 14, 4); x[14] = (s0 + s1) + (s2 + s3);
    SUB_LOAD(pb, 16, 4); s0 = x[15]; s1 = 0.f; s2 = 0.f; s3 = 0.f; SUB_ACC(pa, 15, 4); x[15] = (s0 + s1) + (s2 + s3);
    SUB_LOAD(pa, 17, 5); s0 = x[16]; s1 = 0.f; s2 = 0.f; s3 = 0.f; SUB_ACC(pb, 16, 4); x[16] = (s0 + s1) + (s2 + s3);
    SUB_LOAD(pb, 18, 5); s0 = x[17]; s1 = 0.f; s2 = 0.f; s3 = 0.f; SUB_ACC(pa, 17, 5); x[17] = (s0 + s1) + (s2 + s3);
    SUB_LOAD(pa, 19, 5); s0 = x[18]; s1 = 0.f; s2 = 0.f; s3 = 0.f; SUB_ACC(pb, 18, 5); x[18] = (s0 + s1) + (s2 + s3);
    SUB_LOAD(pb, 20, 5); s0 = x[19]; s1 = 0.f; s2 = 0.f; s3 = 0.f; SUB_ACC(pa, 19, 5); x[19] = (s0 + s1) + (s2 + s3);
    SUB_LOAD(pa, 21, 6); s0 = x[20]; s1 = 0.f; s2 = 0.f; s3 = 0.f; SUB_ACC(pb, 20, 5); x[20] = (s0 + s1) + (s2 + s3);
    SUB_LOAD(pb, 22, 6); s0 = x[21]; s1 = 0.f; s2 = 0.f; s3 = 0.f; SUB_ACC(pa, 21, 6); x[21] = (s0 + s1) + (s2 + s3);
    SUB_LOAD(pa, 23, 6); s0 = x[22]; s1 = 0.f; s2 = 0.f; s3 = 0.f; SUB_ACC(pb, 22, 6); x[22] = (s0 + s1) + (s2 + s3);
    SUB_LOAD(pb, 24, 6); s0 = x[23]; s1 = 0.f; s2 = 0.f; s3 = 0.f; SUB_ACC(pa, 23, 6); x[23] = (s0 + s1) + (s2 + s3);
    SUB_LOAD(pa, 25, 7); s0 = x[24]; s1 = 0.f; s2 = 0.f; s3 = 0.f; SUB_ACC(pb, 24, 6); x[24] = (s0 + s1) + (s2 + s3);
    SUB_LOAD(pb, 26, 7); s0 = x[25]; s1 = 0.f; s2 = 0.f; s3 = 0.f; SUB_ACC(pa, 25, 7); x[25] = (s0 + s1) + (s2 + s3);
    SUB_LOAD(pa, 27, 7); s0 = x[26]; s1 = 0.f; s2 = 0.f; s3 = 0.f; SUB_ACC(pb, 26, 7); x[26] = (s0 + s1) + (s2 + s3);
    SUB_LOAD(pb, 28, 7); s0 = x[27]; s1 = 0.f; s2 = 0.f; s3 = 0.f; SUB_ACC(pa, 27, 7); x[27] = (s0 + s1) + (s2 + s3);
    SUB_LOAD(pa, 29, 8); s0 = x[28]; s1 = 0.f; s2 = 0.f; s3 = 0.f; SUB_ACC(pb, 28, 7); x[28] = (s0 + s1) + (s2 + s3);
    SUB_LOAD(pb, 30, 8); s0 = x[29]; s1 = 0.f; s2 = 0.f; s3 = 0.f; SUB_ACC(pa, 29, 8); x[29] = (s0 + s1) + (s2 + s3);
    SUB_LOAD(pa, 31, 8); s0 = x[30]; s1 = 0.f; s2 = 0.f; s3 = 0.f; SUB_ACC(pb, 30, 8); x[30] = (s0 + s1) + (s2 + s3);
    s0 = x[31]; s1 = 0.f; s2 = 0.f; s3 = 0.f; SUB_ACC(pa, 31, 8); x[31] = (s0 + s1) + (s2 + s3);
#undef SUB_LOAD
#undef SUB_ACC
#pragma unroll
    for (int tt = 0; tt < 32; ++tt) ib[tt * LP] = x[tt];
}

DEVI void phaseA(const Ctx& c, int o, LAS float* L, int bid, int nb) {
    const int tid0 = tid_opaque();
    const bf16_t* Rg = (const bf16_t*)(CWS + B_R); const bf16_t* LWg = (const bf16_t*)(CWS + B_W); const bf16_t* Kg = (const bf16_t*)(CWS + B_K); const bf16_t* Vg = (const bf16_t*)(CWS + B_V);
    const bf16_t* Ag = (const bf16_t*)(CWS + B_A);
    float* TC = (float*)(CWS + B_TC); float* UC = (float*)(CWS + B_UC); float* GH = (float*)(CWS + B_GH); bf16_t* Yg = (bf16_t*)(CWS + B_YL);
    LAS float* AT = L + G_AT * IMGF; LAS float* RT = L + G_RT * IMGF; LAS float* BT = L + G_BT * IMGF; LAS float* KT = L + G_KT * IMGF; LAS float* VV = L + G_VV * IMGF;
    LAS float* MAB = L + G_MAB * IMGF; LAS float* MAK = L + G_MAK * IMGF; LAS float* MRK = L + G_MRK * IMGF; LAS float* GL = L + N_IMG * IMGF;
    (void)o;
    for (int chunk = bid; chunk < 4096; chunk += nb) {
        int tid = tid0; asm volatile("" : "+v"(tid));
        const int wave = __builtin_amdgcn_readfirstlane(tid >> 6), lane = tid & 63, l31 = lane & 31, hi = lane >> 5;
        const int bh = chunk >> 6, cc = chunk & 63, b = bh >> 4, h = bh & 15;
        const size_t g0 = ((size_t)(b * TP + cc * 64)) * D + h * 64;
        const int t = tid >> 3, k8 = (tid & 7) * 8;
        const size_t go = g0 + (size_t)t * D + k8;
        LDS_BARRIER();
        f32x4 r0, r1, kx0, kx1, v0, v1, q0, q1, a0, a1;
        {
            const int col = h * 64 + k8;
            const f32x4 wl0 = ld4bf(LWg + go), wl1 = ld4bf(LWg + go + 4), al0 = ld4bf(Ag + go), al1 = ld4bf(Ag + go + 4);
            kx0 = ld4bf(Kg + go); kx1 = ld4bf(Kg + go + 4); v0 = ld4bf(Vg + go); v1 = ld4bf(Vg + go + 4);
            r0 = ld4bf(Rg + go); r1 = ld4bf(Rg + go + 4);
            const float* w0p = CIN(I_W0) + o * D + col; const float* a0p = CIN(I_A0) + o * D + col; const float* kkp = CIN(I_KK) + o * D + col; const float* kap = CIN(I_KA) + o * D + col;
            const f32x4 pw0 = *GPTR(const f32x4, w0p), pw1 = *GPTR(const f32x4, w0p + 4), pa0 = *GPTR(const f32x4, a0p), pa1 = *GPTR(const f32x4, a0p + 4);
            const f32x4 pk0 = *GPTR(const f32x4, kkp), pk1 = *GPTR(const f32x4, kkp + 4), pc0 = *GPTR(const f32x4, kap), pc1 = *GPTR(const f32x4, kap + 4);
            if (o > 0) {
                const bf16_t* VFg = (const bf16_t*)(CWS + B_VF); const bf16_t* VGg = (const bf16_t*)(CWS + B_VG); const float* v0p = CIN(I_V0) + (o - 1) * D + col;
                const f32x4 vf0 = ld4bf(VFg + go), vf1 = ld4bf(VFg + go + 4), vg0 = ld4bf(VGg + go), vg1 = ld4bf(VGg + go + 4), pv0 = *GPTR(const f32x4, v0p), pv1 = *GPTR(const f32x4, v0p + 4);
#pragma unroll
                for (int i = 0; i < 4; ++i) { v0[i] = v0[i] + (vf0[i] - v0[i]) * sigmoidf_(pv0[i] + vg0[i]); v1[i] = v1[i] + (vf1[i] - v1[i]) * sigmoidf_(pv1[i] + vg1[i]); }
            } else { bf16_t* VFw = (bf16_t*)(CWS + B_VF); *GPTR(u32x4, VFw + go) = pack8(v0, v1); }
            f32x4 lw0, lw1; float n2 = 0.f;
#pragma unroll
            for (int i = 0; i < 4; ++i) {
                const float x0 = -(pw0[i] + wl0[i]), x1 = -(pw1[i] + wl1[i]);
                const float sp0 = softplusf_(x0), sp1 = softplusf_(x1);
                lw0[i] = -__expf(-sp0 - 0.5f); lw1[i] = -__expf(-sp1 - 0.5f);
                a0[i] = sigmoidf_(pa0[i] + al0[i]); a1[i] = sigmoidf_(pa1[i] + al1[i]);
                q0[i] = kx0[i] * pk0[i]; q1[i] = kx1[i] * pk1[i]; n2 += q0[i] * q0[i] + q1[i] * q1[i];
                kx0[i] = kx0[i] * (1.f + (a0[i] - 1.f) * pc0[i]); kx1[i] = kx1[i] * (1.f + (a1[i] - 1.f) * pc1[i]);
            }
            n2 += __shfl_xor(n2, 1, 64); n2 += __shfl_xor(n2, 2, 64); n2 += __shfl_xor(n2, 4, 64);
            const float inv = fminf(__builtin_amdgcn_rsqf(n2), 1e12f);
            q0 *= inv; q1 *= inv;
            *(LAS f32x4*)(MAB + t * LP + k8) = lw0; *(LAS f32x4*)(MAB + t * LP + k8 + 4) = lw1;
            bf16_t* Kw = (bf16_t*)(CWS + B_K); bf16_t* Vw = (bf16_t*)(CWS + B_V);
            *GPTR(u32x4, Kw + go) = pack8(kx0, kx1); *GPTR(u32x4, Vw + go) = pack8(v0, v1);
        }
        LDS_BARRIER();
        if (tid < 64) { float run = 0.f;
#pragma unroll
            for (int hb = 0; hb < 2; ++hb) { float cv[32];
#pragma unroll
                for (int tt = 0; tt < 32; ++tt) cv[tt] = MAB[(hb * 32 + tt) * LP + tid];
#pragma unroll
                for (int tt = 0; tt < 32; ++tt) { run += cv[tt]; MAB[(hb * 32 + tt) * LP + tid] = run; } } }
        LDS_BARRIER();
        {
            const f32x4 c0 = *(const LAS f32x4*)(MAB + t * LP + k8), c1 = *(const LAS f32x4*)(MAB + t * LP + k8 + 4);
            f32x4 p0 = (f32x4){0.f, 0.f, 0.f, 0.f}, p1 = p0;
            if (t > 0) { p0 = *(const LAS f32x4*)(MAB + (t - 1) * LP + k8); p1 = *(const LAS f32x4*)(MAB + (t - 1) * LP + k8 + 4); }
            f32x4 at0, at1, rt0, rt1, bt0, bt1, kt0, kt1;
#pragma unroll
            for (int i = 0; i < 4; ++i) {
                const float e0 = __expf(c0[i]), e1 = __expf(c1[i]), i0 = __expf(-c0[i]), i1 = __expf(-c1[i]);
                at0[i] = -q0[i] * __expf(p0[i]); at1[i] = -q1[i] * __expf(p1[i]);
                rt0[i] = r0[i] * e0; rt1[i] = r1[i] * e1;
                bt0[i] = q0[i] * a0[i] * i0; bt1[i] = q1[i] * a1[i] * i1;
                kt0[i] = kx0[i] * i0; kt1[i] = kx1[i] * i1;
                if (t == 63) { GL[k8 + i] = e0; GL[k8 + 4 + i] = e1; }
            }
            *(LAS f32x4*)(AT + t * LP + k8) = at0; *(LAS f32x4*)(AT + t * LP + k8 + 4) = at1;
            *(LAS f32x4*)(RT + t * LP + k8) = rt0; *(LAS f32x4*)(RT + t * LP + k8 + 4) = rt1;
            *(LAS f32x4*)(BT + t * LP + k8) = bt0; *(LAS f32x4*)(BT + t * LP + k8 + 4) = bt1;
            *(LAS f32x4*)(KT + t * LP + k8) = kt0; *(LAS f32x4*)(KT + t * LP + k8 + 4) = kt1;
            *(LAS f32x4*)(VV + t * LP + k8) = v0; *(LAS f32x4*)(VV + t * LP + k8 + 4) = v1;
        }
        LDS_BARRIER();
#define A2_TILE(q_) do { const int prod = (q_) >> 2, ti = ((q_) >> 1) & 1, tj = (q_) & 1; \
            const LAS float* Ai = prod == 2 ? RT : AT; const LAS float* Bi = prod == 0 ? BT : KT; LAS float* Mo = prod == 0 ? MAB : (prod == 1 ? MAK : MRK); \
            f32x16 acc = {}; \
            _Pragma("unroll") for (int s2 = 0; s2 < 4; ++s2) RWK_MMA(acc, frag_row(Ai, ti * 32 + l31, s2, hi), frag_row(Bi, tj * 32 + l31, s2, hi)); \
            const int jj = tj * 32 + l31; \
            _Pragma("unroll") for (int r = 0; r < 16; ++r) { const int tt = ti * 32 + crow(r, hi); const bool keep = prod == 2 ? (jj <= tt) : (jj < tt); Mo[tt * LP + jj] = keep ? acc[r] : 0.f; } } while (0)
        A2_TILE(wave);
        LDS_BARRIER();
        {
            f32x16 pacc = {};
            const int ti = (wave >> 1) & 1, tj = wave & 1;
            if (wave < 4) A2_TILE(wave + 8);
            else {
#pragma unroll
                for (int s2 = 0; s2 < 4; ++s2) RWK_MMA(pacc, frag_row(MAK, ti * 32 + l31, s2, hi), frag_col(VV, tj * 32 + l31, s2, hi, 1.f));
            }
            LDS_BARRIER();
            if (wave >= 4) {
#pragma unroll
                for (int r = 0; r < 16; ++r) MAK[(ti * 32 + crow(r, hi)) * LP + tj * 32 + l31] = pacc[r];
            }
        }
#undef A2_TILE
        LDS_BARRIER();
        if (tid < 128) { LAS float* img = tid < 64 ? AT : MAK; sub_solve32(MAB, img + (tid & 63)); }
        LDS_BARRIER();
        if (wave >= 4) {
            LAS float* img = (wave & 2) ? MAK : AT; const int tj = wave & 1;
            f32x16 acc;
#pragma unroll
            for (int r = 0; r < 16; ++r) acc[r] = img[(32 + crow(r, hi)) * LP + tj * 32 + l31];
#pragma unroll
            for (int s2 = 0; s2 < 2; ++s2) RWK_MMA(acc, frag_row(MAB, 32 + l31, s2, hi), frag_col(img, tj * 32 + l31, s2, hi, 1.f));
#pragma unroll
            for (int r = 0; r < 16; ++r) img[(32 + crow(r, hi)) * LP + tj * 32 + l31] = acc[r];
        }
        LDS_BARRIER();
        if (tid < 128) { LAS float* img = tid < 64 ? AT : MAK; sub_solve32(MAB + 32 * LP + 32, img + 32 * LP + (tid & 63)); }
        LDS_BARRIER();
        {
            const int ti = (wave >> 1) & 1, tj = wave & 1;
            f32x16 acc = {};
            if (wave < 4) {
#pragma unroll
                for (int s2 = 0; s2 < 4; ++s2) RWK_MMA(acc, frag_row(RT, ti * 32 + l31, s2, hi), frag_row(BT, tj * 32 + l31, s2, hi));
                const int jj = tj * 32 + l31;
#pragma unroll
                for (int r = 0; r < 16; ++r) { const int tt = ti * 32 + crow(r, hi); MAB[tt * LP + jj] = (jj <= tt) ? acc[r] : 0.f; }
            } else {
                const float gl = GL[tj * 32 + l31];
#pragma unroll
                for (int s2 = 0; s2 < 4; ++s2) RWK_MMA(acc, frag_col(AT, ti * 32 + l31, s2, hi, 1.f), frag_col(BT, tj * 32 + l31, s2, hi, gl));
                float* out = TC + (size_t)chunk * 4096;
#pragma unroll
                for (int r = 0; r < 16; ++r) { const int kr = ti * 32 + crow(r, hi), kc = tj * 32 + l31; *GPTR(float, out + kr * 64 + kc) = acc[r] + (kr == kc ? gl : 0.f); }
            }
        }
        LDS_BARRIER();
        for (int q = wave; q < 12; q += 8) {
            const int kind = q >> 2, ti = (q >> 1) & 1, tj = q & 1;
            f32x16 acc = {};
            if (kind == 0) {
#pragma unroll
                for (int r = 0; r < 16; ++r) acc[r] = RT[(ti * 32 + crow(r, hi)) * LP + tj * 32 + l31];
#pragma unroll
                for (int s2 = 0; s2 < 4; ++s2) RWK_MMA(acc, frag_row(MAB, ti * 32 + l31, s2, hi), frag_col(AT, tj * 32 + l31, s2, hi, 1.f));
                bf16_t* out = (bf16_t*)GH + (size_t)chunk * 4096;
#pragma unroll
                for (int r = 0; r < 16; ++r) *GPTR(bf16_t, out + (ti * 32 + crow(r, hi)) * 64 + tj * 32 + l31) = (bf16_t)(cvt_pk_bf16(acc[r], 0.f) & 0xffffu);
            } else if (kind == 1) {
#pragma unroll
                for (int s2 = 0; s2 < 4; ++s2) RWK_MMA(acc, frag_row(MRK, ti * 32 + l31, s2, hi), frag_col(VV, tj * 32 + l31, s2, hi, 1.f));
#pragma unroll
                for (int s2 = 0; s2 < 4; ++s2) RWK_MMA(acc, frag_row(MAB, ti * 32 + l31, s2, hi), frag_col(MAK, tj * 32 + l31, s2, hi, 1.f));
#pragma unroll
                for (int r = 0; r < 16; ++r) *GPTR(bf16_t, Yg + g0 + (size_t)(ti * 32 + crow(r, hi)) * D + tj * 32 + l31) = (bf16_t)(cvt_pk_bf16(acc[r], 0.f) & 0xffffu);
            } else {
                const float gl = GL[tj * 32 + l31];
#pragma unroll
                for (int s2 = 0; s2 < 4; ++s2) RWK_MMA(acc, frag_col(MAK, ti * 32 + l31, s2, hi, 1.f), frag_col(BT, tj * 32 + l31, s2, hi, gl));
#pragma unroll
                for (int s2 = 0; s2 < 4; ++s2) RWK_MMA(acc, frag_col(VV, ti * 32 + l31, s2, hi, 1.f), frag_col(KT, tj * 32 + l31, s2, hi, gl));
                float* out = UC + (size_t)chunk * 4096;
#pragma unroll
                for (int r = 0; r < 16; ++r) *GPTR(float, out + (ti * 32 + crow(r, hi)) * 64 + tj * 32 + l31) = acc[r];
            }
        }
    }
    LDS_BARRIER();
}

DEVI void phaseB(const Ctx& c, int o, LAS float* L, int bid, int nb) {
    constexpr int P = 65, IM = 16 * P, SLOT0 = 2 * IM + 16, SLOTF = 4096 + 1024;
    const int tid = tid_opaque(), wave = __builtin_amdgcn_readfirstlane(tid >> 6), lane = tid & 63, i15 = lane & 15, kq = lane >> 4;
    const float* TC = (const float*)(CWS + B_TC); const float* UC = (const float*)(CWS + B_UC); bf16_t* SC = (bf16_t*)(CWS + B_SC);
    for (int item = bid; item < 256; item += nb) {
        const int bh = (item & 7) + 8 * (item >> 5), vt = (item >> 3) & 3;
        LDS_BARRIER();
        f32x4 st = {0.f, 0.f, 0.f, 0.f};
        if (wave < 4) {
#pragma unroll
            for (int r = 0; r < 4; ++r) L[(4 * kq + r) * P + 16 * wave + i15] = 0.f;
        }
        f32x4 rg[3][3];
#define PB_FETCH(set, cidx) do { const size_t cb = (size_t)(bh * 64 + (cidx)) * 4096; rg[set][0] = *GPTR(const f32x4, TC + cb + 4 * tid); rg[set][1] = *GPTR(const f32x4, TC + cb + 2048 + 4 * tid); \
            if (tid < 256) rg[set][2] = *GPTR(const f32x4, UC + cb + vt * 1024 + 4 * tid); } while (0)
#define PB_PARK(set, cidx) do { LAS float* sl = L + SLOT0 + ((cidx) & 1) * SLOTF; *(LAS f32x4*)(sl + 4 * tid) = rg[set][0]; *(LAS f32x4*)(sl + 2048 + 4 * tid) = rg[set][1]; \
            if (tid < 256) *(LAS f32x4*)(sl + 4096 + 4 * tid) = rg[set][2]; } while (0)
#define PB_STEP(cidx) do { if (wave < 4) { const size_t cho = (size_t)(bh * 64 + (cidx)) * 4096; LAS float* Sc = L + ((cidx) & 1) * IM; LAS float* Sn = L + (((cidx) + 1) & 1) * IM; \
            const LAS float* Tl = L + SLOT0 + ((cidx) & 1) * SLOTF; const LAS float* Ul = Tl + 4096; \
            _Pragma("unroll") for (int r = 0; r < 4; ++r) *GPTR(bf16_t, SC + cho + (16 * vt + 4 * kq + r) * 64 + 16 * wave + i15) = (bf16_t)(cvt_pk_bf16(st[r], 0.f) & 0xffffu); \
            f32x4 a0; _Pragma("unroll") for (int r = 0; r < 4; ++r) a0[r] = Ul[(4 * kq + r) * 64 + 16 * wave + i15]; \
            f32x4 a1 = {0.f, 0.f, 0.f, 0.f}, a2 = a1, a3 = a1; \
            _Pragma("unroll") for (int s2 = 0; s2 < 16; s2 += 4) { \
                a0 = __builtin_amdgcn_mfma_f32_16x16x4f32(Sc[i15 * P + 4 * s2 + kq], Tl[(4 * s2 + kq) * 64 + 16 * wave + i15], a0, 0, 0, 0); \
                a1 = __builtin_amdgcn_mfma_f32_16x16x4f32(Sc[i15 * P + 4 * (s2 + 1) + kq], Tl[(4 * (s2 + 1) + kq) * 64 + 16 * wave + i15], a1, 0, 0, 0); \
                a2 = __builtin_amdgcn_mfma_f32_16x16x4f32(Sc[i15 * P + 4 * (s2 + 2) + kq], Tl[(4 * (s2 + 2) + kq) * 64 + 16 * wave + i15], a2, 0, 0, 0); \
                a3 = __builtin_amdgcn_mfma_f32_16x16x4f32(Sc[i15 * P + 4 * (s2 + 3) + kq], Tl[(4 * (s2 + 3) + kq) * 64 + 16 * wave + i15], a3, 0, 0, 0); } \
            st = (a0 + a1) + (a2 + a3); \
            _Pragma("unroll") for (int r = 0; r < 4; ++r) Sn[(4 * kq + r) * P + 16 * wave + i15] = st[r]; } } while (0)
        PB_FETCH(0, 0); PB_FETCH(1, 1); PB_FETCH(2, 2);
        PB_PARK(0, 0);
        LDS_BARRIER();
        for (int cc = 0; cc < 63; cc += 3) {
            PB_FETCH(0, cc + 3); PB_STEP(cc);     PB_PARK(1, cc + 1); LDS_BARRIER();
            if (cc + 4 < 64) PB_FETCH(1, cc + 4); PB_STEP(cc + 1); PB_PARK(2, cc + 2); LDS_BARRIER();
            if (cc + 5 < 64) PB_FETCH(2, cc + 5); PB_STEP(cc + 2); PB_PARK(0, cc + 3); LDS_BARRIER();
        }
        PB_STEP(63);
#undef PB_FETCH
#undef PB_PARK
#undef PB_STEP
        if (wave < 4) {
            const int b = bh >> 4, h = bh & 15;
            float* op = COUT + O_PWKV + (((size_t)(o * NBP + b) * 16 + h) * 64) * 64;
#pragma unroll
            for (int r = 0; r < 4; ++r) *GPTR(float, op + (16 * vt + 4 * kq + r) * 64 + 16 * wave + i15) = st[r];
        }
    }
    LDS_BARRIER();
}

DEVI void phaseC(const Ctx& c, int bid, int nb) {
    const int tid = tid_opaque(), wave = __builtin_amdgcn_readfirstlane(tid >> 6), lane = tid & 63, l31 = lane & 31, hi = lane >> 5;
    const float* GH = (const float*)(CWS + B_GH); const float* SC = (const float*)(CWS + B_SC); bf16_t* Yg = (bf16_t*)(CWS + B_Y);
    for (int q = bid * 8 + wave; q < 4096 * 4; q += nb * 8) {
        const int chunk = q >> 2, ti = (q >> 1) & 1, tj = q & 1, cc = chunk & 63;
        const int bh = chunk >> 6, b = bh >> 4, h = bh & 15;
        f32x16 acc = {};
        if (cc != 0) {
            const bf16_t* ga = (const bf16_t*)GH + (size_t)chunk * 4096 + (ti * 32 + l31) * 64 + 8 * hi;
            const bf16_t* sb = (const bf16_t*)SC + (size_t)chunk * 4096 + (tj * 32 + l31) * 64 + 8 * hi;
#pragma unroll
            for (int s2 = 0; s2 < 4; ++s2) RWK_MMA(acc, __builtin_bit_cast(bf16x8, *GPTR(const u32x4, ga + 16 * s2)), __builtin_bit_cast(bf16x8, *GPTR(const u32x4, sb + 16 * s2)));
        }
        const size_t yo = ((size_t)(b * TP + cc * 64)) * D + h * 64 + tj * 32 + l31;
#pragma unroll
        for (int r = 0; r < 16; ++r) { const size_t p = yo + (size_t)(ti * 32 + crow(r, hi)) * D; *GPTR(bf16_t, Yg + p) = (bf16_t)(cvt_pk_bf16(acc[r], 0.f) & 0xffffu); }
    }
}
#undef RWK_MMA
}

#define XB_TMO      128
#define XB_XCNT(j)  (256  + 64 * (j))
#define XB_XSUB(j)  (1280 + 64 * (j))
#define XB_XGEN(j)  (2304 + 64 * (j))
#define XB_TOP      3328
#define XB_TOPGEN   3392
#define XCD_BAR_WORDS 3456
#define XB_SPIN_CAP (1u << 22)
DEVI unsigned xb_ld(unsigned* p)              { return __hip_atomic_load(p, __ATOMIC_RELAXED, __HIP_MEMORY_SCOPE_AGENT); }
DEVI unsigned xb_add(unsigned* p, unsigned v) { return __hip_atomic_fetch_add(p, v, __ATOMIC_RELAXED, __HIP_MEMORY_SCOPE_AGENT); }
DEVI unsigned xb_xcc_id() { return (unsigned)__builtin_amdgcn_s_getreg((3 << 11) | 20) & 0xFu; }
#define XB_SPIN(cond, bar) do { unsigned _sp = 0; while (cond) { __builtin_amdgcn_s_sleep(1); \
    if ((++_sp & 255u) == 0u) { if (xb_ld(&(bar)[XB_TMO])) break; if (_sp > XB_SPIN_CAP) { atomicAdd(&(bar)[XB_TMO], 1u); break; } } } } while (0)
struct XcdBarrier { unsigned* bar; unsigned x; volatile LAS unsigned* st; };
DEVI XcdBarrier xcd_barrier_post(unsigned* bar, volatile LAS unsigned* st) {
    XcdBarrier b; b.bar = bar; b.x = xb_xcc_id(); b.st = st;
    if (threadIdx.x == 0) (void)xb_add(&bar[XB_XCNT(b.x)], 1u);
    return b;
}
DEVI void xcd_barrier_complete(unsigned* bar, unsigned x, unsigned& nloc, unsigned& nx) {
    const unsigned G = gridDim.x * gridDim.y * gridDim.z;
    unsigned sum, cnt, mine, sp = 0u;
    for (;;) {
        sum = 0u; cnt = 0u; mine = 0u;
#pragma unroll
        for (unsigned j = 0; j < 16; ++j) { const unsigned cc = xb_ld(&bar[XB_XCNT(j)]); sum += cc; cnt += (cc > 0u) ? 1u : 0u; mine = (j == x) ? cc : mine; }
        if (sum == G) break;
        __builtin_amdgcn_s_sleep(1);
        if ((++sp & 255u) == 0u) { if (xb_ld(&bar[XB_TMO])) break; if (sp > XB_SPIN_CAP) { atomicAdd(&bar[XB_TMO], 1u); break; } }
    }
    nloc = mine > 0u ? mine : 1u; nx = cnt > 0u ? cnt : 1u;
}
template <bool FIRST> DEVI void xcd_barrier_t(const XcdBarrier& b) {
    asm volatile("s_waitcnt vmcnt(0)" ::: "memory");
    __syncthreads();
    if (tid_opaque() == 0) {
        unsigned* bar = b.bar; asm volatile("" : "+s"(bar)); unsigned bx = b.x; asm volatile("" : "+s"(bx));
        __builtin_amdgcn_s_waitcnt(0);
        unsigned nloc = b.st[0], nx = b.st[1];
        if (FIRST) { if (nloc == 0u) { xcd_barrier_complete(bar, bx, nloc, nx); b.st[0] = nloc; b.st[1] = nx; } }
        const unsigned old = xb_add(&bar[XB_XSUB(bx)], 1u);
        const unsigned gen = old / nloc;
        if (old + 1u == (gen + 1u) * nloc) {
            __builtin_amdgcn_fence(__ATOMIC_RELEASE, "agent");
            asm volatile("s_waitcnt vmcnt(0)" ::: "memory");
            const unsigned og = xb_add(&bar[XB_TOP], 1u);
            const unsigned tg = og / nx;
            if (og + 1u == (tg + 1u) * nx) xb_add(&bar[XB_TOPGEN], 1u);
            else XB_SPIN(xb_ld(&bar[XB_TOPGEN]) == tg, bar);
            __builtin_amdgcn_fence(__ATOMIC_ACQUIRE, "agent");
            xb_add(&bar[XB_XGEN(bx)], 1u);
            asm volatile("s_waitcnt vmcnt(0)" ::: "memory");
        } else {
            asm volatile("buffer_inv sc1" ::: "memory");
            XB_SPIN(xb_ld(&bar[XB_XGEN(bx)]) == gen, bar);
            asm volatile("s_waitcnt vmcnt(0)" ::: "memory");
        }
    }
    __syncthreads();
}

#define XB_SPLIT 4096
DEVI void split_arrive(unsigned* bar) {
    asm volatile("s_waitcnt vmcnt(0)" ::: "memory");
    __syncthreads();
    if (tid_opaque() == 0) { asm volatile("" : "+s"(bar)); __builtin_amdgcn_fence(__ATOMIC_RELEASE, "agent"); asm volatile("s_waitcnt vmcnt(0)" ::: "memory"); (void)xb_add(&bar[XB_SPLIT], 1u); }
}
DEVI void split_wait(unsigned* bar, unsigned target) {
    if (tid_opaque() == 0) { asm volatile("" : "+s"(bar)); XB_SPIN(xb_ld(&bar[XB_SPLIT]) < target, bar); __builtin_amdgcn_fence(__ATOMIC_ACQUIRE, "agent"); asm volatile("s_waitcnt vmcnt(0)" ::: "memory"); }
    __syncthreads();
}

constexpr int LDS_BYTES = 147456;
constexpr int MISC_OFF = 147456 - 64;

typedef pg8::EpiStore<true, false, 0, false, D, 256, 256, false> EpiF32;
typedef pg8::EpiStore<false, true, 0, false, D, 256, 256, false> EpiB16;
typedef pg8::EpiStore<true, true, 0, false, D, 256, 256, false> EpiF32B16;
typedef pg8::EpiStore<false, true, 0, true, D, 256, 256, false> EpiQ;
typedef pg8::EpiStore<false, true, 0, false, 256, 256, 1024u * 256u, false> EpiVT;
typedef pg8::EpiStore<false, true, 1, false, 128, 128, 0, false> EpiLoraTanh;
typedef pg8::EpiStore<false, true, 0, false, 128, 128, 0, false> EpiLora128;
typedef pg8::EpiStore<false, true, 2, false, 256, 256, 0, false> EpiLoraSig;
typedef pg8::EpiStore<true, false, 0, false, D, 256, 0, true> EpiScore;
typedef pg8::EpiStore<false, true, 0, false, D, 256, 0, true> EpiPV;
typedef pg8::EpiStore<false, true, 0, false, D, 256, 256, true> EpiFold;

__global__ void __launch_bounds__(NT, 2) mega_fwd(Ctx c) {
    extern __shared__ __attribute__((aligned(16))) unsigned char lds_raw[];
    LAS unsigned char* lds = (LAS unsigned char*)lds_raw;
    float* sm = (float*)lds_raw;
    if (threadIdx.x < 4) ((volatile LAS unsigned*)(lds + MISC_OFF))[threadIdx.x] = 0u;
    __syncthreads();
    XcdBarrier xb = xcd_barrier_post((unsigned*)(CWS + B_CTL), (volatile LAS unsigned*)(lds + MISC_OFF));
    const int bid0 = blockIdx.x, nb0 = gridDim.x;
#define bid opaque_s(bid0)
#define nb opaque_s(nb0)
#define BAR() xcd_barrier_t<false>(xb)
#define ws CWS
#define rowss ((float*)(CWS + B_ROWP))
#define X ((float*)(CWS + B_X))
#define XB ((bf16_t*)(CWS + B_XB))
#define WSB(off) ((bf16_t*)(CWS + (off)))
#define WSF(off) ((float*)(CWS + (off)))
#define GEMM(LDA_, LDB_, K_, EPI_T, Aptr, Bptr, nM_, nN_, Eobj, rot) do { pg8::Order<LDA_, LDB_, false> S_; { const int nb_ = nb; S_.init((nM_), (nN_), nb_, (bid + (rot)) % nb_); } \
        pg8::gemm_phase<LDA_, LDB_, K_, false, EPI_T>(lds, (Aptr), (Bptr), S_, (Eobj)); } while (0)

#ifdef PROBE_PAIR
    unsigned long long tacc0 = 0, tacc1 = 0, tacc2 = 0, tacc3 = 0, tlast = __builtin_amdgcn_s_memrealtime();
#define TCLASS(k) do { const unsigned long long tn_ = __builtin_amdgcn_s_memrealtime(); tacc##k += tn_ - tlast; tlast = tn_; } while (0)
#else
#define TCLASS(k) do {} while (0)
#endif
    ph_prologue(c, sm, bid, nb);
    xcd_barrier_t<true>(xb); TCLASS(3);
    for (int l = 0; l < 4; ++l) {
        const int e = l >> 1, o = l >> 1;
        if ((l & 1) == 0) {
            {
                pg8::EpiEvIn E{rowss + (size_t)(3 * l) * ROWP_N, COUT, CWS, e};
                GEMM(D, D, D, pg8::EpiEvIn, XB, WSB(B_WIN) + (size_t)e * 2048 * D, 66, 8, E, 0);
            }
            if (l == 2) for (int l2 = 2; l2 < 4; ++l2) {
                { pg8::Order<D, D, true> S_; { const int nb_ = nb; S_.init(1, 4, nb_, (bid + (l2 == 2 ? 240 : 112)) % nb_); } S_.nz = 16; S_.aZ1 = 256u * D * 2; S_.aZ2 = 512; S_.bZ1 = 0; S_.bZ2 = 512;
                  EpiFold E{nullptr, WSB(B_WKT) + (size_t)l2 * 4 * D * D, nullptr, (unsigned)D * D, 256u * D};
                  pg8::gemm_phase<D, D, 256, true, EpiFold>(lds, WSB(B_PMKB) + (size_t)l2 * 1024 * D, WSB(B_XWQN) + (size_t)l2 * D * D, S_, E); }
                { pg8::Order<D, D, true> S_; { const int nb_ = nb; S_.init(4, 1, nb_, (bid + (l2 == 2 ? 176 : 240)) % nb_); } S_.nz = 16; S_.aZ1 = 0; S_.aZ2 = 512; S_.bZ1 = 256u * D * 2; S_.bZ2 = 512;
                  EpiFold E{nullptr, WSB(B_VWT) + (size_t)l2 * 4 * D * D, nullptr, (unsigned)D * D, 256u};
                  pg8::gemm_phase<D, D, 256, true, EpiFold>(lds, WSB(B_XWO) + (size_t)l2 * D * D, WSB(B_PMVT) + (size_t)l2 * 1024 * D, S_, E); }
            }
            if (l == 0) for (int l2 = 0; l2 < 4; ++l2) {
                { EpiF32B16 E{COUT + O_PMK + (size_t)l2 * 1024 * D, WSB(B_PMKB) + (size_t)l2 * 1024 * D, nullptr, 0, 0}; GEMM(D, D, D, EpiF32B16, WSB(B_MEMB), WSB(B_XWK) + (size_t)l2 * D * D, 4, 4, E, 48 * l2 + 24); }
                { EpiF32B16 E{COUT + O_PMV + (size_t)l2 * 1024 * D, WSB(B_PMVT) + (size_t)l2 * 1024 * D, nullptr, 0, 0}; GEMM(D, D, D, EpiF32B16, WSB(B_MEMB), WSB(B_XWV) + (size_t)l2 * D * D, 4, 4, E, 48 * l2 + 24 + 16); }
            }
            BAR(); TCLASS(0);
            ph_pool_prep(c, e, bid, nb);
            for (int pass = 0; pass < 2; ++pass) {
                if (((pass ^ (int)bid) & 1) == 0) {
                    const attn_body::AttnTensors AT{(const attn_body::bf16*)(CWS + B_QB), (const attn_body::bf16*)(CWS + B_KB), (const attn_body::bf16*)(CWS + B_VB), (attn_body::bf16*)(CWS + B_OV)};
                    const attn_body::StaticOrder SO((int)nb, (int)bid);
                    attn_body::attn_phase<attn_body::StaticOrder>((char*)lds_raw, AT, SO);
                } else ph_diffattn_sample(c, e, (LAS float*)lds, bid, nb);
                __syncthreads();
            }
            BAR(); TCLASS(2);
            ph_diff_combine(c, e, bid, nb);
            ph_diff_combine_sample(c, e, bid, nb);
            if (l == 0) for (int l2 = 0; l2 < 2; ++l2) {
                { pg8::Order<D, D, true> S_; { const int nb_ = nb; S_.init(1, 4, nb_, (bid + 128 * l2) % nb_); } S_.nz = 16; S_.aZ1 = 256u * D * 2; S_.aZ2 = 512; S_.bZ1 = 0; S_.bZ2 = 512;
                  EpiFold E{nullptr, WSB(B_WKT) + (size_t)l2 * 4 * D * D, nullptr, (unsigned)D * D, 256u * D};
                  pg8::gemm_phase<D, D, 256, true, EpiFold>(lds, WSB(B_PMKB) + (size_t)l2 * 1024 * D, WSB(B_XWQN) + (size_t)l2 * D * D, S_, E); }
                { pg8::Order<D, D, true> S_; { const int nb_ = nb; S_.init(4, 1, nb_, (bid + 128 * l2 + 64) % nb_); } S_.nz = 16; S_.aZ1 = 0; S_.aZ2 = 512; S_.bZ1 = 256u * D * 2; S_.bZ2 = 512;
                  EpiFold E{nullptr, WSB(B_VWT) + (size_t)l2 * 4 * D * D, nullptr, (unsigned)D * D, 256u};
                  pg8::gemm_phase<D, D, 256, true, EpiFold>(lds, WSB(B_XWO) + (size_t)l2 * D * D, WSB(B_PMVT) + (size_t)l2 * 1024 * D, S_, E); }
            }
            BAR(); TCLASS(3);
            { pg8::EpiResid E{X, XB, rowss + (size_t)(3 * l + 1) * ROWP_N}; GEMM(D, D, D, pg8::EpiResid, WSB(B_CAT), WSB(B_WOUT) + (size_t)e * D * D, 64, 4, E, 0); }
            gemm_sample<D, D, 0>((LAS float*)lds, WSB(B_CAT), WSB(B_WOUT) + (size_t)e * D * D, X, XB, rowss + (size_t)(3 * l + 1) * ROWP_N, nullptr, nullptr, bid, nb);
            BAR(); TCLASS(0);
        } else {
            ph_shiftmix(c, l, bid, nb);
            BAR(); TCLASS(3);
            {
                { EpiB16 E{nullptr, WSB(B_R), nullptr, 0, 0}; GEMM(D, D, D, EpiB16, WSB(B_XM) + (size_t)0 * M * D, WSB(B_WR) + (size_t)o * D * D, 66, 4, E, 0); }
                { EpiB16 E{nullptr, WSB(B_K), nullptr, 0, 0}; GEMM(D, D, D, EpiB16, WSB(B_XM) + (size_t)2 * M * D, WSB(B_WK) + (size_t)o * D * D, 66, 4, E, 8); }
                { EpiB16 E{nullptr, WSB(B_V), nullptr, 0, 0}; GEMM(D, D, D, EpiB16, WSB(B_XM) + (size_t)3 * M * D, WSB(B_WV) + (size_t)o * D * D, 66, 4, E, 16); }
                { EpiLoraTanh E{nullptr, WSB(B_LW), nullptr, 0, 0}; GEMM(D, D, D, EpiLoraTanh, WSB(B_XM) + (size_t)1 * M * D, WSB(B_L1) + (size_t)(o * 4 + 0) * 256 * D, 66, 1, E, 24); }
                { EpiLora128 E{nullptr, WSB(B_LA), nullptr, 0, 0}; GEMM(D, D, D, EpiLora128, WSB(B_XM) + (size_t)4 * M * D, WSB(B_L1) + (size_t)(o * 4 + 1) * 256 * D, 66, 1, E, 90); }
                { EpiLoraSig E{nullptr, WSB(B_LG), nullptr, 0, 0}; GEMM(D, D, D, EpiLoraSig, WSB(B_XM) + (size_t)5 * M * D, WSB(B_L1) + (size_t)(o * 4 + 2) * 256 * D, 66, 1, E, 156); }
                if (o > 0) { EpiLora128 E{nullptr, WSB(B_LV), nullptr, 0, 0}; GEMM(D, D, D, EpiLora128, WSB(B_XM) + (size_t)3 * M * D, WSB(B_L1) + (size_t)(o * 4 + 3) * 256 * D, 66, 1, E, 222); }
            }
            BAR(); TCLASS(0);
            {
                { EpiB16 E{nullptr, WSB(B_W), nullptr, 0, 0}; GEMM(128, 128, 128, EpiB16, WSB(B_LW), WSB(B_L2W) + (size_t)o * D * 128, 66, 4, E, 0); }
                { EpiB16 E{nullptr, WSB(B_A), nullptr, 0, 0}; GEMM(128, 128, 128, EpiB16, WSB(B_LA), WSB(B_L2A) + (size_t)o * D * 128, 66, 4, E, 8); }
                { EpiB16 E{nullptr, WSB(B_G), nullptr, 0, 0}; GEMM(256, 256, 256, EpiB16, WSB(B_LG), WSB(B_L2G) + (size_t)o * D * 256, 66, 4, E, 16); }
                if (o > 0) { EpiB16 E{nullptr, WSB(B_VG), nullptr, 0, 0}; GEMM(128, 128, 128, EpiB16, WSB(B_LV), WSB(B_L2V) + (size_t)o * D * 128, 66, 4, E, 24); }
            }
            BAR(); TCLASS(0);
            ph_rw_prep(c, o, bid, nb);
            rwk::phaseA(c, o, (LAS float*)lds, bid, nb);
            BAR(); TCLASS(1);
            ph_rw_scan(c, o, bid, nb, (LAS float*)lds);
            rwk::phaseB(c, o, (LAS float*)lds, bid, nb);
            BAR(); TCLASS(1);
            rwk::phaseC(c, bid, nb);
            BAR(); TCLASS(1);
            ph_rw_post(c, o, bid, nb);
            BAR(); TCLASS(3);
            { pg8::EpiResid E{X, XB, rowss + (size_t)(3 * l + 1) * ROWP_N}; GEMM(D, D, D, pg8::EpiResid, WSB(B_YG), WSB(B_WO) + (size_t)o * D * D, 64, 4, E, 0); }
            gemm_sample<D, D, 0>((LAS float*)lds, WSB(B_YG), WSB(B_WO) + (size_t)o * D * D, X, XB, rowss + (size_t)(3 * l + 1) * ROWP_N, nullptr, nullptr, bid, nb);
            BAR(); TCLASS(0);
        }
        {
            pg8::Order<D, D, true> S_; S_.init(16, 1, nb, bid); S_.nz = 16; S_.aZ1 = (unsigned)TP * D * 2; S_.aZ2 = 0; S_.bZ1 = (unsigned)D * D * 2; S_.bZ2 = 256u * D * 2;
            pg8::EpiSoftmax E{WSB(B_P), (unsigned)TP * D, 256, (LAS float*)(lds + 131072), rowss + (size_t)(3 * l + 1) * ROWP_N};
            pg8::gemm_phase<D, D, D, true, pg8::EpiSoftmax>(lds, XB, WSB(B_WKT) + (size_t)l * 4 * D * D, S_, E);
        }
        gemm_sample<D, D, 1>((LAS float*)lds, XB, WSB(B_XWQ) + (size_t)l * D * D, nullptr, nullptr, nullptr, rowss + (size_t)(3 * l + 1) * ROWP_N, WSB(B_Q), bid, nb);
        BAR(); TCLASS(0);
        ph_xattn_sample(c, l, (LAS float*)lds, bid, nb);
        split_arrive((unsigned*)(CWS + B_CTL));
        {
            pg8::Order<D, D, true> S_; S_.init(16, 4, nb, bid); S_.nz = 4; S_.aZ1 = 0; S_.aZ2 = (unsigned)TP * D * 2; S_.bZ1 = 0; S_.bZ2 = (unsigned)D * D * 2;
            pg8::EpiResidT<true> E{X, XB, rowss + (size_t)(3 * l + 2) * ROWP_N};
            pg8::gemm_phase<D, D, D, true, pg8::EpiResidT<true>>(lds, WSB(B_P), WSB(B_VWT) + (size_t)l * 4 * D * D, S_, E);
        }
        {
            const int b_ = bid, h_ = nb >> 1;
            if (b_ >= h_) {
                split_wait((unsigned*)(CWS + B_CTL), (unsigned)(l + 1) * (unsigned)nb);
                gemm_sample<D, D, 0>((LAS float*)lds, WSB(B_O), WSB(B_XWO) + (size_t)l * D * D, X, XB, rowss + (size_t)(3 * l + 2) * ROWP_N, nullptr, nullptr, b_ - h_, nb - h_);
            }
        }
        BAR(); TCLASS(0);
        { pg8::EpiSwiglu E{rowss + (size_t)(3 * l + 2) * ROWP_N, WSB(B_HG)}; GEMM(D, D, D, pg8::EpiSwiglu, XB, WSB(B_FGU) + (size_t)l * 5632 * D, 66, 22, E, 0); }
        if (l < 2) { const int b_ = bid, nb_ = nb, first = 66 * 22 - 5 * nb_;
            if (first > 0 && first < nb_ && b_ >= first) conv_late(c, l + 2, b_ - first, nb_ - first); }
        BAR(); TCLASS(0);
        { pg8::EpiResid E{X, XB, rowss + (size_t)(3 * l + 3) * ROWP_N}; GEMM(DFF, DFF, DFF, pg8::EpiResid, WSB(B_HG), WSB(B_FWD) + (size_t)l * D * DFF, 64, 4, E, 0); }
        gemm_sample<DFF, DFF, 0>((LAS float*)lds, WSB(B_HG), WSB(B_FWD) + (size_t)l * D * DFF, X, XB, rowss + (size_t)(3 * l + 3) * ROWP_N, nullptr, nullptr, bid, nb);
        BAR(); TCLASS(0);
    }
    ph_final(c, bid, nb);
#ifdef PROBE_PAIR
    TCLASS(3);
    __syncthreads();
    if (blockIdx.x == 0 && threadIdx.x == 0) {
        const float tA = (float)(PROBE_PAIR == 0 ? tacc0 : tacc2) * 0.01f, tB = (float)(PROBE_PAIR == 0 ? tacc1 : tacc3) * 0.01f;
        COUT[O_YP] = 8.f * tA; COUT[O_PSHIFT] = tB;
    }
#endif
#undef ws
#undef rowss
#undef X
#undef XB
#undef bid
#undef nb
}
}

extern "C" void kernel_launch(void* const* d_in, const int* in_sizes, int n_in, void* d_out, int out_size, void* d_ws, size_t ws_size, hipStream_t stream) {
    if (n_in != N_IN || (size_t)out_size != O_END || ws_size < B_END) return;
    Ctx c; for (int i = 0; i < N_IN; ++i) c.in[i] = (const float*)d_in[i];
    c.out = (float*)d_out; c.ws = (unsigned char*)d_ws;
    static int grid = 0;
    if (!grid) {
        int dev = 0, cus = 0;
        (void)hipGetDevice(&dev);
        (void)hipDeviceGetAttribute(&cus, hipDeviceAttributeMultiprocessorCount, dev);
        (void)hipFuncSetAttribute((const void*)mega_fwd, hipFuncAttributeMaxDynamicSharedMemorySize, LDS_BYTES);
        grid = cus > 0 ? cus : 256;
    }
    (void)hipMemsetAsync(d_ws, 0, 32768, stream);
    hipLaunchKernelGGL(mega_fwd, dim3(grid), dim3(NT), LDS_BYTES, stream, c);
}
```

```cpp
#include <hip/hip_runtime.h>
#include <hip/hip_bf16.h>
#include <stdint.h>

#define DEVI __device__ __forceinline__
#define LAS __attribute__((address_space(3)))

namespace {
typedef unsigned short bf16_t;
typedef short bf16x8 __attribute__((ext_vector_type(8)));
typedef float f32x4 __attribute__((ext_vector_type(4)));
typedef unsigned u32x4 __attribute__((ext_vector_type(4)));
typedef unsigned u32x2 __attribute__((ext_vector_type(2)));

constexpr int D = 1024, NBP = 4, TP = 4096, NBS = 32, TS = 16, PAST = 4096;
constexpr int MP = NBP * TP, MS = NBS * TS, M = MP + MS;
constexpr int PW = 512, PHIST = 15;
constexpr int NMEM = 256;
constexpr int DFF = 2816;
constexpr float NORM_EPS = 1e-6f, RW_LN_EPS = 64e-5f;
constexpr int NT = 512;

constexpr size_t O_YP = 0;
constexpr size_t O_YS = O_YP + (size_t)MP * D;
constexpr size_t O_PDK = O_YS + (size_t)MS * D;
constexpr size_t O_PDV = O_PDK + (size_t)2 * MP * 512;
constexpr size_t O_PPOOL = O_PDV + (size_t)2 * MP * 512;
constexpr size_t O_PSHIFT = O_PPOOL + (size_t)2 * NBP * PHIST * PW;
constexpr size_t O_PWKV = O_PSHIFT + (size_t)2 * NBP * D;
constexpr size_t O_PMK = O_PWKV + (size_t)2 * NBP * 16 * 4096;
constexpr size_t O_PMV = O_PMK + (size_t)4 * NBP * NMEM * D;
constexpr size_t O_SDK = O_PMV + (size_t)4 * NBP * NMEM * D;
constexpr size_t O_SDV = O_SDK + (size_t)2 * MS * 512;
constexpr size_t O_SPOOL = O_SDV + (size_t)2 * MS * 512;
constexpr size_t O_SSHIFT = O_SPOOL + (size_t)2 * NBS * PHIST * PW;
constexpr size_t O_SWKV = O_SSHIFT + (size_t)2 * NBS * D;
constexpr size_t O_END = O_SWKV + (size_t)2 * NBS * 16 * 4096;

enum { I_XP = 0, I_XS, I_CDK, I_CDV, I_SPOOL, I_SSHIFT, I_SWKV, I_CMK, I_CMV, I_MEMP, I_NMIX, I_NXA, I_NFFN, I_NFIN,
       I_EWIN, I_EPW, I_EPS, I_LQ1, I_LK1, I_LQ2, I_LK2, I_SUBG, I_EWOUT, I_MU, I_WR, I_WK, I_WV, I_WO, I_W0, I_W1, I_W2,
       I_A0, I_A1, I_A2, I_V0, I_V1, I_V2, I_G1, I_G2, I_KK, I_KA, I_RK, I_LNG, I_LNB, I_XWQ, I_XWK, I_XWV, I_XWO,
       I_FWG, I_FWU, I_FWD, N_IN };

constexpr size_t MiB = 1u << 20;
constexpr size_t B_CTL = 0;
constexpr size_t B_ROWSS = 65536;
constexpr size_t CTL_BYTES = 2 * MiB;
constexpr size_t UB2 = (size_t)M * D * 2, UB4 = (size_t)M * D * 4;
constexpr size_t B_WIN = CTL_BYTES;
constexpr size_t B_WOUT = B_WIN + (size_t)2 * 2048 * 1024 * 2;
constexpr size_t B_WR = B_WOUT + (size_t)2 * 1024 * 1024 * 2;
constexpr size_t B_WK = B_WR + (size_t)2 * 1024 * 1024 * 2;
constexpr size_t B_WV = B_WK + (size_t)2 * 1024 * 1024 * 2;
constexpr size_t B_WO = B_WV + (size_t)2 * 1024 * 1024 * 2;
constexpr size_t B_L1 = B_WO + (size_t)2 * 1024 * 1024 * 2;
constexpr size_t B_L2W = B_L1 + (size_t)2 * 4 * 256 * 1024 * 2;
constexpr size_t B_L2A = B_L2W + (size_t)2 * 1024 * 128 * 2;
constexpr size_t B_L2G = B_L2A + (size_t)2 * 1024 * 128 * 2;
constexpr size_t B_L2V = B_L2G + (size_t)2 * 1024 * 256 * 2;
constexpr size_t B_XWQ = B_L2V + (size_t)2 * 1024 * 128 * 2;
constexpr size_t B_XWK = B_XWQ + (size_t)4 * 1024 * 1024 * 2;
constexpr size_t B_XWV = B_XWK + (size_t)4 * 1024 * 1024 * 2;
constexpr size_t B_XWO = B_XWV + (size_t)4 * 1024 * 1024 * 2;
constexpr size_t B_FGU = B_XWO + (size_t)4 * 1024 * 1024 * 2;
constexpr size_t B_FWD = B_FGU + (size_t)4 * 5632 * 1024 * 2;
constexpr size_t B_MEMB = B_FWD + (size_t)4 * 1024 * 2816 * 2;
constexpr size_t B_PMKB = B_MEMB + (size_t)1024 * 1024 * 2;
constexpr size_t B_PMVT = B_PMKB + (size_t)4 * 1024 * 1024 * 2;
constexpr size_t B_X = ((B_PMVT + (size_t)4 * 1024 * 1024 * 2 + 255) / 256) * 256;
constexpr size_t B_XB = B_X + UB4;
constexpr size_t B_S0 = B_XB + UB2;
constexpr size_t B_U = B_S0;
constexpr size_t B_QB = B_U + (size_t)M * 512 * 4;
constexpr size_t B_KB = B_QB + (size_t)M * 512 * 2;
constexpr size_t B_VB = B_KB + (size_t)M * 512 * 2;
constexpr size_t B_CAT = B_VB + (size_t)M * 512 * 2;
constexpr size_t B_QV = B_CAT + UB2;
constexpr size_t B_KV = B_QV + UB2;
constexpr size_t B_VV = B_KV + UB2;
constexpr size_t B_OV = B_VV + UB2;
constexpr size_t B_XM = B_S0;
constexpr size_t B_R = B_XM + 6 * UB2;
constexpr size_t B_K = B_R + UB4;
constexpr size_t B_V = B_K + UB4;
constexpr size_t B_W = B_V + UB4;
constexpr size_t B_A = B_W + UB4;
constexpr size_t B_G = B_A + UB4;
constexpr size_t B_VG = B_G + UB4;
constexpr size_t B_KK = B_VG + UB4;
constexpr size_t B_Y = B_KK + UB4;
constexpr size_t B_LW = B_Y + UB4;
constexpr size_t B_LA = B_LW + (size_t)M * 128 * 2;
constexpr size_t B_LG = B_LA + (size_t)M * 128 * 2;
constexpr size_t B_LV = B_LG + (size_t)M * 256 * 2;
constexpr size_t B_YG = B_LV + (size_t)M * 128 * 2;
constexpr size_t B_ODD_END = B_YG + UB2;
constexpr size_t CHB = (size_t)4096 * 4096 * 4;

constexpr size_t B_Q = B_S0;
constexpr size_t B_S = B_Q + UB2;
constexpr size_t B_P = B_S + UB4;
constexpr size_t B_O = B_P + UB2;
constexpr size_t B_HG = B_S0;
constexpr size_t B_VF = B_ODD_END;
constexpr size_t B_TC = B_VF + UB4, B_UC = B_TC + CHB, B_GH = B_UC + CHB, B_SC = B_GH + CHB;
constexpr size_t B_YL = B_SC + CHB;
constexpr size_t B_ROWP = B_YL + UB4;
constexpr size_t ROWP_N = (size_t)M * 16;
constexpr size_t B_DPART = B_ROWP + 13 * ROWP_N * 4;
constexpr size_t B_SMP = B_DPART + (size_t)256 * 2 * 16 * 132 * 4;
constexpr size_t SMPN = (size_t)MS * D;
constexpr size_t B_XWQN = B_SMP + 5 * SMPN * 4;
constexpr size_t B_WKT = B_XWQN + (size_t)4 * 1024 * 1024 * 2;
constexpr size_t B_VWT = B_WKT + (size_t)16 * 1024 * 1024 * 2;
constexpr size_t B_END = B_VWT + (size_t)16 * 1024 * 1024 * 2;

struct Ctx { const float* in[N_IN]; float* out; unsigned char* ws; };

template <int OFF> DEVI const void* karg_ptr() {
    unsigned long long p;
    asm volatile("s_load_dwordx2 %0, %1, %2\n\ts_waitcnt lgkmcnt(0)" : "=s"(p) : "s"(__builtin_amdgcn_kernarg_segment_ptr()), "n"(OFF) : "memory");
    return (const void*)(const __attribute__((address_space(1))) void*)p;
}
#define CIN(I) ((const float*)karg_ptr<(I) * 8>())
#define COUT ((float*)karg_ptr<N_IN * 8>())
#define CWS ((unsigned char*)karg_ptr<(N_IN + 1) * 8>())
DEVI float wave_sum(float v) {
#pragma unroll
    for (int o = 32; o > 0; o >>= 1) v += __shfl_xor(v, o, 64);
    return v;
}
DEVI int tid_opaque() { int t = threadIdx.x; asm volatile("" : "+v"(t)); return t; }
DEVI int opaque_s(int v) { asm volatile("" : "+s"(v)); return v; }
DEVI float sigmoidf_(float x) { return __builtin_amdgcn_rcpf(1.f + __expf(-x)); }
DEVI float softplusf_(float x) { return fmaxf(x, 0.f) + __logf(1.f + __expf(-fabsf(x))); }
typedef float f32x2_t_ __attribute__((ext_vector_type(2))); typedef __bf16 bf16x2_t_ __attribute__((ext_vector_type(2)));
DEVI unsigned cvt_pk_bf16(float lo, float hi) { const f32x2_t_ v = {lo, hi}; const bf16x2_t_ b = __builtin_convertvector(v, bf16x2_t_); return __builtin_bit_cast(unsigned, b); }
DEVI float bf2f(unsigned short b) { return __uint_as_float((unsigned)b << 16); }
DEVI float bflo(unsigned w) { return __uint_as_float(w << 16); }
DEVI float bfhi(unsigned w) { return __uint_as_float(w & 0xffff0000u); }
DEVI f32x4 ld4bf(const bf16_t* p) { const u32x2 w = *(const __attribute__((address_space(1))) u32x2*)p; return (f32x4){bflo(w.x), bfhi(w.x), bflo(w.y), bfhi(w.y)}; }
DEVI f32x4 cv4bf(const u32x2 w) { return (f32x4){bflo(w.x), bfhi(w.x), bflo(w.y), bfhi(w.y)}; }
DEVI void st4bf(bf16_t* p, const f32x4& v) { u32x2 w; w.x = cvt_pk_bf16(v[0], v[1]); w.y = cvt_pk_bf16(v[2], v[3]); *(__attribute__((address_space(1))) u32x2*)p = w; }
DEVI u32x4 pack8(const f32x4& a, const f32x4& b) { u32x4 w; w.x = cvt_pk_bf16(a[0], a[1]); w.y = cvt_pk_bf16(a[2], a[3]); w.z = cvt_pk_bf16(b[0], b[1]); w.w = cvt_pk_bf16(b[2], b[3]); return w; }

namespace pg8 {
constexpr int BM = 256, BK = 64, HALF = 128, HTB = HALF * BK * 2, STAGE_BYTES = 8 * HTB, NXCD = 8, WGM = 8;
__host__ __device__ __forceinline__ int lds_byte(int r, int c) { const int st = (r >> 4) * 2 + (c >> 5), rr = r & 15, cc = c & 31, ob = rr * 64 + cc * 2; return st * 1024 + (ob ^ (((ob >> 9) & 1) << 5)); }
__host__ __device__ __forceinline__ void stage_rc(int b, int& R, int& C) { const int st = b / 1024, sb = b % 1024, swz = sb ^ (((sb >> 9) & 1) << 5); R = (st >> 1) * 16 + swz / 64; C = (st & 1) * 32 + (swz % 64) / 2; }
__host__ __device__ __forceinline__ int perm32(int rho) { const int n = rho >> 4, i = rho & 15; return 8 * (i >> 2) + 4 * n + (i & 3); }

struct Unit { int pm, pn, z; };

template <int LDA, int LDB, bool BATCH> struct Order {
    int nM, nN, nz, per, G, c; unsigned aZ1, aZ2, bZ1, bZ2;
    DEVI void init(int nM_, int nN_, int G_, int c_) { nM = nM_; nN = nN_; nz = 1; per = nM * nN; G = G_; c = c_; aZ1 = aZ2 = bZ1 = bZ2 = 0; }
    DEVI bool next(int i, Unit& u) const {
        const int L = i * G + c; if (L >= per * nz) return false;
        int wgid = L % per; u.z = L / per;
        if (!BATCH) { const int q = per / NXCD, r = per % NXCD, xcd = wgid % NXCD, off = wgid / NXCD; wgid = (xcd < r ? xcd * (q + 1) : r * (q + 1) + (xcd - r) * q) + off; }
        const int nig = WGM * nN, gid = wgid / nig, fm = gid * WGM, gsz = (nM - fm) < WGM ? (nM - fm) : WGM;
        u.pm = fm + ((wgid % nig) % gsz); u.pn = (wgid % nig) / gsz; return true;
    }
    DEVI unsigned a_off(const Unit& u) const { return (BATCH ? (unsigned)(u.z >> 2) * aZ1 + (unsigned)(u.z & 3) * aZ2 : 0u) + (unsigned)u.pm * (256u * LDA * 2u); }
    DEVI unsigned b_off(const Unit& u) const { return (BATCH ? (unsigned)(u.z >> 2) * bZ1 + (unsigned)(u.z & 3) * bZ2 : 0u) + (unsigned)u.pn * (256u * LDB * 2u); }
};

template <int LDA, int LDB, int KDIM, bool BATCH, class Epi>
DEVI void gemm_phase(LAS unsigned char* lds, const bf16_t* Ag, const bf16_t* Bg, const Order<LDA, LDB, BATCH>& S, const Epi& E) {
    const int tid = tid_opaque(), wid = __builtin_amdgcn_readfirstlane(tid >> 6), lane = tid & 63, wr = wid >> 2, wc = wid & 3, fr = lane & 15, fq = lane >> 4;
    const int nt = opaque_s(KDIM / BK);
    unsigned voffA[2], voffB[2];
#pragma unroll
    for (int i = 0; i < 2; ++i) { int R, C; stage_rc(tid * 16 + i * 8192, R, C); const int Rb = (R & ~31) + perm32(R & 31);
        voffA[i] = (unsigned)(R * LDA + C) * 2u; voffB[i] = (unsigned)(Rb * LDB + C) * 2u; }
    constexpr unsigned kstep = BK * 2, hstepA = HALF * LDA * 2, hstepB = HALF * LDB * 2;
    const unsigned ldsw = (unsigned)wid * 1024u;
    const int aoff = lds_byte(wr * 64 + fr, fq * 8), boff = lds_byte(wc * 32 + fr, fq * 8);
#define PG8_SA(b, h) (((b) * 2 + (h)) * HTB)
#define PG8_SB(b, h) ((4 + (b) * 2 + (h)) * HTB)
#define PG8_STAGE(bufoff, gbase, voff) do { _Pragma("unroll") for (int _i = 0; _i < 2; ++_i) \
        __builtin_amdgcn_global_load_lds((const __attribute__((address_space(1))) unsigned*)((const __attribute__((address_space(1))) char*)(gbase) + (voff)[_i]), (LAS unsigned*)(lds + (bufoff) + ldsw + _i * 8192), 16, 0, 0); } while (0)
#define PG8_LDA(dst, b, h) do { _Pragma("unroll") for (int m = 0; m < 4; ++m) _Pragma("unroll") for (int k = 0; k < 2; ++k) dst[m][k] = *(const LAS bf16x8*)(lds + PG8_SA(b, h) + aoff + m * 2048 + k * 1024); } while (0)
#define PG8_LDB(dst, b, h) do { _Pragma("unroll") for (int n = 0; n < 2; ++n) _Pragma("unroll") for (int k = 0; k < 2; ++k) dst[n][k] = *(const LAS bf16x8*)(lds + PG8_SB(b, h) + boff + n * 2048 + k * 1024); } while (0)
#define PG8_MMA(ai, bj, At, Bt) do { __builtin_amdgcn_s_setprio(1); _Pragma("unroll") for (int m = 0; m < 4; ++m) _Pragma("unroll") for (int n = 0; n < 2; ++n) _Pragma("unroll") for (int k = 0; k < 2; ++k) \
        acc[ai][bj][m][n] = __builtin_amdgcn_mfma_f32_16x16x32_bf16(Bt[n][k], At[m][k], acc[ai][bj][m][n], 0, 0, 0); __builtin_amdgcn_s_setprio(0); } while (0)
#define PG8_WAIT_V(n) asm volatile("s_waitcnt vmcnt(" #n ")" ::: "memory")
#define PG8_WAIT_L(n) asm volatile("s_waitcnt lgkmcnt(" #n ")" ::: "memory")
#define PG8_BAR __builtin_amdgcn_s_barrier()
#define PG8_SCHED __builtin_amdgcn_sched_barrier(0)
    typedef const __attribute__((address_space(1))) char* gptr;
    Unit cur, nxt; int ui = 0;
    if (!S.next(0, cur)) return;
    f32x4 acc[2][2][4][2];
#pragma unroll
    for (int a = 0; a < 2; ++a)
#pragma unroll
        for (int b = 0; b < 2; ++b)
#pragma unroll
            for (int m = 0; m < 4; ++m)
#pragma unroll
                for (int n = 0; n < 2; ++n) acc[a][b][m][n] = (f32x4){0.f, 0.f, 0.f, 0.f};
    bf16x8 At[4][2], B0[2][2], B1[2][2];
    const gptr A0 = (gptr)Ag, B0p = (gptr)Bg;
    gptr cA = A0 + S.a_off(cur); gptr cB = B0p + S.b_off(cur);
    PG8_STAGE(PG8_SB(0, 0), cB, voffB); PG8_STAGE(PG8_SB(0, 1), cB + hstepB, voffB); PG8_STAGE(PG8_SA(0, 0), cA, voffA); PG8_STAGE(PG8_SA(0, 1), cA + hstepA, voffA);
    if (wr == 1) PG8_BAR;
    PG8_WAIT_V(2); PG8_BAR;
    PG8_STAGE(PG8_SB(1, 0), cB + kstep, voffB); PG8_STAGE(PG8_SA(1, 0), cA + kstep, voffA); PG8_STAGE(PG8_SB(1, 1), cB + hstepB + kstep, voffB);
    PG8_WAIT_V(6); PG8_BAR;
    for (;;) {
        const bool has_next = S.next(ui + 1, nxt);
        gptr nA = has_next ? A0 + S.a_off(nxt) : cA; gptr nB = has_next ? B0p + S.b_off(nxt) : cB;
        for (int t = 0; t < nt; t += 2) {
            const bool last = (t == nt - 2);
            gptr a1 = cA + (unsigned)(t + 1) * kstep;
            gptr a2 = last ? nA : cA + (unsigned)(t + 2) * kstep; gptr b2 = last ? nB : cB + (unsigned)(t + 2) * kstep;
            gptr a3 = a2 + kstep; gptr b3 = b2 + kstep;
            PG8_LDB(B0, 0, 0); PG8_LDB(B1, 0, 1); PG8_SCHED; PG8_LDA(At, 0, 0); PG8_STAGE(PG8_SA(1, 1), a1 + hstepA, voffA);
            PG8_WAIT_V(8); PG8_WAIT_L(0); PG8_BAR; PG8_MMA(0, 0, At, B0); PG8_MMA(0, 1, At, B1); PG8_BAR; PG8_SCHED;
            PG8_LDA(At, 0, 1); PG8_STAGE(PG8_SB(0, 0), b2, voffB); PG8_STAGE(PG8_SB(0, 1), b2 + hstepB, voffB); PG8_STAGE(PG8_SA(0, 0), a2, voffA);
            PG8_WAIT_V(8); PG8_WAIT_L(0); PG8_BAR; PG8_MMA(1, 0, At, B0); PG8_MMA(1, 1, At, B1); PG8_BAR; PG8_SCHED;
            PG8_LDB(B0, 1, 0); PG8_LDB(B1, 1, 1); PG8_SCHED; PG8_LDA(At, 1, 0); PG8_STAGE(PG8_SA(0, 1), a2 + hstepA, voffA);
            PG8_WAIT_V(8); PG8_WAIT_L(0); PG8_BAR; PG8_MMA(0, 0, At, B0); PG8_MMA(0, 1, At, B1); PG8_BAR; PG8_SCHED;
            PG8_LDA(At, 1, 1); PG8_STAGE(PG8_SB(1, 0), b3, voffB); PG8_STAGE(PG8_SB(1, 1), b3 + hstepB, voffB); PG8_STAGE(PG8_SA(1, 0), a3, voffA);
            PG8_WAIT_V(8); PG8_WAIT_L(0); PG8_BAR; PG8_MMA(1, 0, At, B0); PG8_MMA(1, 1, At, B1); PG8_BAR; PG8_SCHED;
        }
        if (wr == 0) PG8_BAR;
        E(acc, cur, wr, wc, fr, fq);
        if (!has_next) break;
#pragma unroll
        for (int a = 0; a < 2; ++a)
#pragma unroll
            for (int b = 0; b < 2; ++b)
#pragma unroll
                for (int m = 0; m < 4; ++m)
#pragma unroll
                    for (int n = 0; n < 2; ++n) acc[a][b][m][n] = (f32x4){0.f, 0.f, 0.f, 0.f};
        cur = nxt; cA = nA; cB = nB; ++ui;
        if (wr == 1) PG8_BAR;
    }
    PG8_WAIT_V(0);
    PG8_BAR;
#undef PG8_SA
#undef PG8_SB
#undef PG8_STAGE
#undef PG8_LDA
#undef PG8_LDB
#undef PG8_MMA
#undef PG8_WAIT_V
#undef PG8_WAIT_L
#undef PG8_BAR
#undef PG8_SCHED
}

#define GPTR(T, p) ((__attribute__((address_space(1))) T*)(p))
DEVI float rs_of(const float* rowp, unsigned row) {
    const f32x4 a = *GPTR(const f32x4, rowp + row * 16), b = *GPTR(const f32x4, rowp + row * 16 + 4), c = *GPTR(const f32x4, rowp + row * 16 + 8), d = *GPTR(const f32x4, rowp + row * 16 + 12);
    const float s = (((a[0] + a[1]) + (a[2] + a[3])) + ((b[0] + b[1]) + (b[2] + b[3]))) + (((c[0] + c[1]) + (c[2] + c[3])) + ((d[0] + d[1]) + (d[2] + d[3])));
    return rsqrtf(s * (1.f / D) + NORM_EPS);
}
template <bool F32, bool BF16, int ACT, bool RS, int LDC, int NCOL, unsigned PNS, bool BATCH> struct EpiStore {
    float* Of; bf16_t* Ob; const float* rowss; unsigned zs1, zs2;
    DEVI void operator()(const f32x4 (&acc)[2][2][4][2], const Unit& u, int wr, int wc, int fr, int fq) const {
        const unsigned row0 = u.pm * BM + wr * 64 + fr;
        const unsigned o0 = (unsigned)u.pn * PNS + (BATCH ? (unsigned)(u.z >> 2) * zs1 + (unsigned)(u.z & 3) * zs2 : 0u) + row0 * LDC + wc * 32 + 8 * fq;
#pragma unroll
        for (int ai = 0; ai < 2; ++ai)
#pragma unroll
            for (int m = 0; m < 4; ++m) {
                float sc = 1.f; if (RS) sc = rs_of(rowss, row0 + ai * HALF + m * 16);
#pragma unroll
                for (int bj = 0; bj < 2; ++bj) {
                    if (bj * HALF < NCOL) {
                        f32x4 v0 = acc[ai][bj][m][0], v1 = acc[ai][bj][m][1];
                        if (RS) { v0 *= sc; v1 *= sc; }
                        if (ACT == 1) {
#pragma unroll
                            for (int i = 0; i < 4; ++i) { v0[i] = 1.f - 2.f / (__expf(2.f * v0[i]) + 1.f); v1[i] = 1.f - 2.f / (__expf(2.f * v1[i]) + 1.f); }
                        } else if (ACT == 2) {
#pragma unroll
                            for (int i = 0; i < 4; ++i) { v0[i] = sigmoidf_(v0[i]); v1[i] = sigmoidf_(v1[i]); }
                        }
                        const unsigned off = o0 + (unsigned)((ai * HALF + m * 16) * LDC + bj * HALF);
                        if (NCOL == 256 || wc * 32 + 8 * fq + bj * HALF < NCOL) {
                            if (F32) { *GPTR(f32x4, Of + off) = v0; *GPTR(f32x4, Of + off + 4) = v1; }
                            if (BF16) *GPTR(u32x4, Ob + off) = pack8(v0, v1);
                        }
                    }
                }
            }
    }
};
struct EpiEvIn {
    const float* rowss; float* out; unsigned char* wsb; int e;
    DEVI void operator()(const f32x4 (&acc)[2][2][4][2], const Unit& u, int wr, int wc, int fr, int fq) const {
        const int seg = u.pn >> 1; const unsigned row0 = u.pm * BM + wr * 64 + fr;
        const unsigned o0 = row0 * 512 + (u.pn & 1) * 256 + wc * 32 + 8 * fq;
        const bool prompt = u.pm < (MP / 256);
        const size_t fo = (seg == 2 ? (prompt ? O_PDK : O_SDK) : (prompt ? O_PDV : O_SDV)) + (size_t)e * (prompt ? (size_t)MP : (size_t)MS) * 512 - (prompt ? (size_t)0 : (size_t)MP * 512);
        float* of = seg == 0 ? (float*)(wsb + B_U) : out + fo;
        bf16_t* ob = (bf16_t*)(wsb + (seg == 1 ? B_QB : (seg == 2 ? B_KB : B_VB)));
#pragma unroll
        for (int ai = 0; ai < 2; ++ai)
#pragma unroll
            for (int m = 0; m < 4; ++m) {
                const float sc = rs_of(rowss, row0 + ai * HALF + m * 16);
#pragma unroll
                for (int bj = 0; bj < 2; ++bj) {
                    const f32x4 v0 = acc[ai][bj][m][0] * sc, v1 = acc[ai][bj][m][1] * sc;
                    const unsigned off = o0 + (unsigned)((ai * HALF + m * 16) * 512 + bj * HALF);
                    if (seg != 1) { *GPTR(f32x4, of + off) = v0; *GPTR(f32x4, of + off + 4) = v1; }
                    if (seg != 0) {
                        if (prompt && seg == 1) { const float c2 = 0.125f * 1.4426950408889634f; *GPTR(u32x4, ob + off) = pack8(v0 * c2, v1 * c2); }
                        else if (prompt || seg == 1) *GPTR(u32x4, ob + off) = pack8(v0, v1);
                    }
                }
            }
    }
};
template <bool ZB> struct EpiResidT {
    float* X; bf16_t* XB; float* rowss_next;
    DEVI void operator()(const f32x4 (&acc)[2][2][4][2], const Unit& u, int wr, int wc, int fr, int fq) const {
        const unsigned row0 = (ZB ? (unsigned)u.z * 16u + (unsigned)u.pm : (unsigned)u.pm) * BM + wr * 64 + fr, o0 = row0 * D + u.pn * BM + wc * 32 + 8 * fq;
#pragma unroll
        for (int ai = 0; ai < 2; ++ai) {
            u32x4 xw[4][2];
#pragma unroll
            for (int m = 0; m < 4; ++m)
#pragma unroll
                for (int bj = 0; bj < 2; ++bj) xw[m][bj] = *GPTR(const u32x4, XB + (o0 + (unsigned)((ai * HALF + m * 16) * D + bj * HALF)));
#pragma unroll
            for (int m = 0; m < 4; ++m) {
                float ss = 0.f;
#pragma unroll
                for (int bj = 0; bj < 2; ++bj) {
                    const unsigned off = o0 + (unsigned)((ai * HALF + m * 16) * D + bj * HALF);
                    const u32x4 w = xw[m][bj];
                    f32x4 x0 = {bflo(w.x), bfhi(w.x), bflo(w.y), bfhi(w.y)}, x1 = {bflo(w.z), bfhi(w.z), bflo(w.w), bfhi(w.w)};
                    x0 += acc[ai][bj][m][0]; x1 += acc[ai][bj][m][1];
                    *GPTR(u32x4, XB + off) = pack8(x0, x1);
                    ss += (x0[0] * x0[0] + x0[1] * x0[1]) + (x0[2] * x0[2] + x0[3] * x0[3]) + (x1[0] * x1[0] + x1[1] * x1[1]) + (x1[2] * x1[2] + x1[3] * x1[3]);
                }
                ss += __shfl_xor(ss, 16, 64); ss += __shfl_xor(ss, 32, 64);
                if (fq == 0) *GPTR(float, rowss_next + (row0 + ai * HALF + m * 16) * 16 + u.pn * 4 + wc) = ss;
            }
            asm volatile("" ::: "memory");
        }
    }
};
typedef EpiResidT<false> EpiResid;
struct EpiSwiglu {
    const float* rowss; bf16_t* HG;
    DEVI void operator()(const f32x4 (&acc)[2][2][4][2], const Unit& u, int wr, int wc, int fr, int fq) const {
        const unsigned row0 = u.pm * BM + wr * 64 + fr, o0 = row0 * DFF + u.pn * 128 + wc * 16 + 4 * fq;
#pragma unroll
        for (int ai = 0; ai < 2; ++ai)
#pragma unroll
            for (int m = 0; m < 4; ++m) {
                const float sc = rs_of(rowss, row0 + ai * HALF + m * 16);
#pragma unroll
                for (int bj = 0; bj < 2; ++bj) {
                    const f32x4 gt = acc[ai][bj][m][0] * sc, up = acc[ai][bj][m][1] * sc;
                    f32x4 o;
#pragma unroll
                    for (int i = 0; i < 4; ++i) o[i] = gt[i] * sigmoidf_(gt[i]) * up[i];
                    u32x2 w; w.x = cvt_pk_bf16(o[0], o[1]); w.y = cvt_pk_bf16(o[2], o[3]);
                    *GPTR(u32x2, HG + (o0 + (unsigned)((ai * HALF + m * 16) * DFF + bj * 64))) = w;
                }
            }
    }
};
struct EpiSoftmax {
    bf16_t* Pb; unsigned zs1, zs2; LAS float* xl; const float* rowss;
    DEVI void operator()(const f32x4 (&acc)[2][2][4][2], const Unit& u, int wr, int wc, int fr, int fq) const {
        const float C2 = 0.0625f * 1.4426950408889634f;
        const unsigned row0 = u.pm * BM + wr * 64 + fr;
        const unsigned o0 = (unsigned)(u.z >> 2) * zs1 + (unsigned)(u.z & 3) * zs2 + row0 * D + wc * 32 + 8 * fq;
        const unsigned grow = (unsigned)(u.z >> 2) * (unsigned)TP + row0;
        float mrow[2][4];
        f32x4 (&A_)[2][2][4][2] = const_cast<f32x4 (&)[2][2][4][2]>(acc);
#pragma unroll
        for (int ai = 0; ai < 2; ++ai)
#pragma unroll
            for (int m = 0; m < 4; ++m) {
                { const float sc_ = C2 * rs_of(rowss, grow + ai * HALF + m * 16);
#pragma unroll
                  for (int bj = 0; bj < 2; ++bj)
#pragma unroll
                      for (int n = 0; n < 2; ++n) A_[ai][bj][m][n] *= sc_; }
                float mx = -3.0e38f;
#pragma unroll
                for (int bj = 0; bj < 2; ++bj)
#pragma unroll
                    for (int n = 0; n < 2; ++n) { const f32x4 v = acc[ai][bj][m][n]; mx = fmaxf(mx, fmaxf(fmaxf(v[0], v[1]), fmaxf(v[2], v[3]))); }
                mx = fmaxf(mx, __shfl_xor(mx, 16, 64)); mx = fmaxf(mx, __shfl_xor(mx, 32, 64));
                if (fq == 0) xl[(ai * HALF + wr * 64 + m * 16 + fr) * 4 + wc] = mx;
            }
        asm volatile("s_waitcnt lgkmcnt(0)\n\ts_barrier" ::: "memory");
#pragma unroll
        for (int ai = 0; ai < 2; ++ai)
#pragma unroll
            for (int m = 0; m < 4; ++m) {
                const f32x4 q = *(const LAS f32x4*)(xl + (ai * HALF + wr * 64 + m * 16 + fr) * 4);
                const float M_ = fmaxf(fmaxf(q[0], q[1]), fmaxf(q[2], q[3]));
                mrow[ai][m] = M_;
                float sm_ = 0.f;
#pragma unroll
                for (int bj = 0; bj < 2; ++bj)
#pragma unroll
                    for (int n = 0; n < 2; ++n) { const f32x4 v = acc[ai][bj][m][n];
#pragma unroll
                        for (int i = 0; i < 4; ++i) sm_ += __builtin_amdgcn_exp2f(v[i] - M_); }
                sm_ += __shfl_xor(sm_, 16, 64); sm_ += __shfl_xor(sm_, 32, 64);
                if (fq == 0) xl[1024 + (ai * HALF + wr * 64 + m * 16 + fr) * 4 + wc] = sm_;
            }
        asm volatile("s_waitcnt lgkmcnt(0)\n\ts_barrier" ::: "memory");
#pragma unroll
        for (int ai = 0; ai < 2; ++ai)
#pragma unroll
            for (int m = 0; m < 4; ++m) {
                const f32x4 q = *(const LAS f32x4*)(xl + 1024 + (ai * HALF + wr * 64 + m * 16 + fr) * 4);
                const float inv = 1.f / ((q[0] + q[1]) + (q[2] + q[3])), M_ = mrow[ai][m];
#pragma unroll
                for (int bj = 0; bj < 2; ++bj) {
                    f32x4 p0, p1;
#pragma unroll
                    for (int i = 0; i < 4; ++i) { p0[i] = __builtin_amdgcn_exp2f(acc[ai][bj][m][0][i] - M_) * inv; p1[i] = __builtin_amdgcn_exp2f(acc[ai][bj][m][1][i] - M_) * inv; }
                    *GPTR(u32x4, Pb + (o0 + (unsigned)((ai * HALF + m * 16) * D + bj * HALF))) = pack8(p0, p1);
                }
            }
    }
};
}


template <int LDA, int KDIM, int MODE>
DEVI void gemm_sample(LAS float* L, const bf16_t* A, const bf16_t* Bt, float* Xp, bf16_t* XBp, float* rowp_next, const float* rowp_cur, bf16_t* Qo, int bid, int nb) {
    const int tid = tid_opaque(), wave = __builtin_amdgcn_readfirstlane(tid >> 6), lane = tid & 63, i15 = lane & 15, kq = lane >> 4, rt = wave >> 2, ct = wave & 3;
    constexpr int KS = KDIM / 8, NS = KS / 32;
    static_assert(KS % 32 == 0, "K slice");
    LAS float* red = L + 16384;
    for (int tile = bid; tile < 256; tile += nb) {
        const int tm = tile >> 4, tn = tile & 15;
        const unsigned row = MP + tm * 32 + rt * 16 + i15;
        const unsigned off = row * D + tn * 64 + ct * 16 + 4 * kq;
        f32x4 xres = {0.f, 0.f, 0.f, 0.f}; float rsc = 1.f;
        if (MODE == 0) xres = ld4bf(XBp + off); else rsc = pg8::rs_of(rowp_cur, row);
        f32x4 acc;
        {
            const bf16_t* ap = A + (size_t)(MP + tm * 32 + i15) * LDA + wave * KS + 8 * kq; const bf16_t* bp = Bt + (size_t)(tn * 64 + i15) * KDIM + wave * KS + 8 * kq;
            f32x4 pacc[2][4];
#pragma unroll
            for (int i = 0; i < 2; ++i)
#pragma unroll
                for (int j = 0; j < 4; ++j) pacc[i][j] = (f32x4){0.f, 0.f, 0.f, 0.f};
#pragma unroll 4
            for (int s2 = 0; s2 < NS; ++s2) {
                bf16x8 af[2], bfr[4];
#pragma unroll
                for (int i = 0; i < 2; ++i) af[i] = __builtin_bit_cast(bf16x8, *GPTR(const u32x4, ap + (size_t)(i * 16) * LDA + 32 * s2));
#pragma unroll
                for (int j = 0; j < 4; ++j) bfr[j] = __builtin_bit_cast(bf16x8, *GPTR(const u32x4, bp + (size_t)(j * 16) * KDIM + 32 * s2));
#pragma unroll
                for (int i = 0; i < 2; ++i)
#pragma unroll
                    for (int j = 0; j < 4; ++j) pacc[i][j] = __builtin_amdgcn_mfma_f32_16x16x32_bf16(bfr[j], af[i], pacc[i][j], 0, 0, 0);
            }
            __syncthreads();
#pragma unroll
            for (int i = 0; i < 2; ++i)
#pragma unroll
                for (int j = 0; j < 4; ++j) *(LAS f32x4*)(L + ((wave * 8 + i * 4 + j) * 64 + lane) * 4) = pacc[i][j];
            __syncthreads();
            acc = *(const LAS f32x4*)(L + ((0 * 8 + wave) * 64 + lane) * 4);
#pragma unroll
            for (int w2 = 1; w2 < 8; ++w2) acc += *(const LAS f32x4*)(L + ((w2 * 8 + wave) * 64 + lane) * 4);
        }
        if (MODE == 0) {
            f32x4 x = xres; x += acc; (void)Xp;
            u32x2 w; w.x = cvt_pk_bf16(x[0], x[1]); w.y = cvt_pk_bf16(x[2], x[3]); *GPTR(u32x2, XBp + off) = w;
            float ss = (x[0] * x[0] + x[1] * x[1]) + (x[2] * x[2] + x[3] * x[3]);
            ss += __shfl_xor(ss, 16, 64); ss += __shfl_xor(ss, 32, 64);
            __syncthreads();
            if (kq == 0) red[(rt * 4 + ct) * 16 + i15] = ss;
            __syncthreads();
            if (ct == 0 && kq == 0) *GPTR(float, rowp_next + row * 16 + tn) = (red[(rt * 4 + 0) * 16 + i15] + red[(rt * 4 + 1) * 16 + i15]) + (red[(rt * 4 + 2) * 16 + i15] + red[(rt * 4 + 3) * 16 + i15]);
        } else {
            const f32x4 v = acc * rsc; u32x2 w; w.x = cvt_pk_bf16(v[0], v[1]); w.y = cvt_pk_bf16(v[2], v[3]); *GPTR(u32x2, Qo + off) = w;
        }
    }
}

namespace attn_body {
using bf16=__hip_bfloat16;
using bf16x8=__attribute__((ext_vector_type(8)))short;
using s16x4=__attribute__((ext_vector_type(4)))short;
using f32x16=__attribute__((ext_vector_type(16)))float;
using u32x4=__attribute__((ext_vector_type(4)))unsigned;
constexpr int BATCH=4,NHEAD=16,SEQ=4096,D=64,DM=NHEAD*D;
constexpr int NW=8,QBLK=32,QB=QBLK*NW,KVBLK=64,NQB=SEQ/QB;
constexpr int ATTN_PITCH=DM, ATTN_UNIT_ROWS=QB;
__device__ __forceinline__ int crow(int r,int hi){return (r&3)+8*(r>>2)+4*hi;}
#define SBAR() __builtin_amdgcn_sched_barrier(0)
__device__ __forceinline__ void cmask(f32x16&p0,f32x16&p1,int jb,int qrel,int hi){
  const float NEG=-INFINITY; (void)hi;
  if(jb>(qrel>>6)){
  #pragma unroll
  for(int r=0;r<16;++r){p0[r]=NEG;p1[r]=NEG;} }
}

constexpr int NSLOT=3, SLOTB=8192;
constexpr int LDS_K=0, LDS_V=NSLOT*SLOTB, LDS_WS=2*NSLOT*SLOTB, LDS_OST=LDS_WS+NW*64*4, LDS_BYTES=LDS_OST+NW*4096;
constexpr float C2=0.125f*1.4426950408889634f;
__device__ __forceinline__ void glds16(const void*gsrc,unsigned lds_dst){unsigned keep;
  asm volatile("s_mov_b32 %0, m0\n\ts_mov_b32 m0, %2\n\ts_nop 0\n\tglobal_load_lds_dwordx4 %1, off\n\ts_mov_b32 m0, %0":"=&s"(keep):"v"(gsrc),"s"(lds_dst):"memory");}
__device__ __forceinline__ float max3f(float a,float b,float c){float r;asm("v_max3_f32 %0, %1, %2, %3":"=v"(r):"v"(a),"v"(b),"v"(c));return r;}
__device__ __forceinline__ float max2f(float a,float b){float r;asm("v_max_f32_e32 %0, %1, %2":"=v"(r):"v"(a),"v"(b));return r;}
__device__ __forceinline__ float fadd_s(float a,float b){float r;asm("v_add_f32_e32 %0, %1, %2":"=v"(r):"v"(a),"v"(b));return r;}
__device__ __forceinline__ float fsub_s(float a,float b){float r;asm("v_sub_f32_e32 %0, %1, %2":"=v"(r):"v"(a),"v"(b));return r;}
typedef float f32x2_t __attribute__((ext_vector_type(2))); typedef __bf16 bf16x2_t __attribute__((ext_vector_type(2)));
__device__ __forceinline__ unsigned cvtpk_s(float lo,float hi){f32x2_t v={lo,hi};bf16x2_t b=__builtin_convertvector(v,bf16x2_t);return __builtin_bit_cast(unsigned,b);}
#define WAIT_BAR(N) asm volatile("s_waitcnt vmcnt(" #N ") lgkmcnt(0)\n\ts_barrier":::"memory")

__device__ __forceinline__ void qkt(f32x16&p0,f32x16&p1,const char*Kslot,const bf16x8*qr,const f32x16&negm,int r32,int hi){
  const char*kb=Kslot+hi*1024+r32*16;
  #pragma unroll
  for(int d0=0;d0<4;++d0){
    const bf16x8 b0=*reinterpret_cast<const bf16x8*>(kb+d0*2048);
    const bf16x8 b1=*reinterpret_cast<const bf16x8*>(kb+d0*2048+512);
    if(d0==0){p0=__builtin_amdgcn_mfma_f32_32x32x16_bf16(b0,qr[0],negm,0,0,0);p1=__builtin_amdgcn_mfma_f32_32x32x16_bf16(b1,qr[0],negm,0,0,0);}
    else{p0=__builtin_amdgcn_mfma_f32_32x32x16_bf16(b0,qr[d0],p0,0,0,0);p1=__builtin_amdgcn_mfma_f32_32x32x16_bf16(b1,qr[d0],p1,0,0,0);}}
}
typedef __attribute__((address_space(3))) const char* lds_cptr;
typedef short v4i16_t __attribute__((ext_vector_type(4)));
__device__ __forceinline__ void kload8(bf16x8*kf,lds_cptr kp){
  kf[0]=*(const __attribute__((address_space(3))) bf16x8*)(kp);      kf[1]=*(const __attribute__((address_space(3))) bf16x8*)(kp+512);
  kf[2]=*(const __attribute__((address_space(3))) bf16x8*)(kp+2048); kf[3]=*(const __attribute__((address_space(3))) bf16x8*)(kp+2560);
  kf[4]=*(const __attribute__((address_space(3))) bf16x8*)(kp+4096); kf[5]=*(const __attribute__((address_space(3))) bf16x8*)(kp+4608);
  kf[6]=*(const __attribute__((address_space(3))) bf16x8*)(kp+6144); kf[7]=*(const __attribute__((address_space(3))) bf16x8*)(kp+6656);
}
__device__ __forceinline__ void kload2(bf16x8*kf,lds_cptr kp,int j){ kf[2*j]=*(const __attribute__((address_space(3))) bf16x8*)(kp+j*2048); kf[2*j+1]=*(const __attribute__((address_space(3))) bf16x8*)(kp+j*2048+512); }
__device__ __forceinline__ s16x4 vtr(lds_cptr p){ return __builtin_bit_cast(s16x4,__builtin_amdgcn_ds_read_tr16_b64_v4i16((__attribute__((address_space(3))) v4i16_t*)p)); }
__device__ __forceinline__ float rowmax(const f32x16&p0,const f32x16&p1){
  float a=max3f(p0[0],p0[1],p1[0]),b=max3f(p0[2],p0[3],p1[1]);a=max3f(a,p1[2],p1[3]);
  #pragma unroll
  for(int r=4;r<16;r+=4){a=max3f(a,p0[r],p0[r+1]);b=max3f(b,p0[r+2],p0[r+3]);a=max3f(a,p1[r],p1[r+1]);b=max3f(b,p1[r+2],p1[r+3]);}
  const float m=max2f(a,b);
  auto rr=__builtin_amdgcn_permlane32_swap(__float_as_uint(m),__float_as_uint(m),false,false);
  return max2f(__uint_as_float(rr[0]),__uint_as_float(rr[1]));
}
__device__ __forceinline__ void pv(f32x16*o,int vb,bf16x8 pa0,bf16x8 pa1,bf16x8 pa2,bf16x8 pa3){
  #pragma unroll
  for(int d0=0;d0<2;++d0){s16x4 lo[4],hi[4];
    #pragma unroll
    for(int ks=0;ks<4;++ks){
      asm volatile("ds_read_b64_tr_b16 %0,%1 offset:%c2":"=&v"(lo[ks]):"v"(vb),"i"(d0*4096+ks*1024):"memory");
      asm volatile("ds_read_b64_tr_b16 %0,%1 offset:%c2":"=&v"(hi[ks]):"v"(vb),"i"(d0*4096+ks*1024+512):"memory");}
    asm volatile("s_waitcnt lgkmcnt(0)":::"memory");SBAR();
    #define PK(k) (bf16x8){lo[k][0],lo[k][1],lo[k][2],lo[k][3],hi[k][0],hi[k][1],hi[k][2],hi[k][3]}
    o[d0]=__builtin_amdgcn_mfma_f32_32x32x16_bf16(pa0,PK(0),o[d0],0,0,0);
    o[d0]=__builtin_amdgcn_mfma_f32_32x32x16_bf16(pa1,PK(1),o[d0],0,0,0);
    o[d0]=__builtin_amdgcn_mfma_f32_32x32x16_bf16(pa2,PK(2),o[d0],0,0,0);
    o[d0]=__builtin_amdgcn_mfma_f32_32x32x16_bf16(pa3,PK(3),o[d0],0,0,0);
    #undef PK
  }
}

#ifndef ATTN_STORE16
#define ATTN_STORE16(p,v) (*(u32x4*)(p)=(v))
#endif
template<int THRL> __device__ __forceinline__ void attn_unit(int b,int h,int qb,const bf16*Q,const bf16*__restrict__ K,const bf16*__restrict__ V,bf16*O,char*shm){
  const int tid=tid_opaque(),lane=tid&63,r32=lane&31,hi=lane>>5; const int wid=__builtin_amdgcn_readfirstlane(tid>>6);
  const long rowbase=(long)b*SEQ; const int q0=qb*QB;
  constexpr int PIN=512;
  const bf16*Qw=Q+(rowbase+q0+wid*QBLK)*PIN+(h>>1)*D;
  const bf16*Kh=K+rowbase*PIN+(h>>1)*D,*Vh=V+rowbase*PIN+((h>>2)*2+(h&1))*D;
  const unsigned lds0=(unsigned)(uintptr_t)shm;
  float*wsf=(float*)(shm+LDS_WS)+wid*64;
  const bf16*ksrc=Kh+(long)lane*PIN+wid*8;
  const bf16*vsrc=Vh+(long)(16*(wid&3)+(lane>>2))*PIN+(wid>>2)*32+(lane&3)*8;
  const unsigned kdst=lds0+LDS_K+wid*1024, vdst=lds0+LDS_V+wid*1024;
  #define DMA_K(t,slot) glds16(ksrc+(long)(t)*KVBLK*PIN,(unsigned)__builtin_amdgcn_readfirstlane(kdst+(slot)))
  #define DMA_V(t,slot) glds16(vsrc+(long)(t)*KVBLK*PIN,(unsigned)__builtin_amdgcn_readfirstlane(vdst+(slot)))
  const int vb0=(int)(lds0+LDS_V)+((lane>>4)&1)*32+(lane&3)*8+(4*hi+((lane&15)>>2))*64;
  const char*Kbase=shm+LDS_K; bf16x8 kf[8];
  const lds_cptr shm3=(lds_cptr)shm; const lds_cptr kp0=shm3+LDS_K+hi*1024+r32*16; const lds_cptr vp0=shm3+LDS_V+((lane>>4)&1)*32+(lane&3)*8+(4*hi+((lane&15)>>2))*64;
  const int NT=(q0+QB)/KVBLK;
  DMA_K(0,0);DMA_V(0,0);DMA_K(1,SLOTB);
  bf16x8 qr[4];
  #pragma unroll
  for(int d0=0;d0<4;++d0)qr[d0]=*reinterpret_cast<const bf16x8*>(&Qw[(long)r32*PIN+d0*16+hi*8]);
  float mhat=0.f,l_reg=0.f;f32x16 o[2];o[0]=f32x16{};o[1]=f32x16{};f32x16 negm=f32x16{};asm volatile("":"+v"(negm));
  const int qrel=wid*QBLK+r32;
  #define CMASK(P0,P1,t) do{int jb_=(t)-(NT-4); if(jb_>=0)cmask(P0,P1,jb_,qrel,hi);}while(0)
  bool resc=false;
  #define START(P0,P1) do{ const float rm=rowmax(P0,P1); resc=false; \
    { const float dl=rm; mhat=fadd_s(mhat,dl); \
      _Pragma("unroll") for(int r=0;r<16;++r){P0[r]=fsub_s(P0[r],dl);P1[r]=fsub_s(P1[r],dl);} \
      _Pragma("unroll") for(int r=0;r<16;++r)negm[r]=-mhat; asm volatile("":"+v"(negm)); } \
    _Pragma("unroll") for(int r=0;r<16;++r)P0[r]=__builtin_amdgcn_exp2f(P0[r]); }while(0)
  #define RESC() do{ if(resc){ asm volatile("s_waitcnt lgkmcnt(0)":::"memory"); \
      _Pragma("unroll") for(int d_=0;d_<2;++d_) _Pragma("unroll") for(int r=0;r<16;++r)o[d_][r]*=wsf[crow(r,hi)]; } }while(0)
  f32x16 pA0,pA1,pB0,pB1;
  int sl_prev=0,sl_cur=0,sl_next=SLOTB;
  #define ROT() do{sl_prev=sl_cur;sl_cur=sl_next;sl_next=(sl_next==(NSLOT-1)*SLOTB)?0:sl_next+SLOTB;}while(0)
  DMA_K(2,2*SLOTB);
  WAIT_BAR(3);
  qkt(pA0,pA1,Kbase,qr,negm,r32,hi);asm volatile("s_nop 15\n\ts_nop 7":"+v"(pA0),"+v"(pA1));CMASK(pA0,pA1,0);
  START(pA0,pA1);
  _Pragma("unroll") for(int r=0;r<16;++r)pA1[r]=__builtin_amdgcn_exp2f(pA1[r]);
  WAIT_BAR(0);
  DMA_K(3,0);DMA_V(1,SLOTB);
  ROT();
  kload8(kf,kp0+sl_cur);
  WAIT_BAR(2);
  s16x4 vlo[8],vhi[8]; u32x4 pw0,pw1,pw2,pw3;
  #define PKW(P,B) cvtpk_s(P[B],P[B+1])
  #define PAF(k) __builtin_bit_cast(bf16x8,pw##k)
  #define VFR(i) (bf16x8){vlo[i][0],vlo[i][1],vlo[i][2],vlo[i][3],vhi[i][0],vhi[i][1],vhi[i][2],vhi[i][3]}
  #define PIN(x) asm volatile("":"+v"(x))
  #define MX3(a,b,c) __builtin_fmaxf(__builtin_fmaxf((a),(b)),(c))
  #define GAPA(MF,A0,A1,A2,A3,W0,W1,PW) do{ MF; sacc+=A0; sacc+=A1; sacc+=A2; sacc+=A3; PIN(sacc); W0; W1; PIN(PW); SBAR(); }while(0)
  #define EX(v) __builtin_amdgcn_exp2f(v)
  #define GAPB(MF,X,B) do{ MF; X[B]=EX(X[B]); X[B+1]=EX(X[B+1]); X[B+2]=EX(X[B+2]); X[B+3]=EX(X[B+3]); PIN(X); SBAR(); }while(0)
  #define VRD(i) do{ vlo[i]=vtr(vp_+(((i)>>2)*4096+((i)&3)*1024)); vhi[i]=vtr(vp_+(((i)>>2)*4096+((i)&3)*1024+512)); }while(0)
  #define KRD(G,j) do{ if(G){ kload2(kf,kp0+sl_next,j); SBAR(); } }while(0)
  #define STEP(C0,C1,P0,P1,t,GK,GV,GL) do{ SBAR(); \
    const lds_cptr vp_=vp0+sl_prev; \
    VRD(0); SBAR(); float sacc=(P0[0]+P0[1]); \
    GAPA(C0=__builtin_amdgcn_mfma_f32_32x32x16_bf16(kf[0],qr[0],negm,0,0,0), P0[2],P0[3],P0[4],P0[5],     pw0[0]=PKW(P0,0), pw0[1]=PKW(P0,2), pw0); \
    VRD(4); SBAR(); GAPA(C1=__builtin_amdgcn_mfma_f32_32x32x16_bf16(kf[1],qr[0],negm,0,0,0), P0[6],P0[7],P0[8],P0[9],     pw0[2]=PKW(P0,4), pw0[3]=PKW(P0,6), pw0); \
    VRD(1); SBAR(); GAPA(C0=__builtin_amdgcn_mfma_f32_32x32x16_bf16(kf[2],qr[1],C0,0,0,0),   P0[10],P0[11],P0[12],P0[13], pw1[0]=PKW(P0,8), pw1[1]=PKW(P0,10), pw1); \
    VRD(5); SBAR(); GAPA(C1=__builtin_amdgcn_mfma_f32_32x32x16_bf16(kf[3],qr[1],C1,0,0,0),   P0[14],P0[15],P1[0],P1[1],   pw1[2]=PKW(P0,12),pw1[3]=PKW(P0,14), pw1); \
    VRD(2); SBAR(); GAPA(C0=__builtin_amdgcn_mfma_f32_32x32x16_bf16(kf[4],qr[2],C0,0,0,0),   P1[2],P1[3],P1[4],P1[5],     pw2[0]=PKW(P1,0), pw2[1]=PKW(P1,2), pw2); \
    VRD(6); SBAR(); GAPA(C1=__builtin_amdgcn_mfma_f32_32x32x16_bf16(kf[5],qr[2],C1,0,0,0),   P1[6],P1[7],P1[8],P1[9],     pw2[2]=PKW(P1,4), pw2[3]=PKW(P1,6), pw2); \
    VRD(3); SBAR(); GAPA(C0=__builtin_amdgcn_mfma_f32_32x32x16_bf16(kf[6],qr[3],C0,0,0,0),   P1[10],P1[11],P1[12],P1[13], pw3[0]=PKW(P1,8), pw3[1]=PKW(P1,10), pw3); \
    VRD(7); SBAR(); GAPA(C1=__builtin_amdgcn_mfma_f32_32x32x16_bf16(kf[7],qr[3],C1,0,0,0),   P1[14],P1[15],0.f,0.f,       pw3[2]=PKW(P1,12),pw3[3]=PKW(P1,14), pw3); \
    l_reg+=sacc; \
    if(GK){DMA_K((t)+3,sl_cur);} if(GV){DMA_V((t)+1,sl_next);} \
    CMASK(C0,C1,t); \
    { float a=MX3(C0[0],C0[1],C1[0]),b=MX3(C0[2],C0[3],C1[1]); a=MX3(a,C1[2],C1[3]); \
      _Pragma("unroll") for(int r=4;r<16;r+=4){a=MX3(a,C0[r],C0[r+1]);b=MX3(b,C0[r+2],C0[r+3]);a=MX3(a,C1[r],C1[r+1]);b=MX3(b,C1[r+2],C1[r+3]);} \
      float rm=__builtin_fmaxf(a,b); { auto rr=__builtin_amdgcn_permlane32_swap(__float_as_uint(rm),__float_as_uint(rm),false,false); rm=__builtin_fmaxf(__uint_as_float(rr[0]),__uint_as_float(rr[1])); } \
      resc=false; \
      if(__builtin_expect(__any(rm>(float)THRL),0)){ const float dl=__builtin_fmaxf(rm,0.f); mhat+=dl; \
        _Pragma("unroll") for(int r=0;r<16;++r){C0[r]-=dl;C1[r]-=dl;} \
        _Pragma("unroll") for(int r=0;r<16;++r)negm[r]=-mhat; asm volatile("":"+v"(negm)); \
        const float f=__builtin_amdgcn_exp2f(-dl); l_reg*=f; if(hi==0)wsf[r32]=f; resc=true; } } \
    SBAR(); \
    GAPB(o[0]=__builtin_amdgcn_mfma_f32_32x32x16_bf16(PAF(0),VFR(0),o[0],0,0,0), C0,0); \
    GAPB(o[1]=__builtin_amdgcn_mfma_f32_32x32x16_bf16(PAF(0),VFR(4),o[1],0,0,0), C0,4); \
    KRD(GL,0); GAPB(o[0]=__builtin_amdgcn_mfma_f32_32x32x16_bf16(PAF(1),VFR(1),o[0],0,0,0), C0,8); \
    KRD(GL,1); GAPB(o[1]=__builtin_amdgcn_mfma_f32_32x32x16_bf16(PAF(1),VFR(5),o[1],0,0,0), C0,12); \
    KRD(GL,2); GAPB(o[0]=__builtin_amdgcn_mfma_f32_32x32x16_bf16(PAF(2),VFR(2),o[0],0,0,0), C1,0); \
    KRD(GL,3); GAPB(o[1]=__builtin_amdgcn_mfma_f32_32x32x16_bf16(PAF(2),VFR(6),o[1],0,0,0), C1,4); \
    GAPB(o[0]=__builtin_amdgcn_mfma_f32_32x32x16_bf16(PAF(3),VFR(3),o[0],0,0,0), C1,8); \
    GAPB(o[1]=__builtin_amdgcn_mfma_f32_32x32x16_bf16(PAF(3),VFR(7),o[1],0,0,0), C1,12); \
    }while(0)
  int t=1;
  #undef CMASK
  #define CMASK(P0,P1,t) do{}while(0)
  for(;t+5<NT;t+=2){
    STEP(pB0,pB1,pA0,pA1,t,true,true,true);     WAIT_BAR(2); RESC(); ROT();
    STEP(pA0,pA1,pB0,pB1,t+1,true,true,true);   WAIT_BAR(2); RESC(); ROT();
  }
  #undef CMASK
  #define CMASK(P0,P1,t) do{int jb_=(t)-(NT-4); if(jb_>=0)cmask(P0,P1,jb_,qrel,hi);}while(0)
  #define ENDW(tt) do{ if((tt)+3<NT){WAIT_BAR(2);} else if((tt)+2<NT){WAIT_BAR(1);} else {WAIT_BAR(0);} }while(0)
  for(;t+1<NT;t+=2){
    STEP(pB0,pB1,pA0,pA1,t,(t+3<NT),(t+1<NT),(t+1<NT));       ENDW(t);   RESC(); ROT();
    STEP(pA0,pA1,pB0,pB1,t+1,(t+4<NT),(t+2<NT),(t+2<NT));     ENDW(t+1); RESC(); ROT();
  }
  STEP(pB0,pB1,pA0,pA1,NT-1,false,false,false); RESC();
  { float sacc=pB0[0]+pB0[1]; _Pragma("unroll") for(int r=2;r<16;++r)sacc+=pB0[r]; _Pragma("unroll") for(int r=0;r<16;++r)sacc+=pB1[r]; l_reg+=sacc;
    pw0=(u32x4){PKW(pB0,0),PKW(pB0,2),PKW(pB0,4),PKW(pB0,6)};pw1=(u32x4){PKW(pB0,8),PKW(pB0,10),PKW(pB0,12),PKW(pB0,14)};pw2=(u32x4){PKW(pB1,0),PKW(pB1,2),PKW(pB1,4),PKW(pB1,6)};pw3=(u32x4){PKW(pB1,8),PKW(pB1,10),PKW(pB1,12),PKW(pB1,14)};
    SBAR(); pv(o,vb0+sl_cur,PAF(0),PAF(1),PAF(2),PAF(3)); }
  #undef PKW
  #undef PAF
  #undef VFR
  #undef PIN
  #undef MX3
  #undef GAPA
  #undef GAPB
  #undef EX
  #undef VRD
  #undef KRD
  #undef STEP
  #undef ENDW
  {auto rr=__builtin_amdgcn_permlane32_swap(__float_as_uint(l_reg),__float_as_uint(l_reg),false,false);l_reg=__uint_as_float(rr[0])+__uint_as_float(rr[1]);}
  if(hi==0)wsf[32+r32]=l_reg;asm volatile("s_waitcnt lgkmcnt(0)":::"memory");
  float rli[16];
  #pragma unroll
  for(int r=0;r<16;++r)rli[r]=__builtin_amdgcn_rcpf(wsf[32+crow(r,hi)]);
  bf16*Ow=O+(rowbase+q0+wid*QBLK)*DM+h*D;
  { bf16*stg=(bf16*)(shm+LDS_OST)+wid*2048;
    #pragma unroll
    for(int r=0;r<16;++r){const int orow=crow(r,hi);
      #pragma unroll
      for(int d0=0;d0<2;++d0)stg[orow*64+d0*32+r32]=__float2bfloat16(o[d0][r]*rli[r]);}
    asm volatile("s_waitcnt lgkmcnt(0)":::"memory");
    #pragma unroll
    for(int i=0;i<4;++i){const int row=i*8+(lane>>3),ch=lane&7; const u32x4 v=*(const u32x4*)(stg+row*64+ch*8); ATTN_STORE16(Ow+(long)row*DM+ch*8,v);} }
  asm volatile("s_waitcnt lgkmcnt(0)\n\ts_barrier":::"memory");
  #undef DMA_K
  #undef DMA_V
  #undef CMASK
  #undef START
  #undef RESC
  #undef ROT
}
constexpr int ATTN_LDS_BYTES=LDS_BYTES;
struct AttnTensors { const bf16* Q; const bf16* K; const bf16* V; bf16* O; };
struct AttnUnit { int bh; int qb; };
struct StaticOrder {
  int vcu;
  __device__ __forceinline__ explicit StaticOrder(int grid,int block):vcu((block%8)*(grid/8)+block/8){}
  __device__ __forceinline__ bool next(int i,AttnUnit&u)const{ if(i>=4)return false; const int s=vcu&3; u.bh=vcu>>2; u.qb=(i==0)?s:(i==1)?7-s:(i==2)?8+s:15-s; return true; }
  __device__ __forceinline__ void a_ready(const AttnUnit&)const{}
  __device__ __forceinline__ void done(const AttnUnit&)const{}
};
template<class Sched,int THRL=8> __device__ __forceinline__ void attn_phase(char*lds,const AttnTensors&T,const Sched&S){
  AttnUnit u;
  for(int i=0;S.next(i,u);++i){ S.a_ready(u); attn_unit<THRL>(u.bh/NHEAD,u.bh%NHEAD,u.qb,T.Q,T.K,T.V,T.O,lds); S.done(u); }
}
#undef SBAR
#undef WAIT_BAR
}


DEVI void conv_T(const float* W, int K, int N, int ldw, bf16_t* WT, int ldt, int koff, const float* gain, int rmode, int rot, int bid, int nb) {
    bid = (bid + rot) % nb;
    const int TIDX = tid_opaque();
    const int wave = TIDX >> 6, lane = TIDX & 63, nblk = N >> 4, total = (K >> 6) * nblk;
#pragma unroll 2
    for (int st = bid * 8 + wave; st < total; st += nb * 8) {
        const int k = (st / nblk) * 64 + lane, n0 = (st % nblk) * 16;
        const float g = gain ? gain[k] : 1.f;
        const float* wp = W + (size_t)k * ldw + n0;
        const f32x4 v0 = *GPTR(const f32x4, wp), v1 = *GPTR(const f32x4, wp + 4), v2 = *GPTR(const f32x4, wp + 8), v3 = *GPTR(const f32x4, wp + 12);
        const float vv[16] = {v0[0], v0[1], v0[2], v0[3], v1[0], v1[1], v1[2], v1[3], v2[0], v2[1], v2[2], v2[3], v3[0], v3[1], v3[2], v3[3]};
#pragma unroll
        for (int j = 0; j < 16; ++j) {
            const int n = n0 + j; const int row = rmode == 0 ? n : ((n >> 2) * 8 + (n & 3) + (rmode == 2 ? 4 : 0));
            *GPTR(bf16_t, WT + (size_t)row * ldt + koff + k) = (bf16_t)(cvt_pk_bf16(vv[j] * g, 0.f) & 0xffffu);
        }
    }
}
DEVI void conv_small(const float* W, int ldw, int k_valid, int n_valid, bf16_t* WT, int R, int C, int bid, int nb) {
    const int TIDX = tid_opaque();
    const int total = R * C;
#pragma unroll 4
    for (int i = bid * NT + TIDX; i < total; i += nb * NT) { const int r = i / C, cc = i % C; float v = 0.f; if (r < n_valid && cc < k_valid) v = W[(size_t)cc * ldw + r];
        WT[i] = (bf16_t)(cvt_pk_bf16(v, 0.f) & 0xffffu); }
}
DEVI void conv_poolw(const Ctx& c, int e, bf16_t* WT, int bid, int nb) {
    const int TIDX = tid_opaque();
    const float* Wg = CIN(I_EPW) + (size_t)e * 4 * 128 * 128; const float* scl = CIN(I_EPS) + e * PW; const float* wo = CIN(I_EWOUT) + (size_t)e * D * D;
    for (int i = bid * NT + TIDX; i < 1024 * 128; i += nb * NT) {
        const int n = i & 1023, kg = __builtin_amdgcn_readfirstlane(i >> 10), k0 = kg * 4, g = k0 >> 7, kk0 = k0 & 127;
        const float* wgp = Wg + (size_t)(g * 128 + kk0) * 128; const float* sp = scl + g * 128; const float* wop = wo + (size_t)(g * 128) * D + n;
        float a[4] = {0.f, 0.f, 0.f, 0.f};
#pragma unroll 16
        for (int jj = 0; jj < 128; ++jj) {
            const float w = wop[(size_t)jj * D] * sp[jj];
#pragma unroll
            for (int j = 0; j < 4; ++j) a[j] = fmaf(wgp[j * 128 + jj], w, a[j]);
        }
        u32x2 w2; w2.x = cvt_pk_bf16(a[0], a[1]); w2.y = cvt_pk_bf16(a[2], a[3]);
        *(u32x2*)(WT + (size_t)n * D + k0) = w2;
    }
}
DEVI float cs_ld(const float* W, int ldw, int kv, int nv, int C, int total, int i) { float v = 0.f; if (i < total) { const int r = i / C, cc = i % C; if (r < nv && cc < kv) v = W[(size_t)cc * ldw + r]; } return v; }
DEVI void cs_st(bf16_t* WT, int total, int i, float v) { if (i < total) WT[i] = (bf16_t)(cvt_pk_bf16(v, 0.f) & 0xffffu); }
DEVI void conv_rowgain(const float* W, const float* gain, bf16_t* O, int bid, int nb) {
    const int TIDX = tid_opaque();
    for (int i = bid * NT + TIDX; i < 1024 * 1024 / 8; i += nb * NT) {
        const float g = gain[i >> 7];
        const f32x4 a = *GPTR(const f32x4, W + (size_t)i * 8), b = *GPTR(const f32x4, W + (size_t)i * 8 + 4);
        *GPTR(u32x4, O + (size_t)i * 8) = pack8(a * g, b * g);
    }
}
DEVI void ph_prologue(const Ctx& c, float* sm, int bid, int nb) {
    const int TIDX = tid_opaque();
    unsigned char* ws = CWS;
    for (int e = 0; e < 2; ++e) {
        conv_T(CIN(I_EWIN) + (size_t)e * D * 2048, D, 2048, 2048, (bf16_t*)(ws + B_WIN) + (size_t)e * 2048 * D, D, 0, CIN(I_NMIX) + (2 * e) * D, 0, 0, bid, nb);
        conv_T(CIN(I_EWOUT) + (size_t)e * D * D + (size_t)512 * D, 512, D, D, (bf16_t*)(ws + B_WOUT) + (size_t)e * D * D, D, 512, nullptr, 0, 0, bid, nb);
        conv_poolw(c, e, (bf16_t*)(ws + B_WOUT) + (size_t)e * D * D, bid, nb);
    }
    for (int o = 0; o < 2; ++o) {
        conv_T(CIN(I_WR) + (size_t)o * D * D, D, D, D, (bf16_t*)(ws + B_WR) + (size_t)o * D * D, D, 0, nullptr, 0, 64, bid, nb);
        conv_T(CIN(I_WK) + (size_t)o * D * D, D, D, D, (bf16_t*)(ws + B_WK) + (size_t)o * D * D, D, 0, nullptr, 0, 192, bid, nb);
        conv_T(CIN(I_WV) + (size_t)o * D * D, D, D, D, (bf16_t*)(ws + B_WV) + (size_t)o * D * D, D, 0, nullptr, 0, 64, bid, nb);
        conv_T(CIN(I_WO) + (size_t)o * D * D, D, D, D, (bf16_t*)(ws + B_WO) + (size_t)o * D * D, D, 0, nullptr, 0, 192, bid, nb);
        bf16_t* l1 = (bf16_t*)(ws + B_L1) + (size_t)o * 4 * 256 * D;
        {
            const int i0 = bid * NT + TIDX, i1 = i0 + nb * NT;
#define CS_JOB(name, W_, ldw_, kv_, nv_, WT_, R_, C_) const float* name##w = (W_); bf16_t* name##t = (WT_); const int name##l = (ldw_), name##k = (kv_), name##n = (nv_), name##c = (C_), name##tot = (R_) * (C_); \
            const float name##0 = cs_ld(name##w, name##l, name##k, name##n, name##c, name##tot, i0), name##1 = cs_ld(name##w, name##l, name##k, name##n, name##c, name##tot, i1)
#define CS_PUT(name) do { cs_st(name##t, name##tot, i0, name##0); cs_st(name##t, name##tot, i1, name##1); } while (0)
            const int ov = o > 0 ? o - 1 : 0; const int vv = o > 0 ? 32 : 0;
            CS_JOB(jw1, CIN(I_W1) + (size_t)o * D * 64, 64, D, 64, l1, 256, D);
            CS_JOB(ja1, CIN(I_A1) + (size_t)o * D * 64, 64, D, 64, l1 + (size_t)256 * D, 256, D);
            CS_JOB(jg1, CIN(I_G1) + (size_t)o * D * 160, 160, D, 160, l1 + (size_t)2 * 256 * D, 256, D);
            CS_JOB(jv1, CIN(I_V1) + (size_t)ov * D * 32, 32, D, vv, l1 + (size_t)3 * 256 * D, 256, D);
            CS_JOB(jw2, CIN(I_W2) + (size_t)o * 64 * D, D, 64, D, (bf16_t*)(ws + B_L2W) + (size_t)o * D * 128, D, 128);
            CS_JOB(ja2, CIN(I_A2) + (size_t)o * 64 * D, D, 64, D, (bf16_t*)(ws + B_L2A) + (size_t)o * D * 128, D, 128);
            CS_JOB(jg2, CIN(I_G2) + (size_t)o * 160 * D, D, 160, D, (bf16_t*)(ws + B_L2G) + (size_t)o * D * 256, D, 256);
            CS_JOB(jv2, CIN(I_V2) + (size_t)ov * 32 * D, D, vv, D, (bf16_t*)(ws + B_L2V) + (size_t)o * D * 128, D, 128);
            CS_PUT(jw1); CS_PUT(ja1); CS_PUT(jg1); if (o > 0) CS_PUT(jv1);
            CS_PUT(jw2); CS_PUT(ja2); CS_PUT(jg2); if (o > 0) CS_PUT(jv2);
#undef CS_JOB
#undef CS_PUT
        }
    }
    for (int l = 0; l < 4; ++l) {
        conv_T(CIN(I_XWQ) + (size_t)l * D * D, D, D, D, (bf16_t*)(ws + B_XWQ) + (size_t)l * D * D, D, 0, CIN(I_NXA) + l * D, 0, 64, bid, nb);
        conv_rowgain(CIN(I_XWQ) + (size_t)l * D * D, CIN(I_NXA) + l * D, (bf16_t*)(ws + B_XWQN) + (size_t)l * D * D, bid, nb);
        conv_T(CIN(I_XWK) + (size_t)l * D * D, D, D, D, (bf16_t*)(ws + B_XWK) + (size_t)l * D * D, D, 0, nullptr, 0, 192, bid, nb);
        conv_T(CIN(I_XWV) + (size_t)l * D * D, D, D, D, (bf16_t*)(ws + B_XWV) + (size_t)l * D * D, D, 0, nullptr, 0, 64, bid, nb);
        conv_T(CIN(I_XWO) + (size_t)l * D * D, D, D, D, (bf16_t*)(ws + B_XWO) + (size_t)l * D * D, D, 0, nullptr, 0, 192, bid, nb);
        conv_T(CIN(I_FWG) + (size_t)l * D * DFF, D, DFF, DFF, (bf16_t*)(ws + B_FGU) + (size_t)l * 5632 * D, D, 0, CIN(I_NFFN) + l * D, 1, 64, bid, nb);
        conv_T(CIN(I_FWU) + (size_t)l * D * DFF, D, DFF, DFF, (bf16_t*)(ws + B_FGU) + (size_t)l * 5632 * D, D, 0, CIN(I_NFFN) + l * D, 2, 160, bid, nb);
        conv_T(CIN(I_FWD) + (size_t)l * DFF * D, DFF, D, D, (bf16_t*)(ws + B_FWD) + (size_t)l * D * DFF, DFF, 0, nullptr, 0, 0, bid, nb);
    }
    {
        const int wave = TIDX >> 6, lane = TIDX & 63;
        bf16_t* XB = (bf16_t*)(ws + B_XB); float* rowss = (float*)(ws + B_ROWP);
        const int step = nb * 8;
        for (int r0 = bid * 8 + wave; r0 < M + 1024; r0 += 3 * step) {
            f32x4 v[3][4];
#pragma unroll
            for (int j = 0; j < 3; ++j) { const int r = r0 + j * step;
                if (r < M + 1024) { const float* xr = r < MP ? CIN(I_XP) + (size_t)r * D : (r < M ? CIN(I_XS) + (size_t)(r - MP) * D : CIN(I_MEMP) + (size_t)(r - M) * D);
#pragma unroll
                    for (int i = 0; i < 4; ++i) v[j][i] = *GPTR(const f32x4, xr + 4 * (lane + 64 * i)); } }
#pragma unroll
            for (int j = 0; j < 3; ++j) { const int r = r0 + j * step;
                if (r < M + 1024) { bf16_t* o = r < M ? XB + (size_t)r * D : (bf16_t*)(ws + B_MEMB) + (size_t)(r - M) * D;
                    float ss = 0.f;
#pragma unroll
                    for (int i = 0; i < 4; ++i) { const f32x4 x = v[j][i]; ss += (x[0] * x[0] + x[1] * x[1]) + (x[2] * x[2] + x[3] * x[3]);
                        u32x2 w; w.x = cvt_pk_bf16(x[0], x[1]); w.y = cvt_pk_bf16(x[2], x[3]); *GPTR(u32x2, o + 4 * (lane + 64 * i)) = w; }
                    if (r < M) { ss = wave_sum(ss); if (lane < 16) rowss[(size_t)r * 16 + lane] = lane == 0 ? ss : 0.f; } } }
        }
    }
}

DEVI float lam_init_of(int layer) { return 0.8f - 0.6f * __expf(-0.3f * (float)layer); }
DEVI float lam_of(const Ctx& c, int e) {
    float s1 = 0.f, s2 = 0.f;
    for (int i = 0; i < 64; ++i) { s1 += CIN(I_LQ1)[e * 64 + i] * CIN(I_LK1)[e * 64 + i]; s2 += CIN(I_LQ2)[e * 64 + i] * CIN(I_LK2)[e * 64 + i]; }
    return __expf(s1) - __expf(s2) + lam_init_of(2 * e);
}
DEVI void ph_pool_prep(const Ctx& c, int e, int bid, int nb) {
    const int TIDX = tid_opaque();
    const float* Uf = (const float*)(CWS + B_U); bf16_t* CAT = (bf16_t*)(CWS + B_CAT);
    const size_t total = (size_t)M * 128;
    for (size_t idx = (size_t)bid * NT + TIDX; idx < total; idx += (size_t)nb * NT) {
        const int row = (int)(idx >> 7), col = (int)(idx & 127) * 4;
        const int w = 2 << (col >> 7);
        const bool prompt = row < MP;
        const int b = prompt ? row / TP : (row - MP) / TS, t = prompt ? row % TP : (row - MP) % TS;
        const float4 u = *(const float4*)(Uf + (size_t)row * PW + col);
        float4 s = make_float4(0.f, 0.f, 0.f, 0.f);
        for (int i = 0; i < w; ++i) {
            const int tt = t - i;
            float4 v = make_float4(0.f, 0.f, 0.f, 0.f);
            if (tt >= 0) v = *(const float4*)(Uf + (size_t)(row - i) * PW + col);
            else if (!prompt) v = *(const float4*)(CIN(I_SPOOL) + ((size_t)(e * NBS + b) * PHIST + (PHIST + tt)) * PW + col);
            s.x += v.x; s.y += v.y; s.z += v.z; s.w += v.w;
        }
        const float ic = 1.f / (prompt ? (float)((t + 1) < w ? (t + 1) : w) : (float)w);
        u32x2 o; o.x = cvt_pk_bf16(s.x * ic - u.x, s.y * ic - u.y); o.y = cvt_pk_bf16(s.z * ic - u.z, s.w * ic - u.w);
        *(u32x2*)(CAT + (size_t)row * D + col) = o;
        if (prompt) { if (t >= TP - PHIST) *(float4*)(COUT + O_PPOOL + ((size_t)(e * NBP + b) * PHIST + (t - (TP - PHIST))) * PW + col) = u; }
        else { if (t >= 1) *(float4*)(COUT + O_SPOOL + ((size_t)(e * NBS + b) * PHIST + (t - 1)) * PW + col) = u; }
    }
}
DEVI void ph_diffattn(const Ctx& c, int e, int item0, int bid, int nb, float* sm) {
    const int TIDX = tid_opaque();
    const bf16_t* QB = (const bf16_t*)(CWS + B_QB); const bf16_t* KB = (const bf16_t*)(CWS + B_KB); const bf16_t* VB = (const bf16_t*)(CWS + B_VB); bf16_t* CAT = (bf16_t*)(CWS + B_CAT);
    const int t = TIDX, qi = t & 63, map = (t >> 6) & 1, part = t >> 7;
    float* Ks = sm; float* Vs = sm + 32 * 128;
    const float lam = lam_of(c, e), li = lam_init_of(2 * e);
    for (int item = item0 + bid; item < 1152; item += nb) {
        int b, h, nq, qrow0, n_past, n_new, newrow0; const float* pastK = nullptr; const float* pastV = nullptr;
        if (item < 1024) { b = item >> 8; h = (item >> 6) & 3; const int ch = item & 63; nq = 64; qrow0 = b * TP + ch * 64; n_past = 0; n_new = (ch + 1) * 64; newrow0 = b * TP; }
        else { const int it = item - 1024; b = it >> 2; h = it & 3; nq = TS; qrow0 = MP + b * TS; n_past = PAST; n_new = TS; newrow0 = MP + b * TS;
               pastK = CIN(I_CDK) + ((size_t)(e * NBS + b) * PAST) * 512 + h * 128; pastV = CIN(I_CDV) + ((size_t)(e * NBS + b) * PAST) * 512 + h * 128; }
        const bool act = qi < nq;
        float q[64], o[32];
        {
            const bf16_t* qp = QB + (size_t)(qrow0 + (act ? qi : 0)) * 512 + h * 128 + map * 64;
#pragma unroll
            for (int d = 0; d < 64; d += 8) { const u32x4 v = *(const u32x4*)(qp + d);
                q[d] = bflo(v.x) * 0.125f; q[d + 1] = bfhi(v.x) * 0.125f; q[d + 2] = bflo(v.y) * 0.125f; q[d + 3] = bfhi(v.y) * 0.125f;
                q[d + 4] = bflo(v.z) * 0.125f; q[d + 5] = bfhi(v.z) * 0.125f; q[d + 6] = bflo(v.w) * 0.125f; q[d + 7] = bfhi(v.w) * 0.125f; }
        }
#pragma unroll
        for (int d = 0; d < 32; ++d) o[d] = 0.f;
        float mx = -1e30f, l = 0.f;
        const int total = n_past + n_new;
        for (int k0 = 0; k0 < total; k0 += 32) {
            __syncthreads();
            {
                const int key = t >> 4, c8 = (t & 15) * 8, kg = k0 + key;
                float4 k0v = make_float4(0.f, 0.f, 0.f, 0.f), k1v = k0v, v0v = k0v, v1v = k0v;
                if (kg < total) {
                    if (kg < n_past) { const float* kp = pastK + (size_t)kg * 512 + c8; const float* vp = pastV + (size_t)kg * 512 + c8;
                        k0v = *(const float4*)kp; k1v = *(const float4*)(kp + 4); v0v = *(const float4*)vp; v1v = *(const float4*)(vp + 4); }
                    else { const size_t off = (size_t)(newrow0 + kg - n_past) * 512 + h * 128 + c8; const u32x4 kw = *(const u32x4*)(KB + off), vw = *(const u32x4*)(VB + off);
                        k0v = make_float4(bflo(kw.x), bfhi(kw.x), bflo(kw.y), bfhi(kw.y)); k1v = make_float4(bflo(kw.z), bfhi(kw.z), bflo(kw.w), bfhi(kw.w));
                        v0v = make_float4(bflo(vw.x), bfhi(vw.x), bflo(vw.y), bfhi(vw.y)); v1v = make_float4(bflo(vw.z), bfhi(vw.z), bflo(vw.w), bfhi(vw.w)); }
                }
                *(float4*)(Ks + key * 128 + c8) = k0v; *(float4*)(Ks + key * 128 + c8 + 4) = k1v; *(float4*)(Vs + key * 128 + c8) = v0v; *(float4*)(Vs + key * 128 + c8 + 4) = v1v;
            }
            __syncthreads();
            const int nk = (total - k0) < 32 ? (total - k0) : 32;
            for (int kk = 0; kk < nk; ++kk) {
                const float* kr = Ks + kk * 128 + map * 64;
                float s = 0.f;
#pragma unroll
                for (int d = 0; d < 64; d += 4) { const float4 k4 = *(const float4*)(kr + d); s = fmaf(q[d], k4.x, s); s = fmaf(q[d + 1], k4.y, s); s = fmaf(q[d + 2], k4.z, s); s = fmaf(q[d + 3], k4.w, s); }
                if (s > mx) { const float cf = __expf(mx - s); l *= cf;
#pragma unroll
                    for (int d = 0; d < 32; ++d) o[d] *= cf;
                    mx = s; }
                const float p = __expf(s - mx); l += p;
                const float* vr = Vs + kk * 128 + part * 32;
#pragma unroll
                for (int d = 0; d < 32; d += 4) { const float4 v4 = *(const float4*)(vr + d); o[d] = fmaf(p, v4.x, o[d]); o[d + 1] = fmaf(p, v4.y, o[d + 1]); o[d + 2] = fmaf(p, v4.z, o[d + 2]); o[d + 3] = fmaf(p, v4.w, o[d + 3]); }
            }
        }
        __syncthreads();
        const float inv = 1.f / l;
        if (map == 1) {
#pragma unroll
            for (int d = 0; d < 32; ++d) sm[qi * 128 + part * 32 + d] = o[d] * inv;
        }
        __syncthreads();
        float ssq = 0.f;
        if (map == 0) {
#pragma unroll
            for (int d = 0; d < 32; ++d) { o[d] = o[d] * inv - lam * sm[qi * 128 + part * 32 + d]; ssq += o[d] * o[d]; }
        }
        __syncthreads();
        if (map == 0) sm[part * 64 + qi] = ssq;
        __syncthreads();
        if (map == 0 && act) {
            const float tot = sm[qi] + sm[64 + qi] + sm[128 + qi] + sm[192 + qi];
            const float sc = rsqrtf(tot * (1.f / 128.f) + NORM_EPS) * (1.f - li);
            bf16_t* op = CAT + (size_t)(qrow0 + qi) * D + 512 + h * 128 + part * 32;
            const float* gp = CIN(I_SUBG) + e * 128 + part * 32;
#pragma unroll
            for (int d = 0; d < 32; d += 8) { u32x4 w; w.x = cvt_pk_bf16(o[d] * sc * gp[d], o[d + 1] * sc * gp[d + 1]); w.y = cvt_pk_bf16(o[d + 2] * sc * gp[d + 2], o[d + 3] * sc * gp[d + 3]);
                w.z = cvt_pk_bf16(o[d + 4] * sc * gp[d + 4], o[d + 5] * sc * gp[d + 5]); w.w = cvt_pk_bf16(o[d + 6] * sc * gp[d + 6], o[d + 7] * sc * gp[d + 7]); *(u32x4*)(op + d) = w; }
        }
    }
}
DEVI void ph_diff_combine(const Ctx& c, int e, int bid, int nb) {
    const int TIDX = tid_opaque();
    const bf16_t* OV = (const bf16_t*)(CWS + B_OV); bf16_t* CAT = (bf16_t*)(CWS + B_CAT);
    const int wave = TIDX >> 6, lane = TIDX & 63, hh = lane >> 4, i16 = lane & 15;
    const float lam = lam_of(c, e), li = lam_init_of(2 * e);
    const float* gp = CIN(I_SUBG) + e * 128 + 8 * i16;
    const f32x4 g0 = *GPTR(const f32x4, gp), g1 = *GPTR(const f32x4, gp + 4);
    const int vcol = (hh * 4 + (i16 >> 3)) * 64 + ((8 * i16) & 63);
    const int step = nb * 8;
    for (int row0 = bid * 8 + wave; row0 < MP; row0 += 4 * step) {
        u32x4 w0[4], w1[4];
#pragma unroll
        for (int j = 0; j < 4; ++j) { const int row = row0 + j * step;
            if (row < MP) { w0[j] = *GPTR(const u32x4, OV + (size_t)row * 1024 + vcol); w1[j] = *GPTR(const u32x4, OV + (size_t)row * 1024 + vcol + 128); } }
#pragma unroll
        for (int j = 0; j < 4; ++j) { const int row = row0 + j * step;
            if (row < MP) {
                f32x4 a0 = {bflo(w0[j].x) - lam * bflo(w1[j].x), bfhi(w0[j].x) - lam * bfhi(w1[j].x), bflo(w0[j].y) - lam * bflo(w1[j].y), bfhi(w0[j].y) - lam * bfhi(w1[j].y)};
                f32x4 a1 = {bflo(w0[j].z) - lam * bflo(w1[j].z), bfhi(w0[j].z) - lam * bfhi(w1[j].z), bflo(w0[j].w) - lam * bflo(w1[j].w), bfhi(w0[j].w) - lam * bfhi(w1[j].w)};
                float ss = ((a0[0] * a0[0] + a0[1] * a0[1]) + (a0[2] * a0[2] + a0[3] * a0[3])) + ((a1[0] * a1[0] + a1[1] * a1[1]) + (a1[2] * a1[2] + a1[3] * a1[3]));
                ss += __shfl_xor(ss, 1, 64); ss += __shfl_xor(ss, 2, 64); ss += __shfl_xor(ss, 4, 64); ss += __shfl_xor(ss, 8, 64);
                const float sc = rsqrtf(ss * (1.f / 128.f) + NORM_EPS) * (1.f - li);
                a0 = a0 * g0 * sc; a1 = a1 * g1 * sc;
                *GPTR(u32x4, CAT + (size_t)row * D + 512 + hh * 128 + 8 * i16) = pack8(a0, a1); } }
    }
}
DEVI void ph_diffattn_sample(const Ctx& c, int e, LAS float* L, int bid, int nb) {
    const int tid = tid_opaque(), wave = __builtin_amdgcn_readfirstlane(tid >> 6), lane = tid & 63, i15 = lane & 15, kq = lane >> 4;
    const bf16_t* QB = (const bf16_t*)(CWS + B_QB);
    float* PART = (float*)(CWS + B_DPART);
    const float C2 = 0.125f * 1.4426950408889634f;
    for (int unit = bid; unit < 256; unit += nb) {
        const int half = unit & 1, bh = unit >> 1, b = bh >> 2, h = bh & 3;
        const float* Kc = CIN(I_CDK) + ((size_t)(e * NBS + b) * PAST) * 512 + h * 128;
        const float* Vc = CIN(I_CDV) + ((size_t)(e * NBS + b) * PAST) * 512 + h * 128;
        bf16x8 qf[2][2];
#pragma unroll
        for (int mp = 0; mp < 2; ++mp)
#pragma unroll
            for (int s2 = 0; s2 < 2; ++s2) {
                const u32x4 w = *GPTR(const u32x4, QB + (size_t)(MP + b * TS + i15) * 512 + h * 128 + mp * 64 + 32 * s2 + 8 * kq);
                const f32x4 a = {bflo(w.x) * C2, bfhi(w.x) * C2, bflo(w.y) * C2, bfhi(w.y) * C2}, bq = {bflo(w.z) * C2, bfhi(w.z) * C2, bflo(w.w) * C2, bfhi(w.w) * C2};
                qf[mp][s2] = __builtin_bit_cast(bf16x8, pack8(a, bq));
            }
        float mx[2] = {-1e30f, -1e30f}, ls[2] = {0.f, 0.f};
        f32x4 o[2][8];
#pragma unroll
        for (int mp = 0; mp < 2; ++mp)
#pragma unroll
            for (int db = 0; db < 8; ++db) o[mp][db] = (f32x4){0.f, 0.f, 0.f, 0.f};
        const int key0 = half * 2048 + wave * 256;
        const int ngrp = (half == 1 && wave == 7) ? 9 : 8;
        const float* Kn = COUT + O_SDK + ((size_t)e * MS + b * TS) * 512 + h * 128;
        const float* Vn = COUT + O_SDV + ((size_t)e * MS + b * TS) * 512 + h * 128;
        for (int g = 0; g < ngrp; ++g) {
            const bool newk = g == 8;
            const float* kb = (newk ? Kn : Kc + (size_t)(key0 + g * 32) * 512) + (size_t)i15 * 512 + 8 * kq;
            const float* vb = (newk ? Vn : Vc + (size_t)(key0 + g * 32) * 512) + (size_t)(4 * kq) * 512 + i15;
            f32x4 sc[2][2];
            float vr[4][8], vr2[4][8];
            {
                f32x4 kr[2][2][2][2];
#pragma unroll
                for (int mp = 0; mp < 2; ++mp)
#pragma unroll
                    for (int bl = 0; bl < 2; ++bl)
#pragma unroll
                        for (int s2 = 0; s2 < 2; ++s2) { const float* p = kb + (size_t)bl * 16 * 512 + mp * 64 + 32 * s2; kr[mp][bl][s2][0] = *GPTR(const f32x4, p); kr[mp][bl][s2][1] = *GPTR(const f32x4, p + 4); }
#pragma unroll
                for (int db = 0; db < 4; ++db)
#pragma unroll
                    for (int j = 0; j < 8; ++j) vr[db][j] = *GPTR(const float, vb + (size_t)((j < 4 ? 0 : 16) + (j & 3)) * 512 + db * 16);
#pragma unroll
                for (int db = 0; db < 4; ++db)
#pragma unroll
                    for (int j = 0; j < 8; ++j) vr2[db][j] = *GPTR(const float, vb + (size_t)((j < 4 ? 0 : 16) + (j & 3)) * 512 + (db + 4) * 16);
#pragma unroll
                for (int mp = 0; mp < 2; ++mp)
#pragma unroll
                    for (int bl = 0; bl < 2; ++bl) {
                        f32x4 a = {0.f, 0.f, 0.f, 0.f};
#pragma unroll
                        for (int s2 = 0; s2 < 2; ++s2) a = __builtin_amdgcn_mfma_f32_16x16x32_bf16(__builtin_bit_cast(bf16x8, pack8(kr[mp][bl][s2][0], kr[mp][bl][s2][1])), qf[mp][s2], a, 0, 0, 0);
                        sc[mp][bl] = a;
                    }
            }
            if (newk) { sc[0][1] = (f32x4){-1e30f, -1e30f, -1e30f, -1e30f}; sc[1][1] = sc[0][1]; }
            bf16x8 pf[2];
#pragma unroll
            for (int mp = 0; mp < 2; ++mp) {
                float tm = fmaxf(fmaxf(fmaxf(sc[mp][0][0], sc[mp][0][1]), fmaxf(sc[mp][0][2], sc[mp][0][3])), fmaxf(fmaxf(sc[mp][1][0], sc[mp][1][1]), fmaxf(sc[mp][1][2], sc[mp][1][3])));
                tm = fmaxf(tm, __shfl_xor(tm, 16, 64)); tm = fmaxf(tm, __shfl_xor(tm, 32, 64));
                const float mn = fmaxf(mx[mp], tm), al = __builtin_amdgcn_exp2f(mx[mp] - mn);
                f32x4 p0, p1;
#pragma unroll
                for (int r = 0; r < 4; ++r) { p0[r] = __builtin_amdgcn_exp2f(sc[mp][0][r] - mn); p1[r] = __builtin_amdgcn_exp2f(sc[mp][1][r] - mn); }
                ls[mp] = ls[mp] * al + ((p0[0] + p0[1]) + (p0[2] + p0[3])) + ((p1[0] + p1[1]) + (p1[2] + p1[3]));
                mx[mp] = mn;
                pf[mp] = __builtin_bit_cast(bf16x8, pack8(p0, p1));
#pragma unroll
                for (int db = 0; db < 8; ++db) o[mp][db] *= al;
            }
#pragma unroll
            for (int db = 0; db < 4; ++db) {
                const f32x4 a = {vr[db][0], vr[db][1], vr[db][2], vr[db][3]}, bq = {vr[db][4], vr[db][5], vr[db][6], vr[db][7]}; const bf16x8 vf = __builtin_bit_cast(bf16x8, pack8(a, bq));
                o[0][db] = __builtin_amdgcn_mfma_f32_16x16x32_bf16(vf, pf[0], o[0][db], 0, 0, 0);
                o[1][db] = __builtin_amdgcn_mfma_f32_16x16x32_bf16(vf, pf[1], o[1][db], 0, 0, 0);
            }
#pragma unroll
            for (int db = 0; db < 4; ++db) {
                const f32x4 a = {vr2[db][0], vr2[db][1], vr2[db][2], vr2[db][3]}, bq = {vr2[db][4], vr2[db][5], vr2[db][6], vr2[db][7]}; const bf16x8 vf = __builtin_bit_cast(bf16x8, pack8(a, bq));
                o[0][db + 4] = __builtin_amdgcn_mfma_f32_16x16x32_bf16(vf, pf[0], o[0][db + 4], 0, 0, 0);
                o[1][db + 4] = __builtin_amdgcn_mfma_f32_16x16x32_bf16(vf, pf[1], o[1][db + 4], 0, 0, 0);
            }
        }
#pragma unroll
        for (int mp = 0; mp < 2; ++mp) {
            float lt = ls[mp]; lt += __shfl_xor(lt, 16, 64); lt += __shfl_xor(lt, 32, 64);
            __syncthreads();
            LAS float* wq = L + (wave * 16 + i15) * 132;
#pragma unroll
            for (int db = 0; db < 8; ++db) *(LAS f32x4*)(wq + db * 16 + 4 * kq) = o[mp][db];
            if (kq == 0) { wq[128] = mx[mp]; wq[129] = lt; }
            __syncthreads();
            {
                const int q = tid >> 5, d4 = (tid & 31) * 4;
                float M_ = -1e30f;
#pragma unroll
                for (int w = 0; w < 8; ++w) M_ = fmaxf(M_, L[(w * 16 + q) * 132 + 128]);
                float Ls = 0.f; f32x4 acc = {0.f, 0.f, 0.f, 0.f};
#pragma unroll
                for (int w = 0; w < 8; ++w) { const float f = __builtin_amdgcn_exp2f(L[(w * 16 + q) * 132 + 128] - M_); Ls += L[(w * 16 + q) * 132 + 129] * f; acc += *(const LAS f32x4*)(L + (w * 16 + q) * 132 + d4) * f; }
                float* po = PART + ((size_t)((bh * 2 + half) * 2 + mp) * 16 + q) * 132;
                *GPTR(f32x4, po + d4) = acc;
                if ((tid & 31) == 0) { po[128] = M_; po[129] = Ls; }
            }
        }
        __syncthreads();
    }
}
DEVI void ph_diff_combine_sample(const Ctx& c, int e, int bid, int nb) {
    const int TIDX = tid_opaque();
    const float* PART = (const float*)(CWS + B_DPART); bf16_t* CAT = (bf16_t*)(CWS + B_CAT);
    const int wave = TIDX >> 6, lane = TIDX & 63;
    const float lam = lam_of(c, e), li = lam_init_of(2 * e);
    const float* gp = CIN(I_SUBG) + e * 128;
    const float g0 = gp[2 * lane], g1 = gp[2 * lane + 1];
    for (int it = bid * 8 + wave; it < 128 * 16; it += nb * 8) {
        const int bh = it >> 4, q = it & 15, b = bh >> 2, h = bh & 3;
        float a0 = 0.f, a1 = 0.f;
#pragma unroll
        for (int mp = 0; mp < 2; ++mp) {
            const float* p0 = PART + ((size_t)((bh * 2 + 0) * 2 + mp) * 16 + q) * 132; const float* p1 = PART + ((size_t)((bh * 2 + 1) * 2 + mp) * 16 + q) * 132;
            const float m0 = p0[128], m1 = p1[128], mm = fmaxf(m0, m1), f0 = __builtin_amdgcn_exp2f(m0 - mm), f1 = __builtin_amdgcn_exp2f(m1 - mm);
            const float inv = 1.f / (p0[129] * f0 + p1[129] * f1);
            const float x0 = (p0[2 * lane] * f0 + p1[2 * lane] * f1) * inv, x1 = (p0[2 * lane + 1] * f0 + p1[2 * lane + 1] * f1) * inv;
            if (mp == 0) { a0 = x0; a1 = x1; } else { a0 -= lam * x0; a1 -= lam * x1; }
        }
        const float ss = wave_sum(a0 * a0 + a1 * a1);
        const float sc = rsqrtf(ss * (1.f / 128.f) + NORM_EPS) * (1.f - li);
        *(unsigned*)(CAT + (size_t)(MP + b * TS + q) * D + 512 + h * 128 + 2 * lane) = cvt_pk_bf16(a0 * sc * g0, a1 * sc * g1);
    }
}
DEVI void ph_shiftmix(const Ctx& c, int l, int bid, int nb) {
    const int TIDX = tid_opaque();
    const int o = l >> 1;
    const bf16_t* X = (const bf16_t*)(CWS + B_XB); const float* rowss = (const float*)(CWS + B_ROWP) + (size_t)(3 * l) * ROWP_N; bf16_t* XM = (bf16_t*)(CWS + B_XM);
    const float* mu = CIN(I_MU) + (size_t)o * 6 * D; const float* gn = CIN(I_NMIX) + l * D;
    const unsigned total = (unsigned)M * 128u;
    for (unsigned idx = (unsigned)bid * NT + TIDX; idx < total; idx += (unsigned)nb * NT) {
        const int row = (int)(idx >> 7), col = (int)(idx & 127) * 8;
        const bool prompt = row < MP;
        const int b = prompt ? row / TP : (row - MP) / TS, t = prompt ? row % TP : (row - MP) % TS;
        const f32x4 g0 = *GPTR(const f32x4, gn + col), g1 = *GPTR(const f32x4, gn + col + 4);
        const float s = pg8::rs_of(rowss, row);
        const u32x4 xw = *GPTR(const u32x4, X + (size_t)row * D + col);
        const f32x4 h0 = (f32x4){bflo(xw.x), bfhi(xw.x), bflo(xw.y), bfhi(xw.y)} * s * g0, h1 = (f32x4){bflo(xw.z), bfhi(xw.z), bflo(xw.w), bfhi(xw.w)} * s * g1;
        f32x4 p0 = {0.f, 0.f, 0.f, 0.f}, p1 = p0;
        if (t > 0) { const float s1 = pg8::rs_of(rowss, row - 1); const u32x4 pw = *GPTR(const u32x4, X + (size_t)(row - 1) * D + col);
            p0 = (f32x4){bflo(pw.x), bfhi(pw.x), bflo(pw.y), bfhi(pw.y)} * s1 * g0; p1 = (f32x4){bflo(pw.z), bfhi(pw.z), bflo(pw.w), bfhi(pw.w)} * s1 * g1; }
        else if (!prompt) { const float* sp = CIN(I_SSHIFT) + ((size_t)o * NBS + b) * D + col; p0 = *GPTR(const f32x4, sp); p1 = *GPTR(const f32x4, sp + 4); }
        const f32x4 d0 = p0 - h0, d1 = p1 - h1;
#pragma unroll
        for (int i = 0; i < 6; ++i) {
            const f32x4 m0 = *GPTR(const f32x4, mu + i * D + col), m1 = *GPTR(const f32x4, mu + i * D + col + 4);
            *GPTR(u32x4, XM + (size_t)i * M * D + (size_t)row * D + col) = pack8(h0 + d0 * m0, h1 + d1 * m1);
        }
        if (prompt) { if (t == TP - 1) { float* op = COUT + O_PSHIFT + ((size_t)o * NBP + b) * D + col; *GPTR(f32x4, op) = h0; *GPTR(f32x4, op + 4) = h1; } }
        else { if (t == TS - 1) { float* op = COUT + O_SSHIFT + ((size_t)o * NBS + b) * D + col; *GPTR(f32x4, op) = h0; *GPTR(f32x4, op + 4) = h1; } }
    }
}
DEVI float sum16(float v) { v += __shfl_xor(v, 1, 64); v += __shfl_xor(v, 2, 64); v += __shfl_xor(v, 4, 64); v += __shfl_xor(v, 8, 64); return v; }
DEVI void ph_rw_prep(const Ctx& c, int o, int bid, int nb) {
    const int TIDX = tid_opaque();
    bf16_t* K = (bf16_t*)(CWS + B_K); bf16_t* V = (bf16_t*)(CWS + B_V); const bf16_t* W = (const bf16_t*)(CWS + B_W); const bf16_t* A = (const bf16_t*)(CWS + B_A); bf16_t* VF = (bf16_t*)(CWS + B_VF); const bf16_t* VG = (const bf16_t*)(CWS + B_VG);
    float* SMP = (float*)(CWS + B_SMP);
    const int wave = TIDX >> 6, lane = TIDX & 63;
    const float* w0p = CIN(I_W0) + o * D; const float* a0p = CIN(I_A0) + o * D; const float* v0p = CIN(I_V0) + (o > 0 ? o - 1 : 0) * D; const float* kkp = CIN(I_KK) + o * D; const float* kap = CIN(I_KA) + o * D;
    const int items = MS * 4;
    for (int it = bid * 8 + wave; it < items; it += nb * 8) {
        const int row = MP + (it >> 2), col = (it & 3) * 256 + lane * 4; const size_t base = (size_t)row * D + col, sb = (size_t)(it >> 2) * D + col;
        const f32x4 wl = ld4bf(W + base), al = ld4bf(A + base), kl = ld4bf(K + base); f32x4 vl = ld4bf(V + base);
        const f32x4 w0 = *GPTR(const f32x4, w0p + col), a0 = *GPTR(const f32x4, a0p + col), kk0 = *GPTR(const f32x4, kkp + col), ka0 = *GPTR(const f32x4, kap + col);
        f32x4 lw, av, kk, k2;
        if (o > 0) {
            const f32x4 vf = ld4bf(VF + base), vg = ld4bf(VG + base), v0 = *GPTR(const f32x4, v0p + col);
#pragma unroll
            for (int i = 0; i < 4; ++i) vl[i] = vl[i] + (vf[i] - vl[i]) * sigmoidf_(v0[i] + vg[i]);
        } else st4bf(VF + base, vl);
        float n2 = 0.f;
#pragma unroll
        for (int i = 0; i < 4; ++i) {
            const float x = -(w0[i] + wl[i]); const float sp = softplusf_(x);
            lw[i] = -__expf(-sp - 0.5f);
            av[i] = sigmoidf_(a0[i] + al[i]);
            kk[i] = kl[i] * kk0[i]; n2 += kk[i] * kk[i];
            k2[i] = kl[i] * (1.f + (av[i] - 1.f) * ka0[i]);
        }
        const float inv = 1.f / fmaxf(sqrtf(sum16(n2)), 1e-12f);
        kk *= inv;
        *GPTR(f32x4, SMP + 0 * SMPN + sb) = lw; *GPTR(f32x4, SMP + 1 * SMPN + sb) = av; *GPTR(f32x4, SMP + 2 * SMPN + sb) = kk; *GPTR(f32x4, SMP + 3 * SMPN + sb) = k2; *GPTR(f32x4, SMP + 4 * SMPN + sb) = vl;
        st4bf(K + base, k2); st4bf(V + base, vl);
    }
}
DEVI void ph_rw_scan(const Ctx& c, int o, int bid, int nb, LAS float* L) {
    const int TIDX = tid_opaque();
    const bf16_t* R = (const bf16_t*)(CWS + B_R); const float* SMP = (const float*)(CWS + B_SMP); bf16_t* Y = (bf16_t*)(CWS + B_Y);
    const float* W = SMP; const float* A = SMP + SMPN; const float* KKb = SMP + 2 * SMPN; const float* K = SMP + 3 * SMPN; const float* V = SMP + 4 * SMPN;
    const int wave = __builtin_amdgcn_readfirstlane(TIDX >> 6), lane = TIDX & 63, grp = wave >> 2, w4 = wave & 3, k0 = 16 * w4;
    LAS float* red = L + grp * 256;
    LAS float* yred = L + 1024 + grp * 256;
#define RL(x, k_) __builtin_bit_cast(float, __builtin_amdgcn_readlane(__builtin_bit_cast(int, (x)), (k_)))
    for (int it0 = bid; it0 < NBS * 16; it0 += 2 * nb) {
        const int it = it0 + grp * nb; const bool act = it < NBS * 16; const int itc = act ? it : it0;
        const int b = itc >> 4, h = itc & 15, row0 = MP + b * TS;
        float S[16];
        {
            const float* sp = CIN(I_SWKV) + (((size_t)(o * NBS + b) * 16 + h) * 64 + lane) * 64 + k0;
#pragma unroll
            for (int k = 0; k < 16; k += 4) { const f32x4 v = *GPTR(const f32x4, sp + k); S[k] = v[0]; S[k + 1] = v[1]; S[k + 2] = v[2]; S[k + 3] = v[3]; }
        }
        const size_t base0 = (size_t)row0 * D + h * 64 + lane, sbase0 = (size_t)(b * TS) * D + h * 64 + lane;
        float pr[TS], pd[TS], pk[TS], pkk[TS], pab[TS], pv[TS];
#pragma unroll
        for (int t = 0; t < TS; ++t) { const size_t bb = base0 + (size_t)t * D, sb = sbase0 + (size_t)t * D;
            pr[t] = bf2f(R[bb]); pd[t] = W[sb]; pk[t] = K[sb]; pkk[t] = KKb[sb]; pab[t] = A[sb]; pv[t] = V[sb]; }
#pragma unroll
        for (int t = 0; t < TS; ++t) { pd[t] = __expf(pd[t]); pab[t] = pkk[t] * pab[t]; }
        {
            float s0 = 0.f, s1 = 0.f;
#pragma unroll
            for (int k = 0; k < 16; k += 2) { s0 = fmaf(S[k], RL(pkk[0], k0 + k), s0); s1 = fmaf(S[k + 1], RL(pkk[0], k0 + k + 1), s1); }
            red[w4 * 64 + lane] = s0 + s1;
        }
        __syncthreads();
#pragma unroll
        for (int t = 0; t < TS; ++t) {
            const int slot = (t & 1) * 512;
            const float sa = -((red[slot + lane] + red[slot + 64 + lane]) + (red[slot + 128 + lane] + red[slot + 192 + lane]));
            const float vj = pv[t];
            float y0 = 0.f, y1 = 0.f;
#pragma unroll
            for (int k = 0; k < 16; k += 2) {
                S[k] = fmaf(S[k], RL(pd[t], k0 + k), fmaf(sa, RL(pab[t], k0 + k), vj * RL(pk[t], k0 + k))); y0 = fmaf(S[k], RL(pr[t], k0 + k), y0);
                S[k + 1] = fmaf(S[k + 1], RL(pd[t], k0 + k + 1), fmaf(sa, RL(pab[t], k0 + k + 1), vj * RL(pk[t], k0 + k + 1))); y1 = fmaf(S[k + 1], RL(pr[t], k0 + k + 1), y1);
            }
            yred[slot + w4 * 64 + lane] = y0 + y1;
            if (t + 1 < TS) {
                float s0 = 0.f, s1 = 0.f;
#pragma unroll
                for (int k = 0; k < 16; k += 2) { s0 = fmaf(S[k], RL(pkk[t + 1 < TS ? t + 1 : t], k0 + k), s0); s1 = fmaf(S[k + 1], RL(pkk[t + 1 < TS ? t + 1 : t], k0 + k + 1), s1); }
                red[(512 - slot) + w4 * 64 + lane] = s0 + s1;
            }
            __syncthreads();
            if (w4 == 0 && act) Y[base0 + (size_t)t * D] = (bf16_t)(cvt_pk_bf16((yred[slot + lane] + yred[slot + 64 + lane]) + (yred[slot + 128 + lane] + yred[slot + 192 + lane]), 0.f) & 0xffffu);
        }
        if (act) {
            float* op = COUT + O_SWKV + (((size_t)(o * NBS + b) * 16 + h) * 64 + lane) * 64 + k0;
#pragma unroll
            for (int k = 0; k < 16; k += 4) *GPTR(f32x4, op + k) = (f32x4){S[k], S[k + 1], S[k + 2], S[k + 3]};
        }
        __syncthreads();
    }
#undef RL
}
DEVI void ph_rw_post(const Ctx& c, int o, int bid, int nb) {
    const int TIDX = tid_opaque();
    const bf16_t* R = (const bf16_t*)(CWS + B_R); const bf16_t* K = (const bf16_t*)(CWS + B_K); const bf16_t* V = (const bf16_t*)(CWS + B_V); const bf16_t* G = (const bf16_t*)(CWS + B_G); const bf16_t* Y = (const bf16_t*)(CWS + B_Y); bf16_t* YG = (bf16_t*)(CWS + B_YG);
    const int wave = TIDX >> 6, lane = TIDX & 63;
    const float* lgp = CIN(I_LNG) + o * D; const float* lbp = CIN(I_LNB) + o * D; const float* rkp = CIN(I_RK) + o * D;
    const int items = M * 4;
    for (int it = bid * 8 + wave; it < items; it += nb * 8) {
        const int row = it >> 2, col = (it & 3) * 256 + lane * 4; const size_t base = (size_t)row * D + col;
        f32x4 y = ld4bf(Y + base); const f32x4 r = ld4bf(R + base), k = ld4bf(K + base), v = ld4bf(V + base), g = ld4bf(G + base);
        if (row < MP) y += ld4bf((const bf16_t*)(CWS + B_YL) + base);
        const f32x4 lg = *GPTR(const f32x4, lgp + col), lb = *GPTR(const f32x4, lbp + col), rk = *GPTR(const f32x4, rkp + col);
        const float mean = sum16((y[0] + y[1]) + (y[2] + y[3])) * (1.f / 64.f);
        const f32x4 dl = y - mean;
        const float var = sum16((dl[0] * dl[0] + dl[1] * dl[1]) + (dl[2] * dl[2] + dl[3] * dl[3])) * (1.f / 64.f);
        const float rstd = rsqrtf(var + RW_LN_EPS);
        const float bon = sum16((r[0] * k[0] * rk[0] + r[1] * k[1] * rk[1]) + (r[2] * k[2] * rk[2] + r[3] * k[3] * rk[3]));
        f32x4 ov;
#pragma unroll
        for (int i = 0; i < 4; ++i) ov[i] = (dl[i] * rstd * lg[i] + lb[i] + bon * v[i]) * g[i];
        u32x2 w; w.x = cvt_pk_bf16(ov[0], ov[1]); w.y = cvt_pk_bf16(ov[2], ov[3]);
        *GPTR(u32x2, YG + base) = w;
    }
}
DEVI void ph_softmax256(const Ctx& c, int bid, int nb) {
    const int TIDX = tid_opaque();
    const float* S = (const float*)(CWS + B_S); bf16_t* P = (bf16_t*)(CWS + B_P);
    const int wave = TIDX >> 6, lane = TIDX & 63;
    const int items = MP * 4;
    for (int it = bid * 8 + wave; it < items; it += nb * 8) {
        float4 v = *((const float4*)(S + (size_t)it * 256) + lane); v.x *= 0.0625f; v.y *= 0.0625f; v.z *= 0.0625f; v.w *= 0.0625f;
        float mx = fmaxf(fmaxf(v.x, v.y), fmaxf(v.z, v.w));
#pragma unroll
        for (int o = 32; o > 0; o >>= 1) mx = fmaxf(mx, __shfl_xor(mx, o, 64));
        v.x = __expf(v.x - mx); v.y = __expf(v.y - mx); v.z = __expf(v.z - mx); v.w = __expf(v.w - mx);
        const float inv = 1.f / wave_sum(v.x + v.y + v.z + v.w);
        u32x2 w; w.x = cvt_pk_bf16(v.x * inv, v.y * inv); w.y = cvt_pk_bf16(v.z * inv, v.w * inv);
        *((u32x2*)(P + (size_t)it * 256) + lane) = w;
    }
}
DEVI void ph_xattn_sample(const Ctx& c, int l, LAS float* L, int bid, int nb) {
    const int tid = tid_opaque(), wave = __builtin_amdgcn_readfirstlane(tid >> 6), lane = tid & 63, i15 = lane & 15, kq = lane >> 4;
    const bf16_t* Q = (const bf16_t*)(CWS + B_Q); bf16_t* O = (bf16_t*)(CWS + B_O);
    LAS float* rmax = L; LAS float* rsum = L + 128;
    LAS bf16_t* Pl = (LAS bf16_t*)(L + 256);
    constexpr int PP = 264;
    const float C2 = 0.0625f * 1.4426950408889634f;
    for (int item = bid; item < NBS * 4; item += nb) {
        const int b = item >> 2, h = item & 3;
        const float* Kc = CIN(I_CMK) + ((size_t)(l * NBS + b) * NMEM) * D + h * 256; const float* Vc = CIN(I_CMV) + ((size_t)(l * NBS + b) * NMEM) * D + h * 256;
        bf16x8 qf[8];
#pragma unroll
        for (int s2 = 0; s2 < 8; ++s2) {
            const u32x4 w = *GPTR(const u32x4, Q + (size_t)(MP + b * TS + i15) * D + h * 256 + 32 * s2 + 8 * kq);
            const f32x4 a = {bflo(w.x) * C2, bfhi(w.x) * C2, bflo(w.y) * C2, bfhi(w.y) * C2}, bq = {bflo(w.z) * C2, bfhi(w.z) * C2, bflo(w.w) * C2, bfhi(w.w) * C2};
            qf[s2] = __builtin_bit_cast(bf16x8, pack8(a, bq));
        }
        f32x4 sc[2];
#pragma unroll
        for (int bl = 0; bl < 2; ++bl) {
            const float* kb = Kc + (size_t)(32 * wave + 16 * bl + i15) * D + 8 * kq;
            f32x4 kr[8][2];
#pragma unroll
            for (int s2 = 0; s2 < 8; ++s2) { kr[s2][0] = *GPTR(const f32x4, kb + 32 * s2); kr[s2][1] = *GPTR(const f32x4, kb + 32 * s2 + 4); }
            f32x4 a = {0.f, 0.f, 0.f, 0.f};
#pragma unroll
            for (int s2 = 0; s2 < 8; ++s2) a = __builtin_amdgcn_mfma_f32_16x16x32_bf16(__builtin_bit_cast(bf16x8, pack8(kr[s2][0], kr[s2][1])), qf[s2], a, 0, 0, 0);
            sc[bl] = a;
        }
        float tm = fmaxf(fmaxf(fmaxf(sc[0][0], sc[0][1]), fmaxf(sc[0][2], sc[0][3])), fmaxf(fmaxf(sc[1][0], sc[1][1]), fmaxf(sc[1][2], sc[1][3])));
        tm = fmaxf(tm, __shfl_xor(tm, 16, 64)); tm = fmaxf(tm, __shfl_xor(tm, 32, 64));
        __syncthreads();
        if (kq == 0) rmax[wave * 16 + i15] = tm;
        __syncthreads();
        float M_ = rmax[i15];
#pragma unroll
        for (int w = 1; w < 8; ++w) M_ = fmaxf(M_, rmax[w * 16 + i15]);
        f32x4 p0, p1;
#pragma unroll
        for (int r = 0; r < 4; ++r) { p0[r] = __builtin_amdgcn_exp2f(sc[0][r] - M_); p1[r] = __builtin_amdgcn_exp2f(sc[1][r] - M_); }
        float lt = ((p0[0] + p0[1]) + (p0[2] + p0[3])) + ((p1[0] + p1[1]) + (p1[2] + p1[3]));
        lt += __shfl_xor(lt, 16, 64); lt += __shfl_xor(lt, 32, 64);
        if (kq == 0) rsum[wave * 16 + i15] = lt;
        { u32x2 w0; w0.x = cvt_pk_bf16(p0[0], p0[1]); w0.y = cvt_pk_bf16(p0[2], p0[3]); *(LAS u32x2*)(Pl + i15 * PP + 32 * wave + 4 * kq) = w0;
          u32x2 w1; w1.x = cvt_pk_bf16(p1[0], p1[1]); w1.y = cvt_pk_bf16(p1[2], p1[3]); *(LAS u32x2*)(Pl + i15 * PP + 32 * wave + 16 + 4 * kq) = w1; }
        __syncthreads();
        float Ls = rsum[i15];
#pragma unroll
        for (int w = 1; w < 8; ++w) Ls += rsum[w * 16 + i15];
        const float inv = 1.f / Ls;
        f32x4 o[2] = {{0.f, 0.f, 0.f, 0.f}, {0.f, 0.f, 0.f, 0.f}};
#pragma unroll
        for (int g = 0; g < 8; ++g) {
            const bf16x8 pf = __builtin_bit_cast(bf16x8, *(const LAS u32x4*)(Pl + i15 * PP + 32 * g + 8 * kq));
#pragma unroll
            for (int db = 0; db < 2; ++db) {
                const float* vb = Vc + (size_t)(32 * g + 8 * kq) * D + (2 * wave + db) * 16 + i15;
                f32x4 a, bq;
#pragma unroll
                for (int j = 0; j < 4; ++j) { a[j] = *GPTR(const float, vb + (size_t)j * D); bq[j] = *GPTR(const float, vb + (size_t)(j + 4) * D); }
                o[db] = __builtin_amdgcn_mfma_f32_16x16x32_bf16(__builtin_bit_cast(bf16x8, pack8(a, bq)), pf, o[db], 0, 0, 0);
            }
        }
#pragma unroll
        for (int db = 0; db < 2; ++db) {
            const f32x4 v = o[db] * inv; u32x2 w; w.x = cvt_pk_bf16(v[0], v[1]); w.y = cvt_pk_bf16(v[2], v[3]);
            *GPTR(u32x2, O + (size_t)(MP + b * TS + i15) * D + h * 256 + (2 * wave + db) * 16 + 4 * kq) = w;
        }
    }
}
DEVI void ph_final(const Ctx& c, int bid, int nb) {
    const int TIDX = tid_opaque();
    const bf16_t* X = (const bf16_t*)(CWS + B_XB); const float* rowss = (const float*)(CWS + B_ROWP) + (size_t)12 * ROWP_N; const float* g = CIN(I_NFIN);
    const int wave = TIDX >> 6, lane = TIDX & 63, step = nb * 8;
    f32x4 g4[4];
#pragma unroll
    for (int i = 0; i < 4; ++i) g4[i] = *GPTR(const f32x4, g + 4 * (lane + 64 * i));
    for (int r0 = bid * 8 + wave; r0 < M; r0 += 3 * step) {
        u32x2 xw[3][4]; float sc[3];
#pragma unroll
        for (int j = 0; j < 3; ++j) { const int r = r0 + j * step;
            if (r < M) { sc[j] = pg8::rs_of(rowss, r);
#pragma unroll
                for (int i = 0; i < 4; ++i) xw[j][i] = *GPTR(const u32x2, X + (size_t)r * D + 4 * (lane + 64 * i)); } }
#pragma unroll
        for (int j = 0; j < 3; ++j) { const int r = r0 + j * step;
            if (r < M) {
#pragma unroll
                for (int i = 0; i < 4; ++i) *GPTR(f32x4, COUT + O_YP + (size_t)r * D + 4 * (lane + 64 * i)) = cv4bf(xw[j][i]) * sc[j] * g4[i]; } }
    }
}


namespace rwk {
typedef float f32x16 __attribute__((ext_vector_type(16)));
constexpr int LP = 68, IMGF = 64 * LP;
enum { G_AT = 0, G_RT, G_BT, G_KT, G_VV, G_MAB, G_MAK, G_MRK, N_IMG };
DEVI int crow(int r, int hi) { return (r & 3) + 8 * (r >> 2) + 4 * hi; }
DEVI bf16x8 frag_row(const LAS float* img, int row, int s, int hi) {
    const LAS float* p = img + row * LP + 16 * s + 8 * hi;
    const f32x4 a = *(const LAS f32x4*)p, b = *(const LAS f32x4*)(p + 4);
    return __builtin_bit_cast(bf16x8, pack8(a, b));
}
DEVI bf16x8 frag_col(const LAS float* img, int col, int s, int hi, float scale) {
    const LAS float* p = img + (16 * s + 8 * hi) * LP + col;
    f32x4 a, b;
    a[0] = p[0]; a[1] = p[LP]; a[2] = p[2 * LP]; a[3] = p[3 * LP]; b[0] = p[4 * LP]; b[1] = p[5 * LP]; b[2] = p[6 * LP]; b[3] = p[7 * LP];
    a *= scale; b *= scale;
    return __builtin_bit_cast(bf16x8, pack8(a, b));
}
#define LDS_BARRIER() asm volatile("s_waitcnt lgkmcnt(0)\n\ts_barrier" ::: "memory")
#define RWK_MMA(acc, Afr, Bfr) acc = __builtin_amdgcn_mfma_f32_32x32x16_bf16((Afr), (Bfr), acc, 0, 0, 0)

DEVI void sub_solve32(const LAS float* Mb, LAS float* ib) {
    float x[32];
#pragma unroll
    for (int tt = 0; tt < 32; ++tt) x[tt] = ib[tt * LP];
#define SUB_LOAD(buf, t_, n_) do { _Pragma("unroll") for (int j4 = 0; j4 < (n_); ++j4) buf[j4] = *(const LAS f32x4*)(Mb + (t_) * LP + 4 * j4); } while (0)
#define SUB_ACC(buf, t_, n_) do { _Pragma("unroll") for (int j4 = 0; j4 < (n_); ++j4) { const int jb = 4 * j4; \
        if (jb + 0 < (t_)) s0 = fmaf(buf[j4][0], x[jb + 0], s0); if (jb + 1 < (t_)) s1 = fmaf(buf[j4][1], x[jb + 1], s1); \
        if (jb + 2 < (t_)) s2 = fmaf(buf[j4][2], x[jb + 2], s2); if (jb + 3 < (t_)) s3 = fmaf(buf[j4][3], x[jb + 3], s3); } } while (0)
    f32x4 pa[8], pb[8]; float s0 = 0.f, s1 = 0.f, s2 = 0.f, s3 = 0.f;
    SUB_LOAD(pa, 1, 1);
    SUB_LOAD(pb, 2, 1); s0 = x[1]; s1 = 0.f; s2 = 0.f; s3 = 0.f; SUB_ACC(pa, 1, 1); x[1] = (s0 + s1) + (s2 + s3);
    SUB_LOAD(pa, 3, 1); s0 = x[2]; s1 = 0.f; s2 = 0.f; s3 = 0.f; SUB_ACC(pb, 2, 1); x[2] = (s0 + s1) + (s2 + s3);
    SUB_LOAD(pb, 4, 1); s0 = x[3]; s1 = 0.f; s2 = 0.f; s3 = 0.f; SUB_ACC(pa, 3, 1); x[3] = (s0 + s1) + (s2 + s3);
    SUB_LOAD(pa, 5, 2); s0 = x[4]; s1 = 0.f; s2 = 0.f; s3 = 0.f; SUB_ACC(pb, 4, 1); x[4] = (s0 + s1) + (s2 + s3);
    SUB_LOAD(pb, 6, 2); s0 = x[5]; s1 = 0.f; s2 = 0.f; s3 = 0.f; SUB_ACC(pa, 5, 2); x[5] = (s0 + s1) + (s2 + s3);
    SUB_LOAD(pa, 7, 2); s0 = x[6]; s1 = 0.f; s2 = 0.f; s3 = 0.f; SUB_ACC(pb, 6, 2); x[6] = (s0 + s1) + (s2 + s3);
    SUB_LOAD(pb, 8, 2); s0 = x[7]; s1 = 0.f; s2 = 0.f; s3 = 0.f; SUB_ACC(pa, 7, 2); x[7] = (s0 + s1) + (s2 + s3);
    SUB_LOAD(pa, 9, 3); s0 = x[8]; s1 = 0.f; s2 = 0.f; s3 = 0.f; SUB_ACC(pb, 8, 2); x[8] = (s0 + s1) + (s2 + s3);
    SUB_LOAD(pb, 10, 3); s0 = x[9]; s1 = 0.f; s2 = 0.f; s3 = 0.f; SUB_ACC(pa, 9, 3); x[9] = (s0 + s1) + (s2 + s3);
    SUB_LOAD(pa, 11, 3); s0 = x[10]; s1 = 0.f; s2 = 0.f; s3 = 0.f; SUB_ACC(pb, 10, 3); x[10] = (s0 + s1) + (s2 + s3);
    SUB_LOAD(pb, 12, 3); s0 = x[11]; s1 = 0.f; s2 = 0.f; s3 = 0.f; SUB_ACC(pa, 11, 3); x[11] = (s0 + s1) + (s2 + s3);
    SUB_LOAD(pa, 13, 4); s0 = x[12]; s1 = 0.f; s2 = 0.f; s3 = 0.f; SUB_ACC(pb, 12, 3); x[12] = (s0 + s1) + (s2 + s3);
    SUB_LOAD(pb, 14, 4); s0 = x[13]; s1 = 0.f; s2 = 0.f; s3 = 0.f; SUB_ACC(pa, 13, 4); x[13] = (s0 + s1) + (s2 + s3);
    SUB_LOAD(pa, 15, 4); s0 = x[14]; s1 = 0.f; s2 = 0.f; s3 = 0.f; SUB_ACC(pb, 14, 4); x[14] = (s0 + s1) + (s2 + s3);
    SUB_LOAD(pb, 16, 4); s0 = x[15]; s1 = 0.f; s2 = 0.f; s3 = 0.f; SUB_ACC(pa, 15, 4); x[15] = (s0 + s1) + (s2 + s3);
    SUB_LOAD(pa, 17, 5); s0 = x[16]; s1 = 0.f; s2 = 0.f; s3 = 0.f; SUB_ACC(pb, 16, 4); x[16] = (s0 + s1) + (s2 + s3);
    SUB_LOAD(pb, 18, 5); s0 = x[17]; s1 = 0.f; s2 = 0.f; s3 = 0.f; SUB_ACC(pa, 17, 5); x[17] = (s0 + s1) + (s2 + s3);
    SUB_LOAD(pa, 19, 5); s0 = x[18]; s1 = 0.f; s2 = 0.f; s3 = 0.f; SUB_ACC(pb, 18, 5); x[18] = (s0 + s1) + (s2 + s3);
    SUB_LOAD(pb, 20, 5); s0 = x[19]; s1 = 0.f; s2 = 0.f; s3 = 0.f; SUB_ACC(pa, 19, 5); x[19] = (s0 + s1) + (s2 + s3);
    SUB_LOAD(pa, 21, 6); s0 = x[20]; s1 = 0.f; s2 = 0.f; s3 = 0.f; SUB_ACC(pb, 20, 5); x[20] = (s0 + s1) + (s2 + s3);
    SUB_LOAD(pb, 22, 6); s0 = x[21]; s1 = 0.f; s2 = 0.f; s3 = 0.f; SUB_ACC(pa, 21, 6); x[21] = (s0 + s1) + (s2 + s3);
    SUB_LOAD(pa, 23, 6); s0 = x[22]; s1 = 0.f; s2 = 0.f; s3 = 0.f; SUB_ACC(pb, 22, 6); x[22] = (s0 + s1) + (s2 + s3);
    SUB_LOAD(pb, 24, 6); s0 = x[23]; s1 = 0.f; s2 = 0.f; s3 = 0.f; SUB_ACC(pa, 23, 6); x[23] = (s0 + s1) + (s2 + s3);
    SUB_LOAD(pa, 25, 7); s0 = x[24]; s1 = 0.f; s2 = 0.f; s3 = 0.f; SUB_ACC(pb, 24, 6); x[24] = (s0 + s1) + (s2 + s3);
    SUB_LOAD(pb, 26, 7); s0 = x[25]; s1 = 0.f; s2 = 0.f; s3 = 0.f; SUB_ACC(pa, 25, 7); x[25] = (s0 + s1) + (s2 + s3);
    SUB_LOAD(pa, 27, 7); s0 = x[26]; s1 = 0.f; s2 = 0.f; s3 = 0.f; SUB_ACC(pb, 26, 7); x[26] = (s0 + s1) + (s2 + s3);
    SUB_LOAD(pb, 28, 7); s0 = x[27]; s1 = 0.f; s2 = 0.f; s3 = 0.f; SUB_ACC(pa, 27, 7); x[27] = (s0 + s1) + (s2 + s3);
    SUB_LOAD(pa, 29, 8); s0 = x[28]; s1 = 0.f; s2 = 0.f; s3 = 0.f; SUB_ACC(pb, 28, 7); x[28] = (s0 + s1) + (s2 + s3);
    SUB_LOAD(pb, 30, 8); s0 = x[29]; s1 = 0.f; s2 = 0.f; s3 = 0.f; SUB_ACC(pa, 29, 8); x[29] = (s0 + s1) + (s2 + s3);
    SUB_LOAD(pa, 31, 8); s0 = x[30]; s1 = 0.f; s2 = 0.f; s3 = 0.f; SUB_ACC(pb, 30, 8); x[30] = (s0 + s1) + (s2 + s3);
    s0 = x[31]; s1 = 0.f; s2 = 0.f; s3 = 0.f; SUB_ACC(pa, 31, 8); x[31] = (s0 + s1) + (s2 + s3);
#undef SUB_LOAD
#undef SUB_ACC
#pragma unroll
    for (int tt = 0; tt < 32; ++tt) ib[tt * LP] = x[tt];
}

DEVI void phaseA(const Ctx& c, int o, LAS float* L, int bid, int nb) {
    const int tid0 = tid_opaque();
    const bf16_t* Rg = (const bf16_t*)(CWS + B_R); const bf16_t* LWg = (const bf16_t*)(CWS + B_W); const bf16_t* Kg = (const bf16_t*)(CWS + B_K); const bf16_t* Vg = (const bf16_t*)(CWS + B_V);
    const bf16_t* Ag = (const bf16_t*)(CWS + B_A);
    float* TC = (float*)(CWS + B_TC); float* UC = (float*)(CWS + B_UC); float* GH = (float*)(CWS + B_GH); bf16_t* Yg = (bf16_t*)(CWS + B_YL);
    LAS float* AT = L + G_AT * IMGF; LAS float* RT = L + G_RT * IMGF; LAS float* BT = L + G_BT * IMGF; LAS float* KT = L + G_KT * IMGF; LAS float* VV = L + G_VV * IMGF;
    LAS float* MAB = L + G_MAB * IMGF; LAS float* MAK = L + G_MAK * IMGF; LAS float* MRK = L + G_MRK * IMGF; LAS float* GL = L + N_IMG * IMGF;
    (void)o;
    for (int chunk = bid; chunk < 4096; chunk += nb) {
        int tid = tid0; asm volatile("" : "+v"(tid));
        const int wave = __builtin_amdgcn_readfirstlane(tid >> 6), lane = tid & 63, l31 = lane & 31, hi = lane >> 5;
        const int bh = chunk >> 6, cc = chunk & 63, b = bh >> 4, h = bh & 15;
        const size_t g0 = ((size_t)(b * TP + cc * 64)) * D + h * 64;
        const int t = tid >> 3, k8 = (tid & 7) * 8;
        const size_t go = g0 + (size_t)t * D + k8;
        LDS_BARRIER();
        f32x4 r0, r1, kx0, kx1, v0, v1, q0, q1, a0, a1;
        {
            const int col = h * 64 + k8;
            const f32x4 wl0 = ld4bf(LWg + go), wl1 = ld4bf(LWg + go + 4), al0 = ld4bf(Ag + go), al1 = ld4bf(Ag + go + 4);
            kx0 = ld4bf(Kg + go); kx1 = ld4bf(Kg + go + 4); v0 = ld4bf(Vg + go); v1 = ld4bf(Vg + go + 4);
            r0 = ld4bf(Rg + go); r1 = ld4bf(Rg + go + 4);
            const float* w0p = CIN(I_W0) + o * D + col; const float* a0p = CIN(I_A0) + o * D + col; const float* kkp = CIN(I_KK) + o * D + col; const float* kap = CIN(I_KA) + o * D + col;
            const f32x4 pw0 = *GPTR(const f32x4, w0p), pw1 = *GPTR(const f32x4, w0p + 4), pa0 = *GPTR(const f32x4, a0p), pa1 = *GPTR(const f32x4, a0p + 4);
            const f32x4 pk0 = *GPTR(const f32x4, kkp), pk1 = *GPTR(const f32x4, kkp + 4), pc0 = *GPTR(const f32x4, kap), pc1 = *GPTR(const f32x4, kap + 4);
            if (o > 0) {
                const bf16_t* VFg = (const bf16_t*)(CWS + B_VF); const bf16_t* VGg = (const bf16_t*)(CWS + B_VG); const float* v0p = CIN(I_V0) + (o - 1) * D + col;
                const f32x4 vf0 = ld4bf(VFg + go), vf1 = ld4bf(VFg + go + 4), vg0 = ld4bf(VGg + go), vg1 = ld4bf(VGg + go + 4), pv0 = *GPTR(const f32x4, v0p), pv1 = *GPTR(const f32x4, v0p + 4);
#pragma unroll
                for (int i = 0; i < 4; ++i) { v0[i] = v0[i] + (vf0[i] - v0[i]) * sigmoidf_(pv0[i] + vg0[i]); v1[i] = v1[i] + (vf1[i] - v1[i]) * sigmoidf_(pv1[i] + vg1[i]); }
            } else { bf16_t* VFw = (bf16_t*)(CWS + B_VF); *GPTR(u32x4, VFw + go) = pack8(v0, v1); }
            f32x4 lw0, lw1; float n2 = 0.f;
#pragma unroll
            for (int i = 0; i < 4; ++i) {
                const float x0 = -(pw0[i] + wl0[i]), x1 = -(pw1[i] + wl1[i]);
                const float sp0 = softplusf_(x0), sp1 = softplusf_(x1);
                lw0[i] = -__expf(-sp0 - 0.5f); lw1[i] = -__expf(-sp1 - 0.5f);
                a0[i] = sigmoidf_(pa0[i] + al0[i]); a1[i] = sigmoidf_(pa1[i] + al1[i]);
                q0[i] = kx0[i] * pk0[i]; q1[i] = kx1[i] * pk1[i]; n2 += q0[i] * q0[i] + q1[i] * q1[i];
                kx0[i] = kx0[i] * (1.f + (a0[i] - 1.f) * pc0[i]); kx1[i] = kx1[i] * (1.f + (a1[i] - 1.f) * pc1[i]);
            }
            n2 += __shfl_xor(n2, 1, 64); n2 += __shfl_xor(n2, 2, 64); n2 += __shfl_xor(n2, 4, 64);
            const float inv = fminf(__builtin_amdgcn_rsqf(n2), 1e12f);
            q0 *= inv; q1 *= inv;
            *(LAS f32x4*)(MAB + t * LP + k8) = lw0; *(LAS f32x4*)(MAB + t * LP + k8 + 4) = lw1;
            bf16_t* Kw = (bf16_t*)(CWS + B_K); bf16_t* Vw = (bf16_t*)(CWS + B_V);
            *GPTR(u32x4, Kw + go) = pack8(kx0, kx1); *GPTR(u32x4, Vw + go) = pack8(v0, v1);
        }
        LDS_BARRIER();
        if (tid < 64) { float run = 0.f;
#pragma unroll
            for (int hb = 0; hb < 2; ++hb) { float cv[32];
#pragma unroll
                for (int tt = 0; tt < 32; ++tt) cv[tt] = MAB[(hb * 32 + tt) * LP + tid];
#pragma unroll
                for (int tt = 0; tt < 32; ++tt) { run += cv[tt]; MAB[(hb * 32 + tt) * LP + tid] = run; } } }
        LDS_BARRIER();
        {
            const f32x4 c0 = *(const LAS f32x4*)(MAB + t * LP + k8), c1 = *(const LAS f32x4*)(MAB + t * LP + k8 + 4);
            f32x4 p0 = (f32x4){0.f, 0.f, 0.f, 0.f}, p1 = p0;
            if (t > 0) { p0 = *(const LAS f32x4*)(MAB + (t - 1) * LP + k8); p1 = *(const LAS f32x4*)(MAB + (t - 1) * LP + k8 + 4); }
            f32x4 at0, at1, rt0, rt1, bt0, bt1, kt0, kt1;
#pragma unroll
            for (int i = 0; i < 4; ++i) {
                const float e0 = __expf(c0[i]), e1 = __expf(c1[i]), i0 = __expf(-c0[i]), i1 = __expf(-c1[i]);
                at0[i] = -q0[i] * __expf(p0[i]); at1[i] = -q1[i] * __expf(p1[i]);
                rt0[i] = r0[i] * e0; rt1[i] = r1[i] * e1;
                bt0[i] = q0[i] * a0[i] * i0; bt1[i] = q1[i] * a1[i] * i1;
                kt0[i] = kx0[i] * i0; kt1[i] = kx1[i] * i1;
                if (t == 63) { GL[k8 + i] = e0; GL[k8 + 4 + i] = e1; }
            }
            *(LAS f32x4*)(AT + t * LP + k8) = at0; *(LAS f32x4*)(AT + t * LP + k8 + 4) = at1;
            *(LAS f32x4*)(RT + t * LP + k8) = rt0; *(LAS f32x4*)(RT + t * LP + k8 + 4) = rt1;
            *(LAS f32x4*)(BT + t * LP + k8) = bt0; *(LAS f32x4*)(BT + t * LP + k8 + 4) = bt1;
            *(LAS f32x4*)(KT + t * LP + k8) = kt0; *(LAS f32x4*)(KT + t * LP + k8 + 4) = kt1;
            *(LAS f32x4*)(VV + t * LP + k8) = v0; *(LAS f32x4*)(VV + t * LP + k8 + 4) = v1;
        }
        LDS_BARRIER();
#define A2_TILE(q_) do { const int prod = (q_) >> 2, ti = ((q_) >> 1) & 1, tj = (q_) & 1; \
            const LAS float* Ai = prod == 2 ? RT : AT; const LAS float* Bi = prod == 0 ? BT : KT; LAS float* Mo = prod == 0 ? MAB : (prod == 1 ? MAK : MRK); \
            f32x16 acc = {}; \
            _Pragma("unroll") for (int s2 = 0; s2 < 4; ++s2) RWK_MMA(acc, frag_row(Ai, ti * 32 + l31, s2, hi), frag_row(Bi, tj * 32 + l31, s2, hi)); \
            const int jj = tj * 32 + l31; \
            _Pragma("unroll") for (int r = 0; r < 16; ++r) { const int tt = ti * 32 + crow(r, hi); const bool keep = prod == 2 ? (jj <= tt) : (jj < tt); Mo[tt * LP + jj] = keep ? acc[r] : 0.f; } } while (0)
        A2_TILE(wave);
        LDS_BARRIER();
        {
            f32x16 pacc = {};
            const int ti = (wave >> 1) & 1, tj = wave & 1;
            if (wave < 4) A2_TILE(wave + 8);
            else {
#pragma unroll
                for (int s2 = 0; s2 < 4; ++s2) RWK_MMA(pacc, frag_row(MAK, ti * 32 + l31, s2, hi), frag_col(VV, tj * 32 + l31, s2, hi, 1.f));
            }
            LDS_BARRIER();
            if (wave >= 4) {
#pragma unroll
                for (int r = 0; r < 16; ++r) MAK[(ti * 32 + crow(r, hi)) * LP + tj * 32 + l31] = pacc[r];
            }
        }
#undef A2_TILE
        LDS_BARRIER();
        if (tid < 128) { LAS float* img = tid < 64 ? AT : MAK; sub_solve32(MAB, img + (tid & 63)); }
        LDS_BARRIER();
        if (wave >= 4) {
            LAS float* img = (wave & 2) ? MAK : AT; const int tj = wave & 1;
            f32x16 acc;
#pragma unroll
            for (int r = 0; r < 16; ++r) acc[r] = img[(32 + crow(r, hi)) * LP + tj * 32 + l31];
#pragma unroll
            for (int s2 = 0; s2 < 2; ++s2) RWK_MMA(acc, frag_row(MAB, 32 + l31, s2, hi), frag_col(img, tj * 32 + l31, s2, hi, 1.f));
#pragma unroll
            for (int r = 0; r < 16; ++r) img[(32 + crow(r, hi)) * LP + tj * 32 + l31] = acc[r];
        }
        LDS_BARRIER();
        if (tid < 128) { LAS float* img = tid < 64 ? AT : MAK; sub_solve32(MAB + 32 * LP + 32, img + 32 * LP + (tid & 63)); }
        LDS_BARRIER();
        {
            const int ti = (wave >> 1) & 1, tj = wave & 1;
            f32x16 acc = {};
            if (wave < 4) {
#pragma unroll
                for (int s2 = 0; s2 < 4; ++s2) RWK_MMA(acc, frag_row(RT, ti * 32 + l31, s2, hi), frag_row(BT, tj * 32 + l31, s2, hi));
                const int jj = tj * 32 + l31;
#pragma unroll
                for (int r = 0; r < 16; ++r) { const int tt = ti * 32 + crow(r, hi); MAB[tt * LP + jj] = (jj <= tt) ? acc[r] : 0.f; }
            } else {
                const float gl = GL[tj * 32 + l31];
#pragma unroll
                for (int s2 = 0; s2 < 4; ++s2) RWK_MMA(acc, frag_col(AT, ti * 32 + l31, s2, hi, 1.f), frag_col(BT, tj * 32 + l31, s2, hi, gl));
                float* out = TC + (size_t)chunk * 4096;
#pragma unroll
                for (int r = 0; r < 16; ++r) { const int kr = ti * 32 + crow(r, hi), kc = tj * 32 + l31; *GPTR(float, out + kr * 64 + kc) = acc[r] + (kr == kc ? gl : 0.f); }
            }
        }
        LDS_BARRIER();
        for (int q = wave; q < 12; q += 8) {
            const int kind = q >> 2, ti = (q >> 1) & 1, tj = q & 1;
            f32x16 acc = {};
            if (kind == 0) {
#pragma unroll
                for (int r = 0; r < 16; ++r) acc[r] = RT[(ti * 32 + crow(r, hi)) * LP + tj * 32 + l31];
#pragma unroll
                for (int s2 = 0; s2 < 4; ++s2) RWK_MMA(acc, frag_row(MAB, ti * 32 + l31, s2, hi), frag_col(AT, tj * 32 + l31, s2, hi, 1.f));
                bf16_t* out = (bf16_t*)GH + (size_t)chunk * 4096;
#pragma unroll
                for (int r = 0; r < 16; ++r) *GPTR(bf16_t, out + (ti * 32 + crow(r, hi)) * 64 + tj * 32 + l31) = (bf16_t)(cvt_pk_bf16(acc[r], 0.f) & 0xffffu);
            } else if (kind == 1) {
#pragma unroll
                for (int s2 = 0; s2 < 4; ++s2) RWK_MMA(acc, frag_row(MRK, ti * 32 + l31, s2, hi), frag_col(VV, tj * 32 + l31, s2, hi, 1.f));
#pragma unroll
                for (int s2 = 0; s2 < 4; ++s2) RWK_MMA(acc, frag_row(MAB, ti * 32 + l31, s2, hi), frag_col(MAK, tj * 32 + l31, s2, hi, 1.f));
#pragma unroll
                for (int r = 0; r < 16; ++r) *GPTR(bf16_t, Yg + g0 + (size_t)(ti * 32 + crow(r, hi)) * D + tj * 32 + l31) = (bf16_t)(cvt_pk_bf16(acc[r], 0.f) & 0xffffu);
            } else {
                const float gl = GL[tj * 32 + l31];
#pragma unroll
                for (int s2 = 0; s2 < 4; ++s2) RWK_MMA(acc, frag_col(MAK, ti * 32 + l31, s2, hi, 1.f), frag_col(BT, tj * 32 + l31, s2, hi, gl));
#pragma unroll
                for (int s2 = 0; s2 < 4; ++s2) RWK_MMA(acc, frag_col(VV, ti * 32 + l31, s2, hi, 1.f), frag_col(KT, tj * 32 + l31, s2, hi, gl));
                float* out = UC + (size_t)chunk * 4096;
#pragma unroll
                for (int r = 0; r < 16; ++r) *GPTR(float, out + (ti * 32 + crow(r, hi)) * 64 + tj * 32 + l31) = acc[r];
            }
        }
    }
    LDS_BARRIER();
}

DEVI void phaseB(const Ctx& c, int o, LAS float* L, int bid, int nb) {
    constexpr int P = 65, IM = 16 * P, SLOT0 = 2 * IM + 16, SLOTF = 4096 + 1024;
    const int tid = tid_opaque(), wave = __builtin_amdgcn_readfirstlane(tid >> 6), lane = tid & 63, i15 = lane & 15, kq = lane >> 4;
    const float* TC = (const float*)(CWS + B_TC); const float* UC = (const float*)(CWS + B_UC); bf16_t* SC = (bf16_t*)(CWS + B_SC);
    for (int item = bid; item < 256; item += nb) {
        const int bh = (item & 7) + 8 * (item >> 5), vt = (item >> 3) & 3;
        LDS_BARRIER();
        f32x4 st = {0.f, 0.f, 0.f, 0.f};
        if (wave < 4) {
#pragma unroll
            for (int r = 0; r < 4; ++r) L[(4 * kq + r) * P + 16 * wave + i15] = 0.f;
        }
        f32x4 rg[3][3];
#define PB_FETCH(set, cidx) do { const size_t cb = (size_t)(bh * 64 + (cidx)) * 4096; rg[set][0] = *GPTR(const f32x4, TC + cb + 4 * tid); rg[set][1] = *GPTR(const f32x4, TC + cb + 2048 + 4 * tid); \
            if (tid < 256) rg[set][2] = *GPTR(const f32x4, UC + cb + vt * 1024 + 4 * tid); } while (0)
#define PB_PARK(set, cidx) do { LAS float* sl = L + SLOT0 + ((cidx) & 1) * SLOTF; *(LAS f32x4*)(sl + 4 * tid) = rg[set][0]; *(LAS f32x4*)(sl + 2048 + 4 * tid) = rg[set][1]; \
            if (tid < 256) *(LAS f32x4*)(sl + 4096 + 4 * tid) = rg[set][2]; } while (0)
#define PB_STEP(cidx) do { if (wave < 4) { const size_t cho = (size_t)(bh * 64 + (cidx)) * 4096; LAS float* Sc = L + ((cidx) & 1) * IM; LAS float* Sn = L + (((cidx) + 1) & 1) * IM; \
            const LAS float* Tl = L + SLOT0 + ((cidx) & 1) * SLOTF; const LAS float* Ul = Tl + 4096; \
            _Pragma("unroll") for (int r = 0; r < 4; ++r) *GPTR(bf16_t, SC + cho + (16 * vt + 4 * kq + r) * 64 + 16 * wave + i15) = (bf16_t)(cvt_pk_bf16(st[r], 0.f) & 0xffffu); \
            f32x4 a0; _Pragma("unroll") for (int r = 0; r < 4; ++r) a0[r] = Ul[(4 * kq + r) * 64 + 16 * wave + i15]; \
            f32x4 a1 = {0.f, 0.f, 0.f, 0.f}, a2 = a1, a3 = a1; \
            _Pragma("unroll") for (int s2 = 0; s2 < 16; s2 += 4) { \
                a0 = __builtin_amdgcn_mfma_f32_16x16x4f32(Sc[i15 * P + 4 * s2 + kq], Tl[(4 * s2 + kq) * 64 + 16 * wave + i15], a0, 0, 0, 0); \
                a1 = __builtin_amdgcn_mfma_f32_16x16x4f32(Sc[i15 * P + 4 * (s2 + 1) + kq], Tl[(4 * (s2 + 1) + kq) * 64 + 16 * wave + i15], a1, 0, 0, 0); \
                a2 = __builtin_amdgcn_mfma_f32_16x16x4f32(Sc[i15 * P + 4 * (s2 + 2) + kq], Tl[(4 * (s2 + 2) + kq) * 64 + 16 * wave + i15], a2, 0, 0, 0); \
                a3 = __builtin_amdgcn_mfma_f32_16x16x4f32(Sc[i15 * P + 4 * (s2 + 3) + kq], Tl[(4 * (s2 + 3) + kq) * 64 + 16 * wave + i15], a3, 0, 0, 0); } \
            st = (a0 + a1) + (a2 + a3); \
            _Pragma("unroll") for (int r = 0; r < 4; ++r) Sn[(4 * kq + r) * P + 16 * wave + i15] = st[r]; } } while (0)
        PB_FETCH(0, 0); PB_FETCH(1, 1); PB_FETCH(2, 2);
        PB_PARK(0, 0);
        LDS_BARRIER();
        for (int cc = 0; cc < 63; cc += 3) {
            PB_FETCH(0, cc + 3); PB_STEP(cc);     PB_PARK(1, cc + 1); LDS_BARRIER();
            if (cc + 4 < 64) PB_FETCH(1, cc + 4); PB_STEP(cc + 1); PB_PARK(2, cc + 2); LDS_BARRIER();
            if (cc + 5 < 64) PB_FETCH(2, cc + 5); PB_STEP(cc + 2); PB_PARK(0, cc + 3); LDS_BARRIER();
        }
        PB_STEP(63);
#undef PB_FETCH
#undef PB_PARK
#undef PB_STEP
        if (wave < 4) {
            const int b = bh >> 4, h = bh & 15;
            float* op = COUT + O_PWKV + (((size_t)(o * NBP + b) * 16 + h) * 64) * 64;
#pragma unroll
            for (int r = 0; r < 4; ++r) *GPTR(float, op + (16 * vt + 4 * kq + r) * 64 + 16 * wave + i15) = st[r];
        }
    }
    LDS_BARRIER();
}

DEVI void phaseC(const Ctx& c, int bid, int nb) {
    const int tid = tid_opaque(), wave = __builtin_amdgcn_readfirstlane(tid >> 6), lane = tid & 63, l31 = lane & 31, hi = lane >> 5;
    const float* GH = (const float*)(CWS + B_GH); const float* SC = (const float*)(CWS + B_SC); bf16_t* Yg = (bf16_t*)(CWS + B_Y);
    for (int q = bid * 8 + wave; q < 4096 * 4; q += nb * 8) {
        const int chunk = q >> 2, ti = (q >> 1) & 1, tj = q & 1, cc = chunk & 63;
        const int bh = chunk >> 6, b = bh >> 4, h = bh & 15;
        f32x16 acc = {};
        if (cc != 0) {
            const bf16_t* ga = (const bf16_t*)GH + (size_t)chunk * 4096 + (ti * 32 + l31) * 64 + 8 * hi;
            const bf16_t* sb = (const bf16_t*)SC + (size_t)chunk * 4096 + (tj * 32 + l31) * 64 + 8 * hi;
#pragma unroll
            for (int s2 = 0; s2 < 4; ++s2) RWK_MMA(acc, __builtin_bit_cast(bf16x8, *GPTR(const u32x4, ga + 16 * s2)), __builtin_bit_cast(bf16x8, *GPTR(const u32x4, sb + 16 * s2)));
        }
        const size_t yo = ((size_t)(b * TP + cc * 64)) * D + h * 64 + tj * 32 + l31;
#pragma unroll
        for (int r = 0; r < 16; ++r) { const size_t p = yo + (size_t)(ti * 32 + crow(r, hi)) * D; *GPTR(bf16_t, Yg + p) = (bf16_t)(cvt_pk_bf16(acc[r], 0.f) & 0xffffu); }
    }
}
#undef RWK_MMA
}

#define XB_TMO      128
#define XB_XCNT(j)  (256  + 64 * (j))
#define XB_XSUB(j)  (1280 + 64 * (j))
#define XB_XGEN(j)  (2304 + 64 * (j))
#define XB_TOP      3328
#define XB_TOPGEN   3392
#define XCD_BAR_WORDS 3456
#define XB_SPIN_CAP (1u << 22)
DEVI unsigned xb_ld(unsigned* p)              { return __hip_atomic_load(p, __ATOMIC_RELAXED, __HIP_MEMORY_SCOPE_AGENT); }
DEVI unsigned xb_add(unsigned* p, unsigned v) { return __hip_atomic_fetch_add(p, v, __ATOMIC_RELAXED, __HIP_MEMORY_SCOPE_AGENT); }
DEVI unsigned xb_xcc_id() { return (unsigned)__builtin_amdgcn_s_getreg((3 << 11) | 20) & 0xFu; }
#define XB_SPIN(cond, bar) do { unsigned _sp = 0; while (cond) { __builtin_amdgcn_s_sleep(1); \
    if ((++_sp & 255u) == 0u) { if (xb_ld(&(bar)[XB_TMO])) break; if (_sp > XB_SPIN_CAP) { atomicAdd(&(bar)[XB_TMO], 1u); break; } } } } while (0)
struct XcdBarrier { unsigned* bar; unsigned x; volatile LAS unsigned* st; };
DEVI XcdBarrier xcd_barrier_post(unsigned* bar, volatile LAS unsigned* st) {
    XcdBarrier b; b.bar = bar; b.x = xb_xcc_id(); b.st = st;
    if (threadIdx.x == 0) (void)xb_add(&bar[XB_XCNT(b.x)], 1u);
    return b;
}
DEVI void xcd_barrier_complete(unsigned* bar, unsigned x, unsigned& nloc, unsigned& nx) {
    const unsigned G = gridDim.x * gridDim.y * gridDim.z;
    unsigned sum, cnt, mine, sp = 0u;
    for (;;) {
        sum = 0u; cnt = 0u; mine = 0u;
#pragma unroll
        for (unsigned j = 0; j < 16; ++j) { const unsigned cc = xb_ld(&bar[XB_XCNT(j)]); sum += cc; cnt += (cc > 0u) ? 1u : 0u; mine = (j == x) ? cc : mine; }
        if (sum == G) break;
        __builtin_amdgcn_s_sleep(1);
        if ((++sp & 255u) == 0u) { if (xb_ld(&bar[XB_TMO])) break; if (sp > XB_SPIN_CAP) { atomicAdd(&bar[XB_TMO], 1u); break; } }
    }
    nloc = mine > 0u ? mine : 1u; nx = cnt > 0u ? cnt : 1u;
}
template <bool FIRST> DEVI void xcd_barrier_t(const XcdBarrier& b) {
    asm volatile("s_waitcnt vmcnt(0)" ::: "memory");
    __syncthreads();
    if (tid_opaque() == 0) {
        unsigned* bar = b.bar; asm volatile("" : "+s"(bar)); unsigned bx = b.x; asm volatile("" : "+s"(bx));
        __builtin_amdgcn_s_waitcnt(0);
        unsigned nloc = b.st[0], nx = b.st[1];
        if (FIRST) { if (nloc == 0u) { xcd_barrier_complete(bar, bx, nloc, nx); b.st[0] = nloc; b.st[1] = nx; } }
        const unsigned old = xb_add(&bar[XB_XSUB(bx)], 1u);
        const unsigned gen = old / nloc;
        if (old + 1u == (gen + 1u) * nloc) {
            __builtin_amdgcn_fence(__ATOMIC_RELEASE, "agent");
            asm volatile("s_waitcnt vmcnt(0)" ::: "memory");
            const unsigned og = xb_add(&bar[XB_TOP], 1u);
            const unsigned tg = og / nx;
            if (og + 1u == (tg + 1u) * nx) xb_add(&bar[XB_TOPGEN], 1u);
            else XB_SPIN(xb_ld(&bar[XB_TOPGEN]) == tg, bar);
            __builtin_amdgcn_fence(__ATOMIC_ACQUIRE, "agent");
            xb_add(&bar[XB_XGEN(bx)], 1u);
            asm volatile("s_waitcnt vmcnt(0)" ::: "memory");
        } else {
            asm volatile("buffer_inv sc1" ::: "memory");
            XB_SPIN(xb_ld(&bar[XB_XGEN(bx)]) == gen, bar);
            asm volatile("s_waitcnt vmcnt(0)" ::: "memory");
        }
    }
    __syncthreads();
}

#define XB_SPLIT 4096
DEVI void split_arrive(unsigned* bar) {
    asm volatile("s_waitcnt vmcnt(0)" ::: "memory");
    __syncthreads();
    if (tid_opaque() == 0) { asm volatile("" : "+s"(bar)); __builtin_amdgcn_fence(__ATOMIC_RELEASE, "agent"); asm volatile("s_waitcnt vmcnt(0)" ::: "memory"); (void)xb_add(&bar[XB_SPLIT], 1u); }
}
DEVI void split_wait(unsigned* bar, unsigned target) {
    if (tid_opaque() == 0) { asm volatile("" : "+s"(bar)); XB_SPIN(xb_ld(&bar[XB_SPLIT]) < target, bar); __builtin_amdgcn_fence(__ATOMIC_ACQUIRE, "agent"); asm volatile("s_waitcnt vmcnt(0)" ::: "memory"); }
    __syncthreads();
}

constexpr int LDS_BYTES = 147456;
constexpr int MISC_OFF = 147456 - 64;

typedef pg8::EpiStore<true, false, 0, false, D, 256, 256, false> EpiF32;
typedef pg8::EpiStore<false, true, 0, false, D, 256, 256, false> EpiB16;
typedef pg8::EpiStore<true, true, 0, false, D, 256, 256, false> EpiF32B16;
typedef pg8::EpiStore<false, true, 0, true, D, 256, 256, false> EpiQ;
typedef pg8::EpiStore<false, true, 0, false, 256, 256, 1024u * 256u, false> EpiVT;
typedef pg8::EpiStore<false, true, 1, false, 128, 128, 0, false> EpiLoraTanh;
typedef pg8::EpiStore<false, true, 0, false, 128, 128, 0, false> EpiLora128;
typedef pg8::EpiStore<false, true, 2, false, 256, 256, 0, false> EpiLoraSig;
typedef pg8::EpiStore<true, false, 0, false, D, 256, 0, true> EpiScore;
typedef pg8::EpiStore<false, true, 0, false, D, 256, 0, true> EpiPV;
typedef pg8::EpiStore<false, true, 0, false, D, 256, 256, true> EpiFold;

__global__ void __launch_bounds__(NT, 2) mega_fwd(Ctx c) {
    extern __shared__ __attribute__((aligned(16))) unsigned char lds_raw[];
    LAS unsigned char* lds = (LAS unsigned char*)lds_raw;
    float* sm = (float*)lds_raw;
    if (threadIdx.x < 4) ((volatile LAS unsigned*)(lds + MISC_OFF))[threadIdx.x] = 0u;
    __syncthreads();
    XcdBarrier xb = xcd_barrier_post((unsigned*)(CWS + B_CTL), (volatile LAS unsigned*)(lds + MISC_OFF));
    const int bid0 = blockIdx.x, nb0 = gridDim.x;
#define bid opaque_s(bid0)
#define nb opaque_s(nb0)
#define BAR() xcd_barrier_t<false>(xb)
#define ws CWS
#define rowss ((float*)(CWS + B_ROWP))
#define X ((float*)(CWS + B_X))
#define XB ((bf16_t*)(CWS + B_XB))
#define WSB(off) ((bf16_t*)(CWS + (off)))
#define WSF(off) ((float*)(CWS + (off)))
#define GEMM(LDA_, LDB_, K_, EPI_T, Aptr, Bptr, nM_, nN_, Eobj, rot) do { pg8::Order<LDA_, LDB_, false> S_; { const int nb_ = nb; S_.init((nM_), (nN_), nb_, (bid + (rot)) % nb_); } \
        pg8::gemm_phase<LDA_, LDB_, K_, false, EPI_T>(lds, (Aptr), (Bptr), S_, (Eobj)); } while (0)

#ifdef PROBE_PAIR
    unsigned long long tacc0 = 0, tacc1 = 0, tacc2 = 0, tacc3 = 0, tlast = __builtin_amdgcn_s_memrealtime();
#define TCLASS(k) do { const unsigned long long tn_ = __builtin_amdgcn_s_memrealtime(); tacc##k += tn_ - tlast; tlast = tn_; } while (0)
#else
#define TCLASS(k) do {} while (0)
#endif
    ph_prologue(c, sm, bid, nb);
    xcd_barrier_t<true>(xb); TCLASS(3);
    for (int l = 0; l < 4; ++l) {
        const int e = l >> 1, o = l >> 1;
        if ((l & 1) == 0) {
            {
                pg8::EpiEvIn E{rowss + (size_t)(3 * l) * ROWP_N, COUT, CWS, e};
                GEMM(D, D, D, pg8::EpiEvIn, XB, WSB(B_WIN) + (size_t)e * 2048 * D, 66, 8, E, 0);
            }
            if (l == 2) for (int l2 = 2; l2 < 4; ++l2) {
                { pg8::Order<D, D, true> S_; { const int nb_ = nb; S_.init(1, 4, nb_, (bid + (l2 == 2 ? 240 : 112)) % nb_); } S_.nz = 16; S_.aZ1 = 256u * D * 2; S_.aZ2 = 512; S_.bZ1 = 0; S_.bZ2 = 512;
                  EpiFold E{nullptr, WSB(B_WKT) + (size_t)l2 * 4 * D * D, nullptr, (unsigned)D * D, 256u * D};
                  pg8::gemm_phase<D, D, 256, true, EpiFold>(lds, WSB(B_PMKB) + (size_t)l2 * 1024 * D, WSB(B_XWQN) + (size_t)l2 * D * D, S_, E); }
                { pg8::Order<D, D, true> S_; { const int nb_ = nb; S_.init(4, 1, nb_, (bid + (l2 == 2 ? 176 : 240)) % nb_); } S_.nz = 16; S_.aZ1 = 0; S_.aZ2 = 512; S_.bZ1 = 256u * D * 2; S_.bZ2 = 512;
                  EpiFold E{nullptr, WSB(B_VWT) + (size_t)l2 * 4 * D * D, nullptr, (unsigned)D * D, 256u};
                  pg8::gemm_phase<D, D, 256, true, EpiFold>(lds, WSB(B_XWO) + (size_t)l2 * D * D, WSB(B_PMVT) + (size_t)l2 * 1024 * D, S_, E); }
            }
            if (l == 0) for (int l2 = 0; l2 < 4; ++l2) {
                { EpiF32B16 E{COUT + O_PMK + (size_t)l2 * 1024 * D, WSB(B_PMKB) + (size_t)l2 * 1024 * D, nullptr, 0, 0}; GEMM(D, D, D, EpiF32B16, WSB(B_MEMB), WSB(B_XWK) + (size_t)l2 * D * D, 4, 4, E, 48 * l2 + 24); }
                { EpiF32B16 E{COUT + O_PMV + (size_t)l2 * 1024 * D, WSB(B_PMVT) + (size_t)l2 * 1024 * D, nullptr, 0, 0}; GEMM(D, D, D, EpiF32B16, WSB(B_MEMB), WSB(B_XWV) + (size_t)l2 * D * D, 4, 4, E, 48 * l2 + 24 + 16); }
            }
            BAR(); TCLASS(0);
            ph_pool_prep(c, e, bid, nb);
            for (int pass = 0; pass < 2; ++pass) {
                if (((pass ^ (int)bid) & 1) == 0) {
                    const attn_body::AttnTensors AT{(const attn_body::bf16*)(CWS + B_QB), (const attn_body::bf16*)(CWS + B_KB), (const attn_body::bf16*)(CWS + B_VB), (attn_body::bf16*)(CWS + B_OV)};
                    const attn_body::StaticOrder SO((int)nb, (int)bid);
                    attn_body::attn_phase<attn_body::StaticOrder>((char*)lds_raw, AT, SO);
                } else ph_diffattn_sample(c, e, (LAS float*)lds, bid, nb);
                __syncthreads();
            }
            BAR(); TCLASS(2);
            ph_diff_combine(c, e, bid, nb);
            ph_diff_combine_sample(c, e, bid, nb);
            if (l == 0) for (int l2 = 0; l2 < 2; ++l2) {
                { pg8::Order<D, D, true> S_; { const int nb_ = nb; S_.init(1, 4, nb_, (bid + 128 * l2) % nb_); } S_.nz = 16; S_.aZ1 = 256u * D * 2; S_.aZ2 = 512; S_.bZ1 = 0; S_.bZ2 = 512;
                  EpiFold E{nullptr, WSB(B_WKT) + (size_t)l2 * 4 * D * D, nullptr, (unsigned)D * D, 256u * D};
                  pg8::gemm_phase<D, D, 256, true, EpiFold>(lds, WSB(B_PMKB) + (size_t)l2 * 1024 * D, WSB(B_XWQN) + (size_t)l2 * D * D, S_, E); }
                { pg8::Order<D, D, true> S_; { const int nb_ = nb; S_.init(4, 1, nb_, (bid + 128 * l2 + 64) % nb_); } S_.nz = 16; S_.aZ1 = 0; S_.aZ2 = 512; S_.bZ1 = 256u * D * 2; S_.bZ2 = 512;
                  EpiFold E{nullptr, WSB(B_VWT) + (size_t)l2 * 4 * D * D, nullptr, (unsigned)D * D, 256u};
                  pg8::gemm_phase<D, D, 256, true, EpiFold>(lds, WSB(B_XWO) + (size_t)l2 * D * D, WSB(B_PMVT) + (size_t)l2 * 1024 * D, S_, E); }
            }
            BAR(); TCLASS(3);
            { pg8::EpiResid E{X, XB, rowss + (size_t)(3 * l + 1) * ROWP_N}; GEMM(D, D, D, pg8::EpiResid, WSB(B_CAT), WSB(B_WOUT) + (size_t)e * D * D, 64, 4, E, 0); }
            gemm_sample<D, D, 0>((LAS float*)lds, WSB(B_CAT), WSB(B_WOUT) + (size_t)e * D * D, X, XB, rowss + (size_t)(3 * l + 1) * ROWP_N, nullptr, nullptr, bid, nb);
            BAR(); TCLASS(0);
        } else {
            ph_shiftmix(c, l, bid, nb);
            BAR(); TCLASS(3);
            {
                { EpiB16 E{nullptr, WSB(B_R), nullptr, 0, 0}; GEMM(D, D, D, EpiB16, WSB(B_XM) + (size_t)0 * M * D, WSB(B_WR) + (size_t)o * D * D, 66, 4, E, 0); }
                { EpiB16 E{nullptr, WSB(B_K), nullptr, 0, 0}; GEMM(D, D, D, EpiB16, WSB(B_XM) + (size_t)2 * M * D, WSB(B_WK) + (size_t)o * D * D, 66, 4, E, 8); }
                { EpiB16 E{nullptr, WSB(B_V), nullptr, 0, 0}; GEMM(D, D, D, EpiB16, WSB(B_XM) + (size_t)3 * M * D, WSB(B_WV) + (size_t)o * D * D, 66, 4, E, 16); }
                { EpiLoraTanh E{nullptr, WSB(B_LW), nullptr, 0, 0}; GEMM(D, D, D, EpiLoraTanh, WSB(B_XM) + (size_t)1 * M * D, WSB(B_L1) + (size_t)(o * 4 + 0) * 256 * D, 66, 1, E, 24); }
                { EpiLora128 E{nullptr, WSB(B_LA), nullptr, 0, 0}; GEMM(D, D, D, EpiLora128, WSB(B_XM) + (size_t)4 * M * D, WSB(B_L1) + (size_t)(o * 4 + 1) * 256 * D, 66, 1, E, 90); }
                { EpiLoraSig E{nullptr, WSB(B_LG), nullptr, 0, 0}; GEMM(D, D, D, EpiLoraSig, WSB(B_XM) + (size_t)5 * M * D, WSB(B_L1) + (size_t)(o * 4 + 2) * 256 * D, 66, 1, E, 156); }
                if (o > 0) { EpiLora128 E{nullptr, WSB(B_LV), nullptr, 0, 0}; GEMM(D, D, D, EpiLora128, WSB(B_XM) + (size_t)3 * M * D, WSB(B_L1) + (size_t)(o * 4 + 3) * 256 * D, 66, 1, E, 222); }
            }
            BAR(); TCLASS(0);
            {
                { EpiB16 E{nullptr, WSB(B_W), nullptr, 0, 0}; GEMM(128, 128, 128, EpiB16, WSB(B_LW), WSB(B_L2W) + (size_t)o * D * 128, 66, 4, E, 0); }
                { EpiB16 E{nullptr, WSB(B_A), nullptr, 0, 0}; GEMM(128, 128, 128, EpiB16, WSB(B_LA), WSB(B_L2A) + (size_t)o * D * 128, 66, 4, E, 8); }
                { EpiB16 E{nullptr, WSB(B_G), nullptr, 0, 0}; GEMM(256, 256, 256, EpiB16, WSB(B_LG), WSB(B_L2G) + (size_t)o * D * 256, 66, 4, E, 16); }
                if (o > 0) { EpiB16 E{nullptr, WSB(B_VG), nullptr, 0, 0}; GEMM(128, 128, 128, EpiB16, WSB(B_LV), WSB(B_L2V) + (size_t)o * D * 128, 66, 4, E, 24); }
            }
            BAR(); TCLASS(0);
            ph_rw_prep(c, o, bid, nb);
            rwk::phaseA(c, o, (LAS float*)lds, bid, nb);
            BAR(); TCLASS(1);
            ph_rw_scan(c, o, bid, nb, (LAS float*)lds);
            rwk::phaseB(c, o, (LAS float*)lds, bid, nb);
            BAR(); TCLASS(1);
            rwk::phaseC(c, bid, nb);
            BAR(); TCLASS(1);
            ph_rw_post(c, o, bid, nb);
            BAR(); TCLASS(3);
            { pg8::EpiResid E{X, XB, rowss + (size_t)(3 * l + 1) * ROWP_N}; GEMM(D, D, D, pg8::EpiResid, WSB(B_YG), WSB(B_WO) + (size_t)o * D * D, 64, 4, E, 0); }
            gemm_sample<D, D, 0>((LAS float*)lds, WSB(B_YG), WSB(B_WO) + (size_t)o * D * D, X, XB, rowss + (size_t)(3 * l + 1) * ROWP_N, nullptr, nullptr, bid, nb);
            BAR(); TCLASS(0);
        }
        {
            pg8::Order<D, D, true> S_; S_.init(16, 1, nb, bid); S_.nz = 16; S_.aZ1 = (unsigned)TP * D * 2; S_.aZ2 = 0; S_.bZ1 = (unsigned)D * D * 2; S_.bZ2 = 256u * D * 2;
            pg8::EpiSoftmax E{WSB(B_P), (unsigned)TP * D, 256, (LAS float*)(lds + 131072), rowss + (size_t)(3 * l + 1) * ROWP_N};
            pg8::gemm_phase<D, D, D, true, pg8::EpiSoftmax>(lds, XB, WSB(B_WKT) + (size_t)l * 4 * D * D, S_, E);
        }
        gemm_sample<D, D, 1>((LAS float*)lds, XB, WSB(B_XWQ) + (size_t)l * D * D, nullptr, nullptr, nullptr, rowss + (size_t)(3 * l + 1) * ROWP_N, WSB(B_Q), bid, nb);
        BAR(); TCLASS(0);
        ph_xattn_sample(c, l, (LAS float*)lds, bid, nb);
        split_arrive((unsigned*)(CWS + B_CTL));
        {
            pg8::Order<D, D, true> S_; S_.init(16, 4, nb, bid); S_.nz = 4; S_.aZ1 = 0; S_.aZ2 = (unsigned)TP * D * 2; S_.bZ1 = 0; S_.bZ2 = (unsigned)D * D * 2;
            pg8::EpiResidT<true> E{X, XB, rowss + (size_t)(3 * l + 2) * ROWP_N};
            pg8::gemm_phase<D, D, D, true, pg8::EpiResidT<true>>(lds, WSB(B_P), WSB(B_VWT) + (size_t)l * 4 * D * D, S_, E);
        }
        {
            const int b_ = bid, h_ = nb >> 1;
            if (b_ >= h_) {
                split_wait((unsigned*)(CWS + B_CTL), (unsigned)(l + 1) * (unsigned)nb);
                gemm_sample<D, D, 0>((LAS float*)lds, WSB(B_O), WSB(B_XWO) + (size_t)l * D * D, X, XB, rowss + (size_t)(3 * l + 2) * ROWP_N, nullptr, nullptr, b_ - h_, nb - h_);
            }
        }
        BAR(); TCLASS(0);
        { pg8::EpiSwiglu E{rowss + (size_t)(3 * l + 2) * ROWP_N, WSB(B_HG)}; GEMM(D, D, D, pg8::EpiSwiglu, XB, WSB(B_FGU) + (size_t)l * 5632 * D, 66, 22, E, 0); }
        BAR(); TCLASS(0);
        { pg8::EpiResid E{X, XB, rowss + (size_t)(3 * l + 3) * ROWP_N}; GEMM(DFF, DFF, DFF, pg8::EpiResid, WSB(B_HG), WSB(B_FWD) + (size_t)l * D * DFF, 64, 4, E, 0); }
        gemm_sample<DFF, DFF, 0>((LAS float*)lds, WSB(B_HG), WSB(B_FWD) + (size_t)l * D * DFF, X, XB, rowss + (size_t)(3 * l + 3) * ROWP_N, nullptr, nullptr, bid, nb);
        BAR(); TCLASS(0);
    }
    ph_final(c, bid, nb);
#ifdef PROBE_PAIR
    TCLASS(3);
    __syncthreads();
    if (blockIdx.x == 0 && threadIdx.x == 0) {
        const float tA = (float)(PROBE_PAIR == 0 ? tacc0 : tacc2) * 0.01f, tB = (float)(PROBE_PAIR == 0 ? tacc1 : tacc3) * 0.01f;
        COUT[O_YP] = 8.f * tA; COUT[O_PSHIFT] = tB;
    }
#endif
#undef ws
#undef rowss
#undef X
#undef XB
#undef bid
#undef nb
}
}

extern "C" void kernel_launch(void* const* d_in, const int* in_sizes, int n_in, void* d_out, int out_size, void* d_ws, size_t ws_size, hipStream_t stream) {
    if (n_in != N_IN || (size_t)out_size != O_END || ws_size < B_END) return;
    Ctx c; for (int i = 0; i < N_IN; ++i) c.in[i] = (const float*)d_in[i];
    c.out = (float*)d_out; c.ws = (unsigned char*)d_ws;
    static int grid = 0;
    if (!grid) {
        int dev = 0, cus = 0;
        (void)hipGetDevice(&dev);
        (void)hipDeviceGetAttribute(&cus, hipDeviceAttributeMultiprocessorCount, dev);
        (void)hipFuncSetAttribute((const void*)mega_fwd, hipFuncAttributeMaxDynamicSharedMemorySize, LDS_BYTES);
        grid = cus > 0 ? cus : 256;
    }
    (void)hipMemsetAsync(d_ws, 0, 32768, stream);
    hipLaunchKernelGGL(mega_fwd, dim3(grid), dim3(NT), LDS_BYTES, stream, c);
}
```

```cpp
#include <hip/hip_runtime.h>
#include <hip/hip_bf16.h>
#include <stdint.h>

#define DEVI __device__ __forceinline__
#define LAS __attribute__((address_space(3)))

namespace {
typedef unsigned short bf16_t;
typedef short bf16x8 __attribute__((ext_vector_type(8)));
typedef float f32x4 __attribute__((ext_vector_type(4)));
typedef unsigned u32x4 __attribute__((ext_vector_type(4)));
typedef unsigned u32x2 __attribute__((ext_vector_type(2)));

constexpr int D = 1024, NBP = 4, TP = 4096, NBS = 32, TS = 16, PAST = 4096;
constexpr int MP = NBP * TP, MS = NBS * TS, M = MP + MS;
constexpr int PW = 512, PHIST = 15;
constexpr int NMEM = 256;
constexpr int DFF = 2816;
constexpr float NORM_EPS = 1e-6f, RW_LN_EPS = 64e-5f;
constexpr int NT = 512;

constexpr size_t O_YP = 0;
constexpr size_t O_YS = O_YP + (size_t)MP * D;
constexpr size_t O_PDK = O_YS + (size_t)MS * D;
constexpr size_t O_PDV = O_PDK + (size_t)2 * MP * 512;
constexpr size_t O_PPOOL = O_PDV + (size_t)2 * MP * 512;
constexpr size_t O_PSHIFT = O_PPOOL + (size_t)2 * NBP * PHIST * PW;
constexpr size_t O_PWKV = O_PSHIFT + (size_t)2 * NBP * D;
constexpr size_t O_PMK = O_PWKV + (size_t)2 * NBP * 16 * 4096;
constexpr size_t O_PMV = O_PMK + (size_t)4 * NBP * NMEM * D;
constexpr size_t O_SDK = O_PMV + (size_t)4 * NBP * NMEM * D;
constexpr size_t O_SDV = O_SDK + (size_t)2 * MS * 512;
constexpr size_t O_SPOOL = O_SDV + (size_t)2 * MS * 512;
constexpr size_t O_SSHIFT = O_SPOOL + (size_t)2 * NBS * PHIST * PW;
constexpr size_t O_SWKV = O_SSHIFT + (size_t)2 * NBS * D;
constexpr size_t O_END = O_SWKV + (size_t)2 * NBS * 16 * 4096;

enum { I_XP = 0, I_XS, I_CDK, I_CDV, I_SPOOL, I_SSHIFT, I_SWKV, I_CMK, I_CMV, I_MEMP, I_NMIX, I_NXA, I_NFFN, I_NFIN,
       I_EWIN, I_EPW, I_EPS, I_LQ1, I_LK1, I_LQ2, I_LK2, I_SUBG, I_EWOUT, I_MU, I_WR, I_WK, I_WV, I_WO, I_W0, I_W1, I_W2,
       I_A0, I_A1, I_A2, I_V0, I_V1, I_V2, I_G1, I_G2, I_KK, I_KA, I_RK, I_LNG, I_LNB, I_XWQ, I_XWK, I_XWV, I_XWO,
       I_FWG, I_FWU, I_FWD, N_IN };

constexpr size_t MiB = 1u << 20;
constexpr size_t B_CTL = 0;
constexpr size_t B_ROWSS = 65536;
constexpr size_t CTL_BYTES = 2 * MiB;
constexpr size_t UB2 = (size_t)M * D * 2, UB4 = (size_t)M * D * 4;
constexpr size_t B_WIN = CTL_BYTES;
constexpr size_t B_WOUT = B_WIN + (size_t)2 * 2048 * 1024 * 2;
constexpr size_t B_WR = B_WOUT + (size_t)2 * 1024 * 1024 * 2;
constexpr size_t B_WK = B_WR + (size_t)2 * 1024 * 1024 * 2;
constexpr size_t B_WV = B_WK + (size_t)2 * 1024 * 1024 * 2;
constexpr size_t B_WO = B_WV + (size_t)2 * 1024 * 1024 * 2;
constexpr size_t B_L1 = B_WO + (size_t)2 * 1024 * 1024 * 2;
constexpr size_t B_L2W = B_L1 + (size_t)2 * 4 * 256 * 1024 * 2;
constexpr size_t B_L2A = B_L2W + (size_t)2 * 1024 * 128 * 2;
constexpr size_t B_L2G = B_L2A + (size_t)2 * 1024 * 128 * 2;
constexpr size_t B_L2V = B_L2G + (size_t)2 * 1024 * 256 * 2;
constexpr size_t B_XWQ = B_L2V + (size_t)2 * 1024 * 128 * 2;
constexpr size_t B_XWK = B_XWQ + (size_t)4 * 1024 * 1024 * 2;
constexpr size_t B_XWV = B_XWK + (size_t)4 * 1024 * 1024 * 2;
constexpr size_t B_XWO = B_XWV + (size_t)4 * 1024 * 1024 * 2;
constexpr size_t B_FGU = B_XWO + (size_t)4 * 1024 * 1024 * 2;
constexpr size_t B_FWD = B_FGU + (size_t)4 * 5632 * 1024 * 2;
constexpr size_t B_MEMB = B_FWD + (size_t)4 * 1024 * 2816 * 2;
constexpr size_t B_PMKB = B_MEMB + (size_t)1024 * 1024 * 2;
constexpr size_t B_PMVT = B_PMKB + (size_t)4 * 1024 * 1024 * 2;
constexpr size_t B_X = ((B_PMVT + (size_t)4 * 1024 * 1024 * 2 + 255) / 256) * 256;
constexpr size_t B_XB = B_X + UB4;
constexpr size_t B_S0 = B_XB + UB2;
constexpr size_t B_U = B_S0;
constexpr size_t B_QB = B_U + (size_t)M * 512 * 4;
constexpr size_t B_KB = B_QB + (size_t)M * 512 * 2;
constexpr size_t B_VB = B_KB + (size_t)M * 512 * 2;
constexpr size_t B_CAT = B_VB + (size_t)M * 512 * 2;
constexpr size_t B_QV = B_CAT + UB2;
constexpr size_t B_KV = B_QV + UB2;
constexpr size_t B_VV = B_KV + UB2;
constexpr size_t B_OV = B_VV + UB2;
constexpr size_t B_XM = B_S0;
constexpr size_t B_R = B_XM + 6 * UB2;
constexpr size_t B_K = B_R + UB4;
constexpr size_t B_V = B_K + UB4;
constexpr size_t B_W = B_V + UB4;
constexpr size_t B_A = B_W + UB4;
constexpr size_t B_G = B_A + UB4;
constexpr size_t B_VG = B_G + UB4;
constexpr size_t B_KK = B_VG + UB4;
constexpr size_t B_Y = B_KK + UB4;
constexpr size_t B_LW = B_Y + UB4;
constexpr size_t B_LA = B_LW + (size_t)M * 128 * 2;
constexpr size_t B_LG = B_LA + (size_t)M * 128 * 2;
constexpr size_t B_LV = B_LG + (size_t)M * 256 * 2;
constexpr size_t B_YG = B_LV + (size_t)M * 128 * 2;
constexpr size_t B_ODD_END = B_YG + UB2;
constexpr size_t CHB = (size_t)4096 * 4096 * 4;

constexpr size_t B_Q = B_S0;
constexpr size_t B_S = B_Q + UB2;
constexpr size_t B_P = B_S + UB4;
constexpr size_t B_O = B_P + UB2;
constexpr size_t B_HG = B_S0;
constexpr size_t B_VF = B_ODD_END;
constexpr size_t B_TC = B_VF + UB4, B_UC = B_TC + CHB, B_GH = B_UC + CHB, B_SC = B_GH + CHB;
constexpr size_t B_YL = B_SC + CHB;
constexpr size_t B_ROWP = B_YL + UB4;
constexpr size_t ROWP_N = (size_t)M * 16;
constexpr size_t B_DPART = B_ROWP + 13 * ROWP_N * 4;
constexpr size_t B_SMP = B_DPART + (size_t)256 * 2 * 16 * 132 * 4;
constexpr size_t SMPN = (size_t)MS * D;
constexpr size_t B_XWQN = B_SMP + 5 * SMPN * 4;
constexpr size_t B_WKT = B_XWQN + (size_t)4 * 1024 * 1024 * 2;
constexpr size_t B_VWT = B_WKT + (size_t)16 * 1024 * 1024 * 2;
constexpr size_t B_END = B_VWT + (size_t)16 * 1024 * 1024 * 2;

struct Ctx { const float* in[N_IN]; float* out; unsigned char* ws; };

template <int OFF> DEVI const void* karg_ptr() {
    unsigned long long p;
    asm volatile("s_load_dwordx2 %0, %1, %2\n\ts_waitcnt lgkmcnt(0)" : "=s"(p) : "s"(__builtin_amdgcn_kernarg_segment_ptr()), "n"(OFF) : "memory");
    return (const void*)(const __attribute__((address_space(1))) void*)p;
}
#define CIN(I) ((const float*)karg_ptr<(I) * 8>())
#define COUT ((float*)karg_ptr<N_IN * 8>())
#define CWS ((unsigned char*)karg_ptr<(N_IN + 1) * 8>())
DEVI float wave_sum(float v) {
#pragma unroll
    for (int o = 32; o > 0; o >>= 1) v += __shfl_xor(v, o, 64);
    return v;
}
DEVI int tid_opaque() { int t = threadIdx.x; asm volatile("" : "+v"(t)); return t; }
DEVI int opaque_s(int v) { asm volatile("" : "+s"(v)); return v; }
DEVI float sigmoidf_(float x) { return __builtin_amdgcn_rcpf(1.f + __expf(-x)); }
DEVI float softplusf_(float x) { return fmaxf(x, 0.f) + __logf(1.f + __expf(-fabsf(x))); }
typedef float f32x2_t_ __attribute__((ext_vector_type(2))); typedef __bf16 bf16x2_t_ __attribute__((ext_vector_type(2)));
DEVI unsigned cvt_pk_bf16(float lo, float hi) { const f32x2_t_ v = {lo, hi}; const bf16x2_t_ b = __builtin_convertvector(v, bf16x2_t_); return __builtin_bit_cast(unsigned, b); }
DEVI float bf2f(unsigned short b) { return __uint_as_float((unsigned)b << 16); }
DEVI float bflo(unsigned w) { return __uint_as_float(w << 16); }
DEVI float bfhi(unsigned w) { return __uint_as_float(w & 0xffff0000u); }
DEVI f32x4 ld4bf(const bf16_t* p) { const u32x2 w = *(const __attribute__((address_space(1))) u32x2*)p; return (f32x4){bflo(w.x), bfhi(w.x), bflo(w.y), bfhi(w.y)}; }
DEVI f32x4 cv4bf(const u32x2 w) { return (f32x4){bflo(w.x), bfhi(w.x), bflo(w.y), bfhi(w.y)}; }
DEVI void st4bf(bf16_t* p, const f32x4& v) { u32x2 w; w.x = cvt_pk_bf16(v[0], v[1]); w.y = cvt_pk_bf16(v[2], v[3]); *(__attribute__((address_space(1))) u32x2*)p = w; }
DEVI u32x4 pack8(const f32x4& a, const f32x4& b) { u32x4 w; w.x = cvt_pk_bf16(a[0], a[1]); w.y = cvt_pk_bf16(a[2], a[3]); w.z = cvt_pk_bf16(b[0], b[1]); w.w = cvt_pk_bf16(b[2], b[3]); return w; }

namespace pg8 {
constexpr int BM = 256, BK = 64, HALF = 128, HTB = HALF * BK * 2, STAGE_BYTES = 8 * HTB, NXCD = 8, WGM = 8;
__host__ __device__ __forceinline__ int lds_byte(int r, int c) { const int st = (r >> 4) * 2 + (c >> 5), rr = r & 15, cc = c & 31, ob = rr * 64 + cc * 2; return st * 1024 + (ob ^ (((ob >> 9) & 1) << 5)); }
__host__ __device__ __forceinline__ void stage_rc(int b, int& R, int& C) { const int st = b / 1024, sb = b % 1024, swz = sb ^ (((sb >> 9) & 1) << 5); R = (st >> 1) * 16 + swz / 64; C = (st & 1) * 32 + (swz % 64) / 2; }
__host__ __device__ __forceinline__ int perm32(int rho) { const int n = rho >> 4, i = rho & 15; return 8 * (i >> 2) + 4 * n + (i & 3); }

struct Unit { int pm, pn, z; };

template <int LDA, int LDB, bool BATCH> struct Order {
    int nM, nN, nz, per, G, c; unsigned aZ1, aZ2, bZ1, bZ2;
    DEVI void init(int nM_, int nN_, int G_, int c_) { nM = nM_; nN = nN_; nz = 1; per = nM * nN; G = G_; c = c_; aZ1 = aZ2 = bZ1 = bZ2 = 0; }
    DEVI bool next(int i, Unit& u) const {
        const int L = i * G + c; if (L >= per * nz) return false;
        int wgid = L % per; u.z = L / per;
        if (!BATCH) { const int q = per / NXCD, r = per % NXCD, xcd = wgid % NXCD, off = wgid / NXCD; wgid = (xcd < r ? xcd * (q + 1) : r * (q + 1) + (xcd - r) * q) + off; }
        const int nig = WGM * nN, gid = wgid / nig, fm = gid * WGM, gsz = (nM - fm) < WGM ? (nM - fm) : WGM;
        u.pm = fm + ((wgid % nig) % gsz); u.pn = (wgid % nig) / gsz; return true;
    }
    DEVI unsigned a_off(const Unit& u) const { return (BATCH ? (unsigned)(u.z >> 2) * aZ1 + (unsigned)(u.z & 3) * aZ2 : 0u) + (unsigned)u.pm * (256u * LDA * 2u); }
    DEVI unsigned b_off(const Unit& u) const { return (BATCH ? (unsigned)(u.z >> 2) * bZ1 + (unsigned)(u.z & 3) * bZ2 : 0u) + (unsigned)u.pn * (256u * LDB * 2u); }
};

template <int LDA, int LDB, int KDIM, bool BATCH, class Epi>
DEVI void gemm_phase(LAS unsigned char* lds, const bf16_t* Ag, const bf16_t* Bg, const Order<LDA, LDB, BATCH>& S, const Epi& E) {
    const int tid = tid_opaque(), wid = __builtin_amdgcn_readfirstlane(tid >> 6), lane = tid & 63, wr = wid >> 2, wc = wid & 3, fr = lane & 15, fq = lane >> 4;
    const int nt = opaque_s(KDIM / BK);
    unsigned voffA[2], voffB[2];
#pragma unroll
    for (int i = 0; i < 2; ++i) { int R, C; stage_rc(tid * 16 + i * 8192, R, C); const int Rb = (R & ~31) + perm32(R & 31);
        voffA[i] = (unsigned)(R * LDA + C) * 2u; voffB[i] = (unsigned)(Rb * LDB + C) * 2u; }
    constexpr unsigned kstep = BK * 2, hstepA = HALF * LDA * 2, hstepB = HALF * LDB * 2;
    const unsigned ldsw = (unsigned)wid * 1024u;
    const int aoff = lds_byte(wr * 64 + fr, fq * 8), boff = lds_byte(wc * 32 + fr, fq * 8);
#define PG8_SA(b, h) (((b) * 2 + (h)) * HTB)
#define PG8_SB(b, h) ((4 + (b) * 2 + (h)) * HTB)
#define PG8_STAGE(bufoff, gbase, voff) do { _Pragma("unroll") for (int _i = 0; _i < 2; ++_i) \
        __builtin_amdgcn_global_load_lds((const __attribute__((address_space(1))) unsigned*)((const __attribute__((address_space(1))) char*)(gbase) + (voff)[_i]), (LAS unsigned*)(lds + (bufoff) + ldsw + _i * 8192), 16, 0, 0); } while (0)
#define PG8_LDA(dst, b, h) do { _Pragma("unroll") for (int m = 0; m < 4; ++m) _Pragma("unroll") for (int k = 0; k < 2; ++k) dst[m][k] = *(const LAS bf16x8*)(lds + PG8_SA(b, h) + aoff + m * 2048 + k * 1024); } while (0)
#define PG8_LDB(dst, b, h) do { _Pragma("unroll") for (int n = 0; n < 2; ++n) _Pragma("unroll") for (int k = 0; k < 2; ++k) dst[n][k] = *(const LAS bf16x8*)(lds + PG8_SB(b, h) + boff + n * 2048 + k * 1024); } while (0)
#define PG8_MMA(ai, bj, At, Bt) do { __builtin_amdgcn_s_setprio(1); _Pragma("unroll") for (int m = 0; m < 4; ++m) _Pragma("unroll") for (int n = 0; n < 2; ++n) _Pragma("unroll") for (int k = 0; k < 2; ++k) \
        acc[ai][bj][m][n] = __builtin_amdgcn_mfma_f32_16x16x32_bf16(Bt[n][k], At[m][k], acc[ai][bj][m][n], 0, 0, 0); __builtin_amdgcn_s_setprio(0); } while (0)
#define PG8_WAIT_V(n) asm volatile("s_waitcnt vmcnt(" #n ")" ::: "memory")
#define PG8_WAIT_L(n) asm volatile("s_waitcnt lgkmcnt(" #n ")" ::: "memory")
#define PG8_BAR __builtin_amdgcn_s_barrier()
#define PG8_SCHED __builtin_amdgcn_sched_barrier(0)
    typedef const __attribute__((address_space(1))) char* gptr;
    Unit cur, nxt; int ui = 0;
    if (!S.next(0, cur)) return;
    f32x4 acc[2][2][4][2];
#pragma unroll
    for (int a = 0; a < 2; ++a)
#pragma unroll
        for (int b = 0; b < 2; ++b)
#pragma unroll
            for (int m = 0; m < 4; ++m)
#pragma unroll
                for (int n = 0; n < 2; ++n) acc[a][b][m][n] = (f32x4){0.f, 0.f, 0.f, 0.f};
    bf16x8 At[4][2], B0[2][2], B1[2][2];
    const gptr A0 = (gptr)Ag, B0p = (gptr)Bg;
    gptr cA = A0 + S.a_off(cur); gptr cB = B0p + S.b_off(cur);
    PG8_STAGE(PG8_SB(0, 0), cB, voffB); PG8_STAGE(PG8_SB(0, 1), cB + hstepB, voffB); PG8_STAGE(PG8_SA(0, 0), cA, voffA); PG8_STAGE(PG8_SA(0, 1), cA + hstepA, voffA);
    if (wr == 1) PG8_BAR;
    PG8_WAIT_V(2); PG8_BAR;
    PG8_STAGE(PG8_SB(1, 0), cB + kstep, voffB); PG8_STAGE(PG8_SA(1, 0), cA + kstep, voffA); PG8_STAGE(PG8_SB(1, 1), cB + hstepB + kstep, voffB);
    PG8_WAIT_V(6); PG8_BAR;
    for (;;) {
        const bool has_next = S.next(ui + 1, nxt);
        gptr nA = has_next ? A0 + S.a_off(nxt) : cA; gptr nB = has_next ? B0p + S.b_off(nxt) : cB;
        for (int t = 0; t < nt; t += 2) {
            const bool last = (t == nt - 2);
            gptr a1 = cA + (unsigned)(t + 1) * kstep;
            gptr a2 = last ? nA : cA + (unsigned)(t + 2) * kstep; gptr b2 = last ? nB : cB + (unsigned)(t + 2) * kstep;
            gptr a3 = a2 + kstep; gptr b3 = b2 + kstep;
            PG8_LDB(B0, 0, 0); PG8_LDB(B1, 0, 1); PG8_SCHED; PG8_LDA(At, 0, 0); PG8_STAGE(PG8_SA(1, 1), a1 + hstepA, voffA);
            PG8_WAIT_V(8); PG8_WAIT_L(0); PG8_BAR; PG8_MMA(0, 0, At, B0); PG8_MMA(0, 1, At, B1); PG8_BAR; PG8_SCHED;
            PG8_LDA(At, 0, 1); PG8_STAGE(PG8_SB(0, 0), b2, voffB); PG8_STAGE(PG8_SB(0, 1), b2 + hstepB, voffB); PG8_STAGE(PG8_SA(0, 0), a2, voffA);
            PG8_WAIT_V(8); PG8_WAIT_L(0); PG8_BAR; PG8_MMA(1, 0, At, B0); PG8_MMA(1, 1, At, B1); PG8_BAR; PG8_SCHED;
            PG8_LDB(B0, 1, 0); PG8_LDB(B1, 1, 1); PG8_SCHED; PG8_LDA(At, 1, 0); PG8_STAGE(PG8_SA(0, 1), a2 + hstepA, voffA);
            PG8_WAIT_V(8); PG8_WAIT_L(0); PG8_BAR; PG8_MMA(0, 0, At, B0); PG8_MMA(0, 1, At, B1); PG8_BAR; PG8_SCHED;
            PG8_LDA(At, 1, 1); PG8_STAGE(PG8_SB(1, 0), b3, voffB); PG8_STAGE(PG8_SB(1, 1), b3 + hstepB, voffB); PG8_STAGE(PG8_SA(1, 0), a3, voffA);
            PG8_WAIT_V(8); PG8_WAIT_L(0); PG8_BAR; PG8_MMA(1, 0, At, B0); PG8_MMA(1, 1, At, B1); PG8_BAR; PG8_SCHED;
        }
        if (wr == 0) PG8_BAR;
        E(acc, cur, wr, wc, fr, fq);
        if (!has_next) break;
#pragma unroll
        for (int a = 0; a < 2; ++a)
#pragma unroll
            for (int b = 0; b < 2; ++b)
#pragma unroll
                for (int m = 0; m < 4; ++m)
#pragma unroll
                    for (int n = 0; n < 2; ++n) acc[a][b][m][n] = (f32x4){0.f, 0.f, 0.f, 0.f};
        cur = nxt; cA = nA; cB = nB; ++ui;
        if (wr == 1) PG8_BAR;
    }
    PG8_WAIT_V(0);
    PG8_BAR;
#undef PG8_SA
#undef PG8_SB
#undef PG8_STAGE
#undef PG8_LDA
#undef PG8_LDB
#undef PG8_MMA
#undef PG8_WAIT_V
#undef PG8_WAIT_L
#undef PG8_BAR
#undef PG8_SCHED
}

#define GPTR(T, p) ((__attribute__((address_space(1))) T*)(p))
DEVI float rs_of(const float* rowp, unsigned row) {
    const f32x4 a = *GPTR(const f32x4, rowp + row * 16), b = *GPTR(const f32x4, rowp + row * 16 + 4), c = *GPTR(const f32x4, rowp + row * 16 + 8), d = *GPTR(const f32x4, rowp + row * 16 + 12);
    const float s = (((a[0] + a[1]) + (a[2] + a[3])) + ((b[0] + b[1]) + (b[2] + b[3]))) + (((c[0] + c[1]) + (c[2] + c[3])) + ((d[0] + d[1]) + (d[2] + d[3])));
    return rsqrtf(s * (1.f / D) + NORM_EPS);
}
template <bool F32, bool BF16, int ACT, bool RS, int LDC, int NCOL, unsigned PNS, bool BATCH> struct EpiStore {
    float* Of; bf16_t* Ob; const float* rowss; unsigned zs1, zs2;
    DEVI void operator()(const f32x4 (&acc)[2][2][4][2], const Unit& u, int wr, int wc, int fr, int fq) const {
        const unsigned row0 = u.pm * BM + wr * 64 + fr;
        const unsigned o0 = (unsigned)u.pn * PNS + (BATCH ? (unsigned)(u.z >> 2) * zs1 + (unsigned)(u.z & 3) * zs2 : 0u) + row0 * LDC + wc * 32 + 8 * fq;
#pragma unroll
        for (int ai = 0; ai < 2; ++ai)
#pragma unroll
            for (int m = 0; m < 4; ++m) {
                float sc = 1.f; if (RS) sc = rs_of(rowss, row0 + ai * HALF + m * 16);
#pragma unroll
                for (int bj = 0; bj < 2; ++bj) {
                    if (bj * HALF < NCOL) {
                        f32x4 v0 = acc[ai][bj][m][0], v1 = acc[ai][bj][m][1];
                        if (RS) { v0 *= sc; v1 *= sc; }
                        if (ACT == 1) {
#pragma unroll
                            for (int i = 0; i < 4; ++i) { v0[i] = 1.f - 2.f / (__expf(2.f * v0[i]) + 1.f); v1[i] = 1.f - 2.f / (__expf(2.f * v1[i]) + 1.f); }
                        } else if (ACT == 2) {
#pragma unroll
                            for (int i = 0; i < 4; ++i) { v0[i] = sigmoidf_(v0[i]); v1[i] = sigmoidf_(v1[i]); }
                        }
                        const unsigned off = o0 + (unsigned)((ai * HALF + m * 16) * LDC + bj * HALF);
                        if (NCOL == 256 || wc * 32 + 8 * fq + bj * HALF < NCOL) {
                            if (F32) { *GPTR(f32x4, Of + off) = v0; *GPTR(f32x4, Of + off + 4) = v1; }
                            if (BF16) *GPTR(u32x4, Ob + off) = pack8(v0, v1);
                        }
                    }
                }
            }
    }
};
struct EpiEvIn {
    const float* rowss; float* out; unsigned char* wsb; int e;
    DEVI void operator()(const f32x4 (&acc)[2][2][4][2], const Unit& u, int wr, int wc, int fr, int fq) const {
        const int seg = u.pn >> 1; const unsigned row0 = u.pm * BM + wr * 64 + fr;
        const unsigned o0 = row0 * 512 + (u.pn & 1) * 256 + wc * 32 + 8 * fq;
        const bool prompt = u.pm < (MP / 256);
        const size_t fo = (seg == 2 ? (prompt ? O_PDK : O_SDK) : (prompt ? O_PDV : O_SDV)) + (size_t)e * (prompt ? (size_t)MP : (size_t)MS) * 512 - (prompt ? (size_t)0 : (size_t)MP * 512);
        float* of = seg == 0 ? (float*)(wsb + B_U) : out + fo;
        bf16_t* ob = (bf16_t*)(wsb + (seg == 1 ? B_QB : (seg == 2 ? B_KB : B_VB)));
#pragma unroll
        for (int ai = 0; ai < 2; ++ai)
#pragma unroll
            for (int m = 0; m < 4; ++m) {
                const float sc = rs_of(rowss, row0 + ai * HALF + m * 16);
#pragma unroll
                for (int bj = 0; bj < 2; ++bj) {
                    const f32x4 v0 = acc[ai][bj][m][0] * sc, v1 = acc[ai][bj][m][1] * sc;
                    const unsigned off = o0 + (unsigned)((ai * HALF + m * 16) * 512 + bj * HALF);
                    if (seg != 1) { *GPTR(f32x4, of + off) = v0; *GPTR(f32x4, of + off + 4) = v1; }
                    if (seg != 0) {
                        if (prompt && seg == 1) { const float c2 = 0.125f * 1.4426950408889634f; *GPTR(u32x4, ob + off) = pack8(v0 * c2, v1 * c2); }
                        else if (prompt || seg == 1) *GPTR(u32x4, ob + off) = pack8(v0, v1);
                    }
                }
            }
    }
};
template <bool ZB> struct EpiResidT {
    float* X; bf16_t* XB; float* rowss_next;
    DEVI void operator()(const f32x4 (&acc)[2][2][4][2], const Unit& u, int wr, int wc, int fr, int fq) const {
        const unsigned row0 = (ZB ? (unsigned)u.z * 16u + (unsigned)u.pm : (unsigned)u.pm) * BM + wr * 64 + fr, o0 = row0 * D + u.pn * BM + wc * 32 + 8 * fq;
#pragma unroll
        for (int ai = 0; ai < 2; ++ai) {
            u32x4 xw[4][2];
#pragma unroll
            for (int m = 0; m < 4; ++m)
#pragma unroll
                for (int bj = 0; bj < 2; ++bj) xw[m][bj] = *GPTR(const u32x4, XB + (o0 + (unsigned)((ai * HALF + m * 16) * D + bj * HALF)));
#pragma unroll
            for (int m = 0; m < 4; ++m) {
                float ss = 0.f;
#pragma unroll
                for (int bj = 0; bj < 2; ++bj) {
                    const unsigned off = o0 + (unsigned)((ai * HALF + m * 16) * D + bj * HALF);
                    const u32x4 w = xw[m][bj];
                    f32x4 x0 = {bflo(w.x), bfhi(w.x), bflo(w.y), bfhi(w.y)}, x1 = {bflo(w.z), bfhi(w.z), bflo(w.w), bfhi(w.w)};
                    x0 += acc[ai][bj][m][0]; x1 += acc[ai][bj][m][1];
                    *GPTR(u32x4, XB + off) = pack8(x0, x1);
                    ss += (x0[0] * x0[0] + x0[1] * x0[1]) + (x0[2] * x0[2] + x0[3] * x0[3]) + (x1[0] * x1[0] + x1[1] * x1[1]) + (x1[2] * x1[2] + x1[3] * x1[3]);
                }
                ss += __shfl_xor(ss, 16, 64); ss += __shfl_xor(ss, 32, 64);
                if (fq == 0) *GPTR(float, rowss_next + (row0 + ai * HALF + m * 16) * 16 + u.pn * 4 + wc) = ss;
            }
            asm volatile("" ::: "memory");
        }
    }
};
typedef EpiResidT<false> EpiResid;
struct EpiSwiglu {
    const float* rowss; bf16_t* HG;
    DEVI void operator()(const f32x4 (&acc)[2][2][4][2], const Unit& u, int wr, int wc, int fr, int fq) const {
        const unsigned row0 = u.pm * BM + wr * 64 + fr, o0 = row0 * DFF + u.pn * 128 + wc * 16 + 4 * fq;
#pragma unroll
        for (int ai = 0; ai < 2; ++ai)
#pragma unroll
            for (int m = 0; m < 4; ++m) {
                const float sc = rs_of(rowss, row0 + ai * HALF + m * 16);
#pragma unroll
                for (int bj = 0; bj < 2; ++bj) {
                    const f32x4 gt = acc[ai][bj][m][0] * sc, up = acc[ai][bj][m][1] * sc;
                    f32x4 o;
#pragma unroll
                    for (int i = 0; i < 4; ++i) o[i] = gt[i] * sigmoidf_(gt[i]) * up[i];
                    u32x2 w; w.x = cvt_pk_bf16(o[0], o[1]); w.y = cvt_pk_bf16(o[2], o[3]);
                    *GPTR(u32x2, HG + (o0 + (unsigned)((ai * HALF + m * 16) * DFF + bj * 64))) = w;
                }
            }
    }
};
struct EpiSoftmax {
    bf16_t* Pb; unsigned zs1, zs2; LAS float* xl; const float* rowss;
    DEVI void operator()(const f32x4 (&acc)[2][2][4][2], const Unit& u, int wr, int wc, int fr, int fq) const {
        const float C2 = 0.0625f * 1.4426950408889634f;
        const unsigned row0 = u.pm * BM + wr * 64 + fr;
        const unsigned o0 = (unsigned)(u.z >> 2) * zs1 + (unsigned)(u.z & 3) * zs2 + row0 * D + wc * 32 + 8 * fq;
        const unsigned grow = (unsigned)(u.z >> 2) * (unsigned)TP + row0;
        float mrow[2][4];
        f32x4 (&A_)[2][2][4][2] = const_cast<f32x4 (&)[2][2][4][2]>(acc);
#pragma unroll
        for (int ai = 0; ai < 2; ++ai)
#pragma unroll
            for (int m = 0; m < 4; ++m) {
                { const float sc_ = C2 * rs_of(rowss, grow + ai * HALF + m * 16);
#pragma unroll
                  for (int bj = 0; bj < 2; ++bj)
#pragma unroll
                      for (int n = 0; n < 2; ++n) A_[ai][bj][m][n] *= sc_; }
                float mx = -3.0e38f;
#pragma unroll
                for (int bj = 0; bj < 2; ++bj)
#pragma unroll
                    for (int n = 0; n < 2; ++n) { const f32x4 v = acc[ai][bj][m][n]; mx = fmaxf(mx, fmaxf(fmaxf(v[0], v[1]), fmaxf(v[2], v[3]))); }
                mx = fmaxf(mx, __shfl_xor(mx, 16, 64)); mx = fmaxf(mx, __shfl_xor(mx, 32, 64));
                if (fq == 0) xl[(ai * HALF + wr * 64 + m * 16 + fr) * 4 + wc] = mx;
            }
        asm volatile("s_waitcnt lgkmcnt(0)\n\ts_barrier" ::: "memory");
#pragma unroll
        for (int ai = 0; ai < 2; ++ai)
#pragma unroll
            for (int m = 0; m < 4; ++m) {
                const f32x4 q = *(const LAS f32x4*)(xl + (ai * HALF + wr * 64 + m * 16 + fr) * 4);
                const float M_ = fmaxf(fmaxf(q[0], q[1]), fmaxf(q[2], q[3]));
                mrow[ai][m] = M_;
                float sm_ = 0.f;
#pragma unroll
                for (int bj = 0; bj < 2; ++bj)
#pragma unroll
                    for (int n = 0; n < 2; ++n) { const f32x4 v = acc[ai][bj][m][n];
#pragma unroll
                        for (int i = 0; i < 4; ++i) sm_ += __builtin_amdgcn_exp2f(v[i] - M_); }
                sm_ += __shfl_xor(sm_, 16, 64); sm_ += __shfl_xor(sm_, 32, 64);
                if (fq == 0) xl[1024 + (ai * HALF + wr * 64 + m * 16 + fr) * 4 + wc] = sm_;
            }
        asm volatile("s_waitcnt lgkmcnt(0)\n\ts_barrier" ::: "memory");
#pragma unroll
        for (int ai = 0; ai < 2; ++ai)
#pragma unroll
            for (int m = 0; m < 4; ++m) {
                const f32x4 q = *(const LAS f32x4*)(xl + 1024 + (ai * HALF + wr * 64 + m * 16 + fr) * 4);
                const float inv = 1.f / ((q[0] + q[1]) + (q[2] + q[3])), M_ = mrow[ai][m];
#pragma unroll
                for (int bj = 0; bj < 2; ++bj) {
                    f32x4 p0, p1;
#pragma unroll
                    for (int i = 0; i < 4; ++i) { p0[i] = __builtin_amdgcn_exp2f(acc[ai][bj][m][0][i] - M_) * inv; p1[i] = __builtin_amdgcn_exp2f(acc[ai][bj][m][1][i] - M_) * inv; }
                    *GPTR(u32x4, Pb + (o0 + (unsigned)((ai * HALF + m * 16) * D + bj * HALF))) = pack8(p0, p1);
                }
            }
    }
};
}


template <int LDA, int KDIM, int MODE>
DEVI void gemm_sample(LAS float* L, const bf16_t* A, const bf16_t* Bt, float* Xp, bf16_t* XBp, float* rowp_next, const float* rowp_cur, bf16_t* Qo, int bid, int nb) {
    const int tid = tid_opaque(), wave = __builtin_amdgcn_readfirstlane(tid >> 6), lane = tid & 63, i15 = lane & 15, kq = lane >> 4, rt = wave >> 2, ct = wave & 3;
    constexpr int KS = KDIM / 8, NS = KS / 32;
    static_assert(KS % 32 == 0, "K slice");
    LAS float* red = L + 16384;
    for (int tile = bid; tile < 256; tile += nb) {
        const int tm = tile >> 4, tn = tile & 15;
        const unsigned row = MP + tm * 32 + rt * 16 + i15;
        const unsigned off = row * D + tn * 64 + ct * 16 + 4 * kq;
        f32x4 xres = {0.f, 0.f, 0.f, 0.f}; float rsc = 1.f;
        if (MODE == 0) xres = ld4bf(XBp + off); else rsc = pg8::rs_of(rowp_cur, row);
        f32x4 acc;
        {
            const bf16_t* ap = A + (size_t)(MP + tm * 32 + i15) * LDA + wave * KS + 8 * kq; const bf16_t* bp = Bt + (size_t)(tn * 64 + i15) * KDIM + wave * KS + 8 * kq;
            f32x4 pacc[2][4];
#pragma unroll
            for (int i = 0; i < 2; ++i)
#pragma unroll
                for (int j = 0; j < 4; ++j) pacc[i][j] = (f32x4){0.f, 0.f, 0.f, 0.f};
#pragma unroll 4
            for (int s2 = 0; s2 < NS; ++s2) {
                bf16x8 af[2], bfr[4];
#pragma unroll
                for (int i = 0; i < 2; ++i) af[i] = __builtin_bit_cast(bf16x8, *GPTR(const u32x4, ap + (size_t)(i * 16) * LDA + 32 * s2));
#pragma unroll
                for (int j = 0; j < 4; ++j) bfr[j] = __builtin_bit_cast(bf16x8, *GPTR(const u32x4, bp + (size_t)(j * 16) * KDIM + 32 * s2));
#pragma unroll
                for (int i = 0; i < 2; ++i)
#pragma unroll
                    for (int j = 0; j < 4; ++j) pacc[i][j] = __builtin_amdgcn_mfma_f32_16x16x32_bf16(bfr[j], af[i], pacc[i][j], 0, 0, 0);
            }
            __syncthreads();
#pragma unroll
            for (int i = 0; i < 2; ++i)
#pragma unroll
                for (int j = 0; j < 4; ++j) *(LAS f32x4*)(L + ((wave * 8 + i * 4 + j) * 64 + lane) * 4) = pacc[i][j];
            __syncthreads();
            acc = *(const LAS f32x4*)(L + ((0 * 8 + wave) * 64 + lane) * 4);
#pragma unroll
            for (int w2 = 1; w2 < 8; ++w2) acc += *(const LAS f32x4*)(L + ((w2 * 8 + wave) * 64 + lane) * 4);
        }
        if (MODE == 0) {
            f32x4 x = xres; x += acc; (void)Xp;
            u32x2 w; w.x = cvt_pk_bf16(x[0], x[1]); w.y = cvt_pk_bf16(x[2], x[3]); *GPTR(u32x2, XBp + off) = w;
            float ss = (x[0] * x[0] + x[1] * x[1]) + (x[2] * x[2] + x[3] * x[3]);
            ss += __shfl_xor(ss, 16, 64); ss += __shfl_xor(ss, 32, 64);
            __syncthreads();
            if (kq == 0) red[(rt * 4 + ct) * 16 + i15] = ss;
            __syncthreads();
            if (ct == 0 && kq == 0) *GPTR(float, rowp_next + row * 16 + tn) = (red[(rt * 4 + 0) * 16 + i15] + red[(rt * 4 + 1) * 16 + i15]) + (red[(rt * 4 + 2) * 16 + i15] + red[(rt * 4 + 3) * 16 + i15]);
        } else {
            const f32x4 v = acc * rsc; u32x2 w; w.x = cvt_pk_bf16(v[0], v[1]); w.y = cvt_pk_bf16(v[2], v[3]); *GPTR(u32x2, Qo + off) = w;
        }
    }
}

namespace attn_body {
using bf16=__hip_bfloat16;
using bf16x8=__attribute__((ext_vector_type(8)))short;
using s16x4=__attribute__((ext_vector_type(4)))short;
using f32x16=__attribute__((ext_vector_type(16)))float;
using u32x4=__attribute__((ext_vector_type(4)))unsigned;
constexpr int BATCH=4,NHEAD=16,SEQ=4096,D=64,DM=NHEAD*D;
constexpr int NW=8,QBLK=32,QB=QBLK*NW,KVBLK=64,NQB=SEQ/QB;
constexpr int ATTN_PITCH=DM, ATTN_UNIT_ROWS=QB;
__device__ __forceinline__ int crow(int r,int hi){return (r&3)+8*(r>>2)+4*hi;}
#define SBAR() __builtin_amdgcn_sched_barrier(0)
__device__ __forceinline__ void cmask(f32x16&p0,f32x16&p1,int jb,int qrel,int hi){
  const float NEG=-INFINITY; (void)hi;
  if(jb>(qrel>>6)){
  #pragma unroll
  for(int r=0;r<16;++r){p0[r]=NEG;p1[r]=NEG;} }
}

constexpr int NSLOT=3, SLOTB=8192;
constexpr int LDS_K=0, LDS_V=NSLOT*SLOTB, LDS_WS=2*NSLOT*SLOTB, LDS_OST=LDS_WS+NW*64*4, LDS_BYTES=LDS_OST+NW*4096;
constexpr float C2=0.125f*1.4426950408889634f;
__device__ __forceinline__ void glds16(const void*gsrc,unsigned lds_dst){unsigned keep;
  asm volatile("s_mov_b32 %0, m0\n\ts_mov_b32 m0, %2\n\ts_nop 0\n\tglobal_load_lds_dwordx4 %1, off\n\ts_mov_b32 m0, %0":"=&s"(keep):"v"(gsrc),"s"(lds_dst):"memory");}
__device__ __forceinline__ float max3f(float a,float b,float c){float r;asm("v_max3_f32 %0, %1, %2, %3":"=v"(r):"v"(a),"v"(b),"v"(c));return r;}
__device__ __forceinline__ float max2f(float a,float b){float r;asm("v_max_f32_e32 %0, %1, %2":"=v"(r):"v"(a),"v"(b));return r;}
__device__ __forceinline__ float fadd_s(float a,float b){float r;asm("v_add_f32_e32 %0, %1, %2":"=v"(r):"v"(a),"v"(b));return r;}
__device__ __forceinline__ float fsub_s(float a,float b){float r;asm("v_sub_f32_e32 %0, %1, %2":"=v"(r):"v"(a),"v"(b));return r;}
typedef float f32x2_t __attribute__((ext_vector_type(2))); typedef __bf16 bf16x2_t __attribute__((ext_vector_type(2)));
__device__ __forceinline__ unsigned cvtpk_s(float lo,float hi){f32x2_t v={lo,hi};bf16x2_t b=__builtin_convertvector(v,bf16x2_t);return __builtin_bit_cast(unsigned,b);}
#define WAIT_BAR(N) asm volatile("s_waitcnt vmcnt(" #N ") lgkmcnt(0)\n\ts_barrier":::"memory")

__device__ __forceinline__ void qkt(f32x16&p0,f32x16&p1,const char*Kslot,const bf16x8*qr,const f32x16&negm,int r32,int hi){
  const char*kb=Kslot+hi*1024+r32*16;
  #pragma unroll
  for(int d0=0;d0<4;++d0){
    const bf16x8 b0=*reinterpret_cast<const bf16x8*>(kb+d0*2048);
    const bf16x8 b1=*reinterpret_cast<const bf16x8*>(kb+d0*2048+512);
    if(d0==0){p0=__builtin_amdgcn_mfma_f32_32x32x16_bf16(b0,qr[0],negm,0,0,0);p1=__builtin_amdgcn_mfma_f32_32x32x16_bf16(b1,qr[0],negm,0,0,0);}
    else{p0=__builtin_amdgcn_mfma_f32_32x32x16_bf16(b0,qr[d0],p0,0,0,0);p1=__builtin_amdgcn_mfma_f32_32x32x16_bf16(b1,qr[d0],p1,0,0,0);}}
}
typedef __attribute__((address_space(3))) const char* lds_cptr;
typedef short v4i16_t __attribute__((ext_vector_type(4)));
__device__ __forceinline__ void kload8(bf16x8*kf,lds_cptr kp){
  kf[0]=*(const __attribute__((address_space(3))) bf16x8*)(kp);      kf[1]=*(const __attribute__((address_space(3))) bf16x8*)(kp+512);
  kf[2]=*(const __attribute__((address_space(3))) bf16x8*)(kp+2048); kf[3]=*(const __attribute__((address_space(3))) bf16x8*)(kp+2560);
  kf[4]=*(const __attribute__((address_space(3))) bf16x8*)(kp+4096); kf[5]=*(const __attribute__((address_space(3))) bf16x8*)(kp+4608);
  kf[6]=*(const __attribute__((address_space(3))) bf16x8*)(kp+6144); kf[7]=*(const __attribute__((address_space(3))) bf16x8*)(kp+6656);
}
__device__ __forceinline__ void kload2(bf16x8*kf,lds_cptr kp,int j){ kf[2*j]=*(const __attribute__((address_space(3))) bf16x8*)(kp+j*2048); kf[2*j+1]=*(const __attribute__((address_space(3))) bf16x8*)(kp+j*2048+512); }
__device__ __forceinline__ s16x4 vtr(lds_cptr p){ return __builtin_bit_cast(s16x4,__builtin_amdgcn_ds_read_tr16_b64_v4i16((__attribute__((address_space(3))) v4i16_t*)p)); }
__device__ __forceinline__ float rowmax(const f32x16&p0,const f32x16&p1){
  float a=max3f(p0[0],p0[1],p1[0]),b=max3f(p0[2],p0[3],p1[1]);a=max3f(a,p1[2],p1[3]);
  #pragma unroll
  for(int r=4;r<16;r+=4){a=max3f(a,p0[r],p0[r+1]);b=max3f(b,p0[r+2],p0[r+3]);a=max3f(a,p1[r],p1[r+1]);b=max3f(b,p1[r+2],p1[r+3]);}
  const float m=max2f(a,b);
  auto rr=__builtin_amdgcn_permlane32_swap(__float_as_uint(m),__float_as_uint(m),false,false);
  return max2f(__uint_as_float(rr[0]),__uint_as_float(rr[1]));
}
__device__ __forceinline__ void pv(f32x16*o,int vb,bf16x8 pa0,bf16x8 pa1,bf16x8 pa2,bf16x8 pa3){
  #pragma unroll
  for(int d0=0;d0<2;++d0){s16x4 lo[4],hi[4];
    #pragma unroll
    for(int ks=0;ks<4;++ks){
      asm volatile("ds_read_b64_tr_b16 %0,%1 offset:%c2":"=&v"(lo[ks]):"v"(vb),"i"(d0*4096+ks*1024):"memory");
      asm volatile("ds_read_b64_tr_b16 %0,%1 offset:%c2":"=&v"(hi[ks]):"v"(vb),"i"(d0*4096+ks*1024+512):"memory");}
    asm volatile("s_waitcnt lgkmcnt(0)":::"memory");SBAR();
    #define PK(k) (bf16x8){lo[k][0],lo[k][1],lo[k][2],lo[k][3],hi[k][0],hi[k][1],hi[k][2],hi[k][3]}
    o[d0]=__builtin_amdgcn_mfma_f32_32x32x16_bf16(pa0,PK(0),o[d0],0,0,0);
    o[d0]=__builtin_amdgcn_mfma_f32_32x32x16_bf16(pa1,PK(1),o[d0],0,0,0);
    o[d0]=__builtin_amdgcn_mfma_f32_32x32x16_bf16(pa2,PK(2),o[d0],0,0,0);
    o[d0]=__builtin_amdgcn_mfma_f32_32x32x16_bf16(pa3,PK(3),o[d0],0,0,0);
    #undef PK
  }
}

#ifndef ATTN_STORE16
#define ATTN_STORE16(p,v) (*(u32x4*)(p)=(v))
#endif
template<int THRL> __device__ __forceinline__ void attn_unit(int b,int h,int qb,const bf16*Q,const bf16*__restrict__ K,const bf16*__restrict__ V,bf16*O,char*shm){
  const int tid=tid_opaque(),lane=tid&63,r32=lane&31,hi=lane>>5; const int wid=__builtin_amdgcn_readfirstlane(tid>>6);
  const long rowbase=(long)b*SEQ; const int q0=qb*QB;
  constexpr int PIN=512;
  const bf16*Qw=Q+(rowbase+q0+wid*QBLK)*PIN+(h>>1)*D;
  const bf16*Kh=K+rowbase*PIN+(h>>1)*D,*Vh=V+rowbase*PIN+((h>>2)*2+(h&1))*D;
  const unsigned lds0=(unsigned)(uintptr_t)shm;
  float*wsf=(float*)(shm+LDS_WS)+wid*64;
  const bf16*ksrc=Kh+(long)lane*PIN+wid*8;
  const bf16*vsrc=Vh+(long)(16*(wid&3)+(lane>>2))*PIN+(wid>>2)*32+(lane&3)*8;
  const unsigned kdst=lds0+LDS_K+wid*1024, vdst=lds0+LDS_V+wid*1024;
  #define DMA_K(t,slot) glds16(ksrc+(long)(t)*KVBLK*PIN,(unsigned)__builtin_amdgcn_readfirstlane(kdst+(slot)))
  #define DMA_V(t,slot) glds16(vsrc+(long)(t)*KVBLK*PIN,(unsigned)__builtin_amdgcn_readfirstlane(vdst+(slot)))
  const int vb0=(int)(lds0+LDS_V)+((lane>>4)&1)*32+(lane&3)*8+(4*hi+((lane&15)>>2))*64;
  const char*Kbase=shm+LDS_K; bf16x8 kf[8];
  const lds_cptr shm3=(lds_cptr)shm; const lds_cptr kp0=shm3+LDS_K+hi*1024+r32*16; const lds_cptr vp0=shm3+LDS_V+((lane>>4)&1)*32+(lane&3)*8+(4*hi+((lane&15)>>2))*64;
  const int NT=(q0+QB)/KVBLK;
  DMA_K(0,0);DMA_V(0,0);DMA_K(1,SLOTB);
  bf16x8 qr[4];
  #pragma unroll
  for(int d0=0;d0<4;++d0)qr[d0]=*reinterpret_cast<const bf16x8*>(&Qw[(long)r32*PIN+d0*16+hi*8]);
  float mhat=0.f,l_reg=0.f;f32x16 o[2];o[0]=f32x16{};o[1]=f32x16{};f32x16 negm=f32x16{};asm volatile("":"+v"(negm));
  const int qrel=wid*QBLK+r32;
  #define CMASK(P0,P1,t) do{int jb_=(t)-(NT-4); if(jb_>=0)cmask(P0,P1,jb_,qrel,hi);}while(0)
  bool resc=false;
  #define START(P0,P1) do{ const float rm=rowmax(P0,P1); resc=false; \
    { const float dl=rm; mhat=fadd_s(mhat,dl); \
      _Pragma("unroll") for(int r=0;r<16;++r){P0[r]=fsub_s(P0[r],dl);P1[r]=fsub_s(P1[r],dl);} \
      _Pragma("unroll") for(int r=0;r<16;++r)negm[r]=-mhat; asm volatile("":"+v"(negm)); } \
    _Pragma("unroll") for(int r=0;r<16;++r)P0[r]=__builtin_amdgcn_exp2f(P0[r]); }while(0)
  #define RESC() do{ if(resc){ asm volatile("s_waitcnt lgkmcnt(0)":::"memory"); \
      _Pragma("unroll") for(int d_=0;d_<2;++d_) _Pragma("unroll") for(int r=0;r<16;++r)o[d_][r]*=wsf[crow(r,hi)]; } }while(0)
  f32x16 pA0,pA1,pB0,pB1;
  int sl_prev=0,sl_cur=0,sl_next=SLOTB;
  #define ROT() do{sl_prev=sl_cur;sl_cur=sl_next;sl_next=(sl_next==(NSLOT-1)*SLOTB)?0:sl_next+SLOTB;}while(0)
  DMA_K(2,2*SLOTB);
  WAIT_BAR(3);
  qkt(pA0,pA1,Kbase,qr,negm,r32,hi);asm volatile("s_nop 15\n\ts_nop 7":"+v"(pA0),"+v"(pA1));CMASK(pA0,pA1,0);
  START(pA0,pA1);
  _Pragma("unroll") for(int r=0;r<16;++r)pA1[r]=__builtin_amdgcn_exp2f(pA1[r]);
  WAIT_BAR(0);
  DMA_K(3,0);DMA_V(1,SLOTB);
  ROT();
  kload8(kf,kp0+sl_cur);
  WAIT_BAR(2);
  s16x4 vlo[8],vhi[8]; u32x4 pw0,pw1,pw2,pw3;
  #define PKW(P,B) cvtpk_s(P[B],P[B+1])
  #define PAF(k) __builtin_bit_cast(bf16x8,pw##k)
  #define VFR(i) (bf16x8){vlo[i][0],vlo[i][1],vlo[i][2],vlo[i][3],vhi[i][0],vhi[i][1],vhi[i][2],vhi[i][3]}
  #define PIN(x) asm volatile("":"+v"(x))
  #define MX3(a,b,c) __builtin_fmaxf(__builtin_fmaxf((a),(b)),(c))
  #define GAPA(MF,A0,A1,A2,A3,W0,W1,PW) do{ MF; sacc+=A0; sacc+=A1; sacc+=A2; sacc+=A3; PIN(sacc); W0; W1; PIN(PW); SBAR(); }while(0)
  #define EX(v) __builtin_amdgcn_exp2f(v)
  #define GAPB(MF,X,B) do{ MF; X[B]=EX(X[B]); X[B+1]=EX(X[B+1]); X[B+2]=EX(X[B+2]); X[B+3]=EX(X[B+3]); PIN(X); SBAR(); }while(0)
  #define VRD(i) do{ vlo[i]=vtr(vp_+(((i)>>2)*4096+((i)&3)*1024)); vhi[i]=vtr(vp_+(((i)>>2)*4096+((i)&3)*1024+512)); }while(0)
  #define KRD(G,j) do{ if(G){ kload2(kf,kp0+sl_next,j); SBAR(); } }while(0)
  #define STEP(C0,C1,P0,P1,t,GK,GV,GL) do{ SBAR(); \
    const lds_cptr vp_=vp0+sl_prev; \
    VRD(0); SBAR(); float sacc=(P0[0]+P0[1]); \
    GAPA(C0=__builtin_amdgcn_mfma_f32_32x32x16_bf16(kf[0],qr[0],negm,0,0,0), P0[2],P0[3],P0[4],P0[5],     pw0[0]=PKW(P0,0), pw0[1]=PKW(P0,2), pw0); \
    VRD(4); SBAR(); GAPA(C1=__builtin_amdgcn_mfma_f32_32x32x16_bf16(kf[1],qr[0],negm,0,0,0), P0[6],P0[7],P0[8],P0[9],     pw0[2]=PKW(P0,4), pw0[3]=PKW(P0,6), pw0); \
    VRD(1); SBAR(); GAPA(C0=__builtin_amdgcn_mfma_f32_32x32x16_bf16(kf[2],qr[1],C0,0,0,0),   P0[10],P0[11],P0[12],P0[13], pw1[0]=PKW(P0,8), pw1[1]=PKW(P0,10), pw1); \
    VRD(5); SBAR(); GAPA(C1=__builtin_amdgcn_mfma_f32_32x32x16_bf16(kf[3],qr[1],C1,0,0,0),   P0[14],P0[15],P1[0],P1[1],   pw1[2]=PKW(P0,12),pw1[3]=PKW(P0,14), pw1); \
    VRD(2); SBAR(); GAPA(C0=__builtin_amdgcn_mfma_f32_32x32x16_bf16(kf[4],qr[2],C0,0,0,0),   P1[2],P1[3],P1[4],P1[5],     pw2[0]=PKW(P1,0), pw2[1]=PKW(P1,2), pw2); \
    VRD(6); SBAR(); GAPA(C1=__builtin_amdgcn_mfma_f32_32x32x16_bf16(kf[5],qr[2],C1,0,0,0),   P1[6],P1[7],P1[8],P1[9],     pw2[2]=PKW(P1,4), pw2[3]=PKW(P1,6), pw2); \
    VRD(3); SBAR(); GAPA(C0=__builtin_amdgcn_mfma_f32_32x32x16_bf16(kf[6],qr[3],C0,0,0,0),   P1[10],P1[11],P1[12],P1[13], pw3[0]=PKW(P1,8), pw3[1]=PKW(P1,10), pw3); \
    VRD(7); SBAR(); GAPA(C1=__builtin_amdgcn_mfma_f32_32x32x16_bf16(kf[7],qr[3],C1,0,0,0),   P1[14],P1[15],0.f,0.f,       pw3[2]=PKW(P1,12),pw3[3]=PKW(P1,14), pw3); \
    l_reg+=sacc; \
    if(GK){DMA_K((t)+3,sl_cur);} if(GV){DMA_V((t)+1,sl_next);} \
    CMASK(C0,C1,t); \
    { float a=MX3(C0[0],C0[1],C1[0]),b=MX3(C0[2],C0[3],C1[1]); a=MX3(a,C1[2],C1[3]); \
      _Pragma("unroll") for(int r=4;r<16;r+=4){a=MX3(a,C0[r],C0[r+1]);b=MX3(b,C0[r+2],C0[r+3]);a=MX3(a,C1[r],C1[r+1]);b=MX3(b,C1[r+2],C1[r+3]);} \
      float rm=__builtin_fmaxf(a,b); { auto rr=__builtin_amdgcn_permlane32_swap(__float_as_uint(rm),__float_as_uint(rm),false,false); rm=__builtin_fmaxf(__uint_as_float(rr[0]),__uint_as_float(rr[1])); } \
      resc=false; \
      if(__builtin_expect(__any(rm>(float)THRL),0)){ const float dl=__builtin_fmaxf(rm,0.f); mhat+=dl; \
        _Pragma("unroll") for(int r=0;r<16;++r){C0[r]-=dl;C1[r]-=dl;} \
        _Pragma("unroll") for(int r=0;r<16;++r)negm[r]=-mhat; asm volatile("":"+v"(negm)); \
        const float f=__builtin_amdgcn_exp2f(-dl); l_reg*=f; if(hi==0)wsf[r32]=f; resc=true; } } \
    SBAR(); \
    GAPB(o[0]=__builtin_amdgcn_mfma_f32_32x32x16_bf16(PAF(0),VFR(0),o[0],0,0,0), C0,0); \
    GAPB(o[1]=__builtin_amdgcn_mfma_f32_32x32x16_bf16(PAF(0),VFR(4),o[1],0,0,0), C0,4); \
    KRD(GL,0); GAPB(o[0]=__builtin_amdgcn_mfma_f32_32x32x16_bf16(PAF(1),VFR(1),o[0],0,0,0), C0,8); \
    KRD(GL,1); GAPB(o[1]=__builtin_amdgcn_mfma_f32_32x32x16_bf16(PAF(1),VFR(5),o[1],0,0,0), C0,12); \
    KRD(GL,2); GAPB(o[0]=__builtin_amdgcn_mfma_f32_32x32x16_bf16(PAF(2),VFR(2),o[0],0,0,0), C1,0); \
    KRD(GL,3); GAPB(o[1]=__builtin_amdgcn_mfma_f32_32x32x16_bf16(PAF(2),VFR(6),o[1],0,0,0), C1,4); \
    GAPB(o[0]=__builtin_amdgcn_mfma_f32_32x32x16_bf16(PAF(3),VFR(3),o[0],0,0,0), C1,8); \
    GAPB(o[1]=__builtin_amdgcn_mfma_f32_32x32x16_bf16(PAF(3),VFR(7),o[1],0,0,0), C1,12); \
    }while(0)
  int t=1;
  #undef CMASK
  #define CMASK(P0,P1,t) do{}while(0)
  for(;t+5<NT;t+=2){
    STEP(pB0,pB1,pA0,pA1,t,true,true,true);     WAIT_BAR(2); RESC(); ROT();
    STEP(pA0,pA1,pB0,pB1,t+1,true,true,true);   WAIT_BAR(2); RESC(); ROT();
  }
  #undef CMASK
  #define CMASK(P0,P1,t) do{int jb_=(t)-(NT-4); if(jb_>=0)cmask(P0,P1,jb_,qrel,hi);}while(0)
  #define ENDW(tt) do{ if((tt)+3<NT){WAIT_BAR(2);} else if((tt)+2<NT){WAIT_BAR(1);} else {WAIT_BAR(0);} }while(0)
  for(;t+1<NT;t+=2){
    STEP(pB0,pB1,pA0,pA1,t,(t+3<NT),(t+1<NT),(t+1<NT));       ENDW(t);   RESC(); ROT();
    STEP(pA0,pA1,pB0,pB1,t+1,(t+4<NT),(t+2<NT),(t+2<NT));     ENDW(t+1); RESC(); ROT();
  }
  STEP(pB0,pB1,pA0,pA1,NT-1,false,false,false); RESC();
  { float sacc=pB0[0]+pB0[1]; _Pragma("unroll") for(int r=2;r<16;++r)sacc+=pB0[r]; _Pragma("unroll") for(int r=0;r<16;++r)sacc+=pB1[r]; l_reg+=sacc;
    pw0=(u32x4){PKW(pB0,0),PKW(pB0,2),PKW(pB0,4),PKW(pB0,6)};pw1=(u32x4){PKW(pB0,8),PKW(pB0,10),PKW(pB0,12),PKW(pB0,14)};pw2=(u32x4){PKW(pB1,0),PKW(pB1,2),PKW(pB1,4),PKW(pB1,6)};pw3=(u32x4){PKW(pB1,8),PKW(pB1,10),PKW(pB1,12),PKW(pB1,14)};
    SBAR(); pv(o,vb0+sl_cur,PAF(0),PAF(1),PAF(2),PAF(3)); }
  #undef PKW
  #undef PAF
  #undef VFR
  #undef PIN
  #undef MX3
  #undef GAPA
  #undef GAPB
  #undef EX
  #undef VRD
  #undef KRD
  #undef STEP
  #undef ENDW
  {auto rr=__builtin_amdgcn_permlane32_swap(__float_as_uint(l_reg),__float_as_uint(l_reg),false,false);l_reg=__uint_as_float(rr[0])+__uint_as_float(rr[1]);}
  if(hi==0)wsf[32+r32]=l_reg;asm volatile("s_waitcnt lgkmcnt(0)":::"memory");
  float rli[16];
  #pragma unroll
  for(int r=0;r<16;++r)rli[r]=__builtin_amdgcn_rcpf(wsf[32+crow(r,hi)]);
  bf16*Ow=O+(rowbase+q0+wid*QBLK)*DM+h*D;
  { bf16*stg=(bf16*)(shm+LDS_OST)+wid*2048;
    #pragma unroll
    for(int r=0;r<16;++r){const int orow=crow(r,hi);
      #pragma unroll
      for(int d0=0;d0<2;++d0)stg[orow*64+d0*32+r32]=__float2bfloat16(o[d0][r]*rli[r]);}
    asm volatile("s_waitcnt lgkmcnt(0)":::"memory");
    #pragma unroll
    for(int i=0;i<4;++i){const int row=i*8+(lane>>3),ch=lane&7; const u32x4 v=*(const u32x4*)(stg+row*64+ch*8); ATTN_STORE16(Ow+(long)row*DM+ch*8,v);} }
  asm volatile("s_waitcnt lgkmcnt(0)\n\ts_barrier":::"memory");
  #undef DMA_K
  #undef DMA_V
  #undef CMASK
  #undef START
  #undef RESC
  #undef ROT
}
constexpr int ATTN_LDS_BYTES=LDS_BYTES;
struct AttnTensors { const bf16* Q; const bf16* K; const bf16* V; bf16* O; };
struct AttnUnit { int bh; int qb; };
struct StaticOrder {
  int vcu;
  __device__ __forceinline__ explicit StaticOrder(int grid,int block):vcu((block%8)*(grid/8)+block/8){}
  __device__ __forceinline__ bool next(int i,AttnUnit&u)const{ if(i>=4)return false; const int s=vcu&3; u.bh=vcu>>2; u.qb=(i==0)?s:(i==1)?7-s:(i==2)?8+s:15-s; return true; }
  __device__ __forceinline__ void a_ready(const AttnUnit&)const{}
  __device__ __forceinline__ void done(const AttnUnit&)const{}
};
template<class Sched,int THRL=8> __device__ __forceinline__ void attn_phase(char*lds,const AttnTensors&T,const Sched&S){
  AttnUnit u;
  for(int i=0;S.next(i,u);++i){ S.a_ready(u); attn_unit<THRL>(u.bh/NHEAD,u.bh%NHEAD,u.qb,T.Q,T.K,T.V,T.O,lds); S.done(u); }
}
#undef SBAR
#undef WAIT_BAR
}


DEVI void conv_T(const float* W, int K, int N, int ldw, bf16_t* WT, int ldt, int koff, const float* gain, int rmode, int rot, int bid, int nb) {
    bid = (bid + rot) % nb;
    const int TIDX = tid_opaque();
    const int wave = TIDX >> 6, lane = TIDX & 63, nblk = N >> 4, total = (K >> 6) * nblk;
#pragma unroll 2
    for (int st = bid * 8 + wave; st < total; st += nb * 8) {
        const int k = (st / nblk) * 64 + lane, n0 = (st % nblk) * 16;
        const float g = gain ? gain[k] : 1.f;
        const float* wp = W + (size_t)k * ldw + n0;
        const f32x4 v0 = *GPTR(const f32x4, wp), v1 = *GPTR(const f32x4, wp + 4), v2 = *GPTR(const f32x4, wp + 8), v3 = *GPTR(const f32x4, wp + 12);
        const float vv[16] = {v0[0], v0[1], v0[2], v0[3], v1[0], v1[1], v1[2], v1[3], v2[0], v2[1], v2[2], v2[3], v3[0], v3[1], v3[2], v3[3]};
#pragma unroll
        for (int j = 0; j < 16; ++j) {
            const int n = n0 + j; const int row = rmode == 0 ? n : ((n >> 2) * 8 + (n & 3) + (rmode == 2 ? 4 : 0));
            *GPTR(bf16_t, WT + (size_t)row * ldt + koff + k) = (bf16_t)(cvt_pk_bf16(vv[j] * g, 0.f) & 0xffffu);
        }
    }
}
DEVI void conv_small(const float* W, int ldw, int k_valid, int n_valid, bf16_t* WT, int R, int C, int bid, int nb) {
    const int TIDX = tid_opaque();
    const int total = R * C;
#pragma unroll 4
    for (int i = bid * NT + TIDX; i < total; i += nb * NT) { const int r = i / C, cc = i % C; float v = 0.f; if (r < n_valid && cc < k_valid) v = W[(size_t)cc * ldw + r];
        WT[i] = (bf16_t)(cvt_pk_bf16(v, 0.f) & 0xffffu); }
}
DEVI void conv_poolw(const Ctx& c, int e, bf16_t* WT, int bid, int nb) {
    const int TIDX = tid_opaque();
    const float* Wg = CIN(I_EPW) + (size_t)e * 4 * 128 * 128; const float* scl = CIN(I_EPS) + e * PW; const float* wo = CIN(I_EWOUT) + (size_t)e * D * D;
    for (int i = bid * NT + TIDX; i < 1024 * 128; i += nb * NT) {
        const int n = i & 1023, kg = __builtin_amdgcn_readfirstlane(i >> 10), k0 = kg * 4, g = k0 >> 7, kk0 = k0 & 127;
        const float* wgp = Wg + (size_t)(g * 128 + kk0) * 128; const float* sp = scl + g * 128; const float* wop = wo + (size_t)(g * 128) * D + n;
        float a[4] = {0.f, 0.f, 0.f, 0.f};
#pragma unroll 16
        for (int jj = 0; jj < 128; ++jj) {
            const float w = wop[(size_t)jj * D] * sp[jj];
#pragma unroll
            for (int j = 0; j < 4; ++j) a[j] = fmaf(wgp[j * 128 + jj], w, a[j]);
        }
        u32x2 w2; w2.x = cvt_pk_bf16(a[0], a[1]); w2.y = cvt_pk_bf16(a[2], a[3]);
        *(u32x2*)(WT + (size_t)n * D + k0) = w2;
    }
}
DEVI float cs_ld(const float* W, int ldw, int kv, int nv, int C, int total, int i) { float v = 0.f; if (i < total) { const int r = i / C, cc = i % C; if (r < nv && cc < kv) v = W[(size_t)cc * ldw + r]; } return v; }
DEVI void cs_st(bf16_t* WT, int total, int i, float v) { if (i < total) WT[i] = (bf16_t)(cvt_pk_bf16(v, 0.f) & 0xffffu); }
DEVI void conv_rowgain(const float* W, const float* gain, bf16_t* O, int bid, int nb) {
    const int TIDX = tid_opaque();
    for (int i = bid * NT + TIDX; i < 1024 * 1024 / 8; i += nb * NT) {
        const float g = gain[i >> 7];
        const f32x4 a = *GPTR(const f32x4, W + (size_t)i * 8), b = *GPTR(const f32x4, W + (size_t)i * 8 + 4);
        *GPTR(u32x4, O + (size_t)i * 8) = pack8(a * g, b * g);
    }
}
DEVI void ph_prologue(const Ctx& c, float* sm, int bid, int nb) {
    const int TIDX = tid_opaque();
    unsigned char* ws = CWS;
    for (int e = 0; e < 2; ++e) {
        conv_T(CIN(I_EWIN) + (size_t)e * D * 2048, D, 2048, 2048, (bf16_t*)(ws + B_WIN) + (size_t)e * 2048 * D, D, 0, CIN(I_NMIX) + (2 * e) * D, 0, 0, bid, nb);
        conv_T(CIN(I_EWOUT) + (size_t)e * D * D + (size_t)512 * D, 512, D, D, (bf16_t*)(ws + B_WOUT) + (size_t)e * D * D, D, 512, nullptr, 0, 0, bid, nb);
        conv_poolw(c, e, (bf16_t*)(ws + B_WOUT) + (size_t)e * D * D, bid, nb);
    }
    for (int o = 0; o < 2; ++o) {
        conv_T(CIN(I_WR) + (size_t)o * D * D, D, D, D, (bf16_t*)(ws + B_WR) + (size_t)o * D * D, D, 0, nullptr, 0, 64, bid, nb);
        conv_T(CIN(I_WK) + (size_t)o * D * D, D, D, D, (bf16_t*)(ws + B_WK) + (size_t)o * D * D, D, 0, nullptr, 0, 192, bid, nb);
        conv_T(CIN(I_WV) + (size_t)o * D * D, D, D, D, (bf16_t*)(ws + B_WV) + (size_t)o * D * D, D, 0, nullptr, 0, 64, bid, nb);
        conv_T(CIN(I_WO) + (size_t)o * D * D, D, D, D, (bf16_t*)(ws + B_WO) + (size_t)o * D * D, D, 0, nullptr, 0, 192, bid, nb);
        bf16_t* l1 = (bf16_t*)(ws + B_L1) + (size_t)o * 4 * 256 * D;
        {
            const int i0 = bid * NT + TIDX, i1 = i0 + nb * NT;
#define CS_JOB(name, W_, ldw_, kv_, nv_, WT_, R_, C_) const float* name##w = (W_); bf16_t* name##t = (WT_); const int name##l = (ldw_), name##k = (kv_), name##n = (nv_), name##c = (C_), name##tot = (R_) * (C_); \
            const float name##0 = cs_ld(name##w, name##l, name##k, name##n, name##c, name##tot, i0), name##1 = cs_ld(name##w, name##l, name##k, name##n, name##c, name##tot, i1)
#define CS_PUT(name) do { cs_st(name##t, name##tot, i0, name##0); cs_st(name##t, name##tot, i1, name##1); } while (0)
            const int ov = o > 0 ? o - 1 : 0; const int vv = o > 0 ? 32 : 0;
            CS_JOB(jw1, CIN(I_W1) + (size_t)o * D * 64, 64, D, 64, l1, 256, D);
            CS_JOB(ja1, CIN(I_A1) + (size_t)o * D * 64, 64, D, 64, l1 + (size_t)256 * D, 256, D);
            CS_JOB(jg1, CIN(I_G1) + (size_t)o * D * 160, 160, D, 160, l1 + (size_t)2 * 256 * D, 256, D);
            CS_JOB(jv1, CIN(I_V1) + (size_t)ov * D * 32, 32, D, vv, l1 + (size_t)3 * 256 * D, 256, D);
            CS_JOB(jw2, CIN(I_W2) + (size_t)o * 64 * D, D, 64, D, (bf16_t*)(ws + B_L2W) + (size_t)o * D * 128, D, 128);
            CS_JOB(ja2, CIN(I_A2) + (size_t)o * 64 * D, D, 64, D, (bf16_t*)(ws + B_L2A) + (size_t)o * D * 128, D, 128);
            CS_JOB(jg2, CIN(I_G2) + (size_t)o * 160 * D, D, 160, D, (bf16_t*)(ws + B_L2G) + (size_t)o * D * 256, D, 256);
            CS_JOB(jv2, CIN(I_V2) + (size_t)ov * 32 * D, D, vv, D, (bf16_t*)(ws + B_L2V) + (size_t)o * D * 128, D, 128);
            CS_PUT(jw1); CS_PUT(ja1); CS_PUT(jg1); if (o > 0) CS_PUT(jv1);
            CS_PUT(jw2); CS_PUT(ja2); CS_PUT(jg2); if (o > 0) CS_PUT(jv2);
#undef CS_JOB
#undef CS_PUT
        }
    }
    for (int l = 0; l < 4; ++l) {
        conv_T(CIN(I_XWQ) + (size_t)l * D * D, D, D, D, (bf16_t*)(ws + B_XWQ) + (size_t)l * D * D, D, 0, CIN(I_NXA) + l * D, 0, 64, bid, nb);
        conv_rowgain(CIN(I_XWQ) + (size_t)l * D * D, CIN(I_NXA) + l * D, (bf16_t*)(ws + B_XWQN) + (size_t)l * D * D, bid, nb);
        conv_T(CIN(I_XWK) + (size_t)l * D * D, D, D, D, (bf16_t*)(ws + B_XWK) + (size_t)l * D * D, D, 0, nullptr, 0, 192, bid, nb);
        conv_T(CIN(I_XWV) + (size_t)l * D * D, D, D, D, (bf16_t*)(ws + B_XWV) + (size_t)l * D * D, D, 0, nullptr, 0, 64, bid, nb);
        conv_T(CIN(I_XWO) + (size_t)l * D * D, D, D, D, (bf16_t*)(ws + B_XWO) + (size_t)l * D * D, D, 0, nullptr, 0, 192, bid, nb);
        conv_T(CIN(I_FWG) + (size_t)l * D * DFF, D, DFF, DFF, (bf16_t*)(ws + B_FGU) + (size_t)l * 5632 * D, D, 0, CIN(I_NFFN) + l * D, 1, 64, bid, nb);
        conv_T(CIN(I_FWU) + (size_t)l * D * DFF, D, DFF, DFF, (bf16_t*)(ws + B_FGU) + (size_t)l * 5632 * D, D, 0, CIN(I_NFFN) + l * D, 2, 160, bid, nb);
        conv_T(CIN(I_FWD) + (size_t)l * DFF * D, DFF, D, D, (bf16_t*)(ws + B_FWD) + (size_t)l * D * DFF, DFF, 0, nullptr, 0, 0, bid, nb);
    }
    {
        const int wave = TIDX >> 6, lane = TIDX & 63;
        bf16_t* XB = (bf16_t*)(ws + B_XB); float* rowss = (float*)(ws + B_ROWP);
        const int step = nb * 8;
        for (int r0 = bid * 8 + wave; r0 < M + 1024; r0 += 3 * step) {
            f32x4 v[3][4];
#pragma unroll
            for (int j = 0; j < 3; ++j) { const int r = r0 + j * step;
                if (r < M + 1024) { const float* xr = r < MP ? CIN(I_XP) + (size_t)r * D : (r < M ? CIN(I_XS) + (size_t)(r - MP) * D : CIN(I_MEMP) + (size_t)(r - M) * D);
#pragma unroll
                    for (int i = 0; i < 4; ++i) v[j][i] = *GPTR(const f32x4, xr + 4 * (lane + 64 * i)); } }
#pragma unroll
            for (int j = 0; j < 3; ++j) { const int r = r0 + j * step;
                if (r < M + 1024) { bf16_t* o = r < M ? XB + (size_t)r * D : (bf16_t*)(ws + B_MEMB) + (size_t)(r - M) * D;
                    float ss = 0.f;
#pragma unroll
                    for (int i = 0; i < 4; ++i) { const f32x4 x = v[j][i]; ss += (x[0] * x[0] + x[1] * x[1]) + (x[2] * x[2] + x[3] * x[3]);
                        u32x2 w; w.x = cvt_pk_bf16(x[0], x[1]); w.y = cvt_pk_bf16(x[2], x[3]); *GPTR(u32x2, o + 4 * (lane + 64 * i)) = w; }
                    if (r < M) { ss = wave_sum(ss); if (lane < 16) rowss[(size_t)r * 16 + lane] = lane == 0 ? ss : 0.f; } } }
        }
    }
}

DEVI float lam_init_of(int layer) { return 0.8f - 0.6f * __expf(-0.3f * (float)layer); }
DEVI float lam_of(const Ctx& c, int e) {
    float s1 = 0.f, s2 = 0.f;
    for (int i = 0; i < 64; ++i) { s1 += CIN(I_LQ1)[e * 64 + i] * CIN(I_LK1)[e * 64 + i]; s2 += CIN(I_LQ2)[e * 64 + i] * CIN(I_LK2)[e * 64 + i]; }
    return __expf(s1) - __expf(s2) + lam_init_of(2 * e);
}
DEVI void ph_pool_prep(const Ctx& c, int e, int bid, int nb) {
    const int TIDX = tid_opaque();
    const float* Uf = (const float*)(CWS + B_U); bf16_t* CAT = (bf16_t*)(CWS + B_CAT);
    const size_t total = (size_t)M * 128;
    for (size_t idx = (size_t)bid * NT + TIDX; idx < total; idx += (size_t)nb * NT) {
        const int row = (int)(idx >> 7), col = (int)(idx & 127) * 4;
        const int w = 2 << (col >> 7);
        const bool prompt = row < MP;
        const int b = prompt ? row / TP : (row - MP) / TS, t = prompt ? row % TP : (row - MP) % TS;
        const float4 u = *(const float4*)(Uf + (size_t)row * PW + col);
        float4 s = make_float4(0.f, 0.f, 0.f, 0.f);
        for (int i = 0; i < w; ++i) {
            const int tt = t - i;
            float4 v = make_float4(0.f, 0.f, 0.f, 0.f);
            if (tt >= 0) v = *(const float4*)(Uf + (size_t)(row - i) * PW + col);
            else if (!prompt) v = *(const float4*)(CIN(I_SPOOL) + ((size_t)(e * NBS + b) * PHIST + (PHIST + tt)) * PW + col);
            s.x += v.x; s.y += v.y; s.z += v.z; s.w += v.w;
        }
        const float ic = 1.f / (prompt ? (float)((t + 1) < w ? (t + 1) : w) : (float)w);
        u32x2 o; o.x = cvt_pk_bf16(s.x * ic - u.x, s.y * ic - u.y); o.y = cvt_pk_bf16(s.z * ic - u.z, s.w * ic - u.w);
        *(u32x2*)(CAT + (size_t)row * D + col) = o;
        if (prompt) { if (t >= TP - PHIST) *(float4*)(COUT + O_PPOOL + ((size_t)(e * NBP + b) * PHIST + (t - (TP - PHIST))) * PW + col) = u; }
        else { if (t >= 1) *(float4*)(COUT + O_SPOOL + ((size_t)(e * NBS + b) * PHIST + (t - 1)) * PW + col) = u; }
    }
}
DEVI void ph_diffattn(const Ctx& c, int e, int item0, int bid, int nb, float* sm) {
    const int TIDX = tid_opaque();
    const bf16_t* QB = (const bf16_t*)(CWS + B_QB); const bf16_t* KB = (const bf16_t*)(CWS + B_KB); const bf16_t* VB = (const bf16_t*)(CWS + B_VB); bf16_t* CAT = (bf16_t*)(CWS + B_CAT);
    const int t = TIDX, qi = t & 63, map = (t >> 6) & 1, part = t >> 7;
    float* Ks = sm; float* Vs = sm + 32 * 128;
    const float lam = lam_of(c, e), li = lam_init_of(2 * e);
    for (int item = item0 + bid; item < 1152; item += nb) {
        int b, h, nq, qrow0, n_past, n_new, newrow0; const float* pastK = nullptr; const float* pastV = nullptr;
        if (item < 1024) { b = item >> 8; h = (item >> 6) & 3; const int ch = item & 63; nq = 64; qrow0 = b * TP + ch * 64; n_past = 0; n_new = (ch + 1) * 64; newrow0 = b * TP; }
        else { const int it = item - 1024; b = it >> 2; h = it & 3; nq = TS; qrow0 = MP + b * TS; n_past = PAST; n_new = TS; newrow0 = MP + b * TS;
               pastK = CIN(I_CDK) + ((size_t)(e * NBS + b) * PAST) * 512 + h * 128; pastV = CIN(I_CDV) + ((size_t)(e * NBS + b) * PAST) * 512 + h * 128; }
        const bool act = qi < nq;
        float q[64], o[32];
        {
            const bf16_t* qp = QB + (size_t)(qrow0 + (act ? qi : 0)) * 512 + h * 128 + map * 64;
#pragma unroll
            for (int d = 0; d < 64; d += 8) { const u32x4 v = *(const u32x4*)(qp + d);
                q[d] = bflo(v.x) * 0.125f; q[d + 1] = bfhi(v.x) * 0.125f; q[d + 2] = bflo(v.y) * 0.125f; q[d + 3] = bfhi(v.y) * 0.125f;
                q[d + 4] = bflo(v.z) * 0.125f; q[d + 5] = bfhi(v.z) * 0.125f; q[d + 6] = bflo(v.w) * 0.125f; q[d + 7] = bfhi(v.w) * 0.125f; }
        }
#pragma unroll
        for (int d = 0; d < 32; ++d) o[d] = 0.f;
        float mx = -1e30f, l = 0.f;
        const int total = n_past + n_new;
        for (int k0 = 0; k0 < total; k0 += 32) {
            __syncthreads();
            {
                const int key = t >> 4, c8 = (t & 15) * 8, kg = k0 + key;
                float4 k0v = make_float4(0.f, 0.f, 0.f, 0.f), k1v = k0v, v0v = k0v, v1v = k0v;
                if (kg < total) {
                    if (kg < n_past) { const float* kp = pastK + (size_t)kg * 512 + c8; const float* vp = pastV + (size_t)kg * 512 + c8;
                        k0v = *(const float4*)kp; k1v = *(const float4*)(kp + 4); v0v = *(const float4*)vp; v1v = *(const float4*)(vp + 4); }
                    else { const size_t off = (size_t)(newrow0 + kg - n_past) * 512 + h * 128 + c8; const u32x4 kw = *(const u32x4*)(KB + off), vw = *(const u32x4*)(VB + off);
                        k0v = make_float4(bflo(kw.x), bfhi(kw.x), bflo(kw.y), bfhi(kw.y)); k1v = make_float4(bflo(kw.z), bfhi(kw.z), bflo(kw.w), bfhi(kw.w));
                        v0v = make_float4(bflo(vw.x), bfhi(vw.x), bflo(vw.y), bfhi(vw.y)); v1v = make_float4(bflo(vw.z), bfhi(vw.z), bflo(vw.w), bfhi(vw.w)); }
                }
                *(float4*)(Ks + key * 128 + c8) = k0v; *(float4*)(Ks + key * 128 + c8 + 4) = k1v; *(float4*)(Vs + key * 128 + c8) = v0v; *(float4*)(Vs + key * 128 + c8 + 4) = v1v;
            }
            __syncthreads();
            const int nk = (total - k0) < 32 ? (total - k0) : 32;
            for (int kk = 0; kk < nk; ++kk) {
                const float* kr = Ks + kk * 128 + map * 64;
                float s = 0.f;
#pragma unroll
                for (int d = 0; d < 64; d += 4) { const float4 k4 = *(const float4*)(kr + d); s = fmaf(q[d], k4.x, s); s = fmaf(q[d + 1], k4.y, s); s = fmaf(q[d + 2], k4.z, s); s = fmaf(q[d + 3], k4.w, s); }
                if (s > mx) { const float cf = __expf(mx - s); l *= cf;
#pragma unroll
                    for (int d = 0; d < 32; ++d) o[d] *= cf;
                    mx = s; }
                const float p = __expf(s - mx); l += p;
                const float* vr = Vs + kk * 128 + part * 32;
#pragma unroll
                for (int d = 0; d < 32; d += 4) { const float4 v4 = *(const float4*)(vr + d); o[d] = fmaf(p, v4.x, o[d]); o[d + 1] = fmaf(p, v4.y, o[d + 1]); o[d + 2] = fmaf(p, v4.z, o[d + 2]); o[d + 3] = fmaf(p, v4.w, o[d + 3]); }
            }
        }
        __syncthreads();
        const float inv = 1.f / l;
        if (map == 1) {
#pragma unroll
            for (int d = 0; d < 32; ++d) sm[qi * 128 + part * 32 + d] = o[d] * inv;
        }
        __syncthreads();
        float ssq = 0.f;
        if (map == 0) {
#pragma unroll
            for (int d = 0; d < 32; ++d) { o[d] = o[d] * inv - lam * sm[qi * 128 + part * 32 + d]; ssq += o[d] * o[d]; }
        }
        __syncthreads();
        if (map == 0) sm[part * 64 + qi] = ssq;
        __syncthreads();
        if (map == 0 && act) {
            const float tot = sm[qi] + sm[64 + qi] + sm[128 + qi] + sm[192 + qi];
            const float sc = rsqrtf(tot * (1.f / 128.f) + NORM_EPS) * (1.f - li);
            bf16_t* op = CAT + (size_t)(qrow0 + qi) * D + 512 + h * 128 + part * 32;
            const float* gp = CIN(I_SUBG) + e * 128 + part * 32;
#pragma unroll
            for (int d = 0; d < 32; d += 8) { u32x4 w; w.x = cvt_pk_bf16(o[d] * sc * gp[d], o[d + 1] * sc * gp[d + 1]); w.y = cvt_pk_bf16(o[d + 2] * sc * gp[d + 2], o[d + 3] * sc * gp[d + 3]);
                w.z = cvt_pk_bf16(o[d + 4] * sc * gp[d + 4], o[d + 5] * sc * gp[d + 5]); w.w = cvt_pk_bf16(o[d + 6] * sc * gp[d + 6], o[d + 7] * sc * gp[d + 7]); *(u32x4*)(op + d) = w; }
        }
    }
}
DEVI void ph_diff_combine(const Ctx& c, int e, int bid, int nb) {
    const int TIDX = tid_opaque();
    const bf16_t* OV = (const bf16_t*)(CWS + B_OV); bf16_t* CAT = (bf16_t*)(CWS + B_CAT);
    const int wave = TIDX >> 6, lane = TIDX & 63, hh = lane >> 4, i16 = lane & 15;
    const float lam = lam_of(c, e), li = lam_init_of(2 * e);
    const float* gp = CIN(I_SUBG) + e * 128 + 8 * i16;
    const f32x4 g0 = *GPTR(const f32x4, gp), g1 = *GPTR(const f32x4, gp + 4);
    const int vcol = (hh * 4 + (i16 >> 3)) * 64 + ((8 * i16) & 63);
    const int step = nb * 8;
    for (int row0 = bid * 8 + wave; row0 < MP; row0 += 4 * step) {
        u32x4 w0[4], w1[4];
#pragma unroll
        for (int j = 0; j < 4; ++j) { const int row = row0 + j * step;
            if (row < MP) { w0[j] = *GPTR(const u32x4, OV + (size_t)row * 1024 + vcol); w1[j] = *GPTR(const u32x4, OV + (size_t)row * 1024 + vcol + 128); } }
#pragma unroll
        for (int j = 0; j < 4; ++j) { const int row = row0 + j * step;
            if (row < MP) {
                f32x4 a0 = {bflo(w0[j].x) - lam * bflo(w1[j].x), bfhi(w0[j].x) - lam * bfhi(w1[j].x), bflo(w0[j].y) - lam * bflo(w1[j].y), bfhi(w0[j].y) - lam * bfhi(w1[j].y)};
                f32x4 a1 = {bflo(w0[j].z) - lam * bflo(w1[j].z), bfhi(w0[j].z) - lam * bfhi(w1[j].z), bflo(w0[j].w) - lam * bflo(w1[j].w), bfhi(w0[j].w) - lam * bfhi(w1[j].w)};
                float ss = ((a0[0] * a0[0] + a0[1] * a0[1]) + (a0[2] * a0[2] + a0[3] * a0[3])) + ((a1[0] * a1[0] + a1[1] * a1[1]) + (a1[2] * a1[2] + a1[3] * a1[3]));
                ss += __shfl_xor(ss, 1, 64); ss += __shfl_xor(ss, 2, 64); ss += __shfl_xor(ss, 4, 64); ss += __shfl_xor(ss, 8, 64);
                const float sc = rsqrtf(ss * (1.f / 128.f) + NORM_EPS) * (1.f - li);
                a0 = a0 * g0 * sc; a1 = a1 * g1 * sc;
                *GPTR(u32x4, CAT + (size_t)row * D + 512 + hh * 128 + 8 * i16) = pack8(a0, a1); } }
    }
}
DEVI void ph_diffattn_sample(const Ctx& c, int e, LAS float* L, int bid, int nb) {
    const int tid = tid_opaque(), wave = __builtin_amdgcn_readfirstlane(tid >> 6), lane = tid & 63, i15 = lane & 15, kq = lane >> 4;
    const bf16_t* QB = (const bf16_t*)(CWS + B_QB);
    float* PART = (float*)(CWS + B_DPART);
    const float C2 = 0.125f * 1.4426950408889634f;
    for (int unit = bid; unit < 256; unit += nb) {
        const int half = unit & 1, bh = unit >> 1, b = bh >> 2, h = bh & 3;
        const float* Kc = CIN(I_CDK) + ((size_t)(e * NBS + b) * PAST) * 512 + h * 128;
        const float* Vc = CIN(I_CDV) + ((size_t)(e * NBS + b) * PAST) * 512 + h * 128;
        bf16x8 qf[2][2];
#pragma unroll
        for (int mp = 0; mp < 2; ++mp)
#pragma unroll
            for (int s2 = 0; s2 < 2; ++s2) {
                const u32x4 w = *GPTR(const u32x4, QB + (size_t)(MP + b * TS + i15) * 512 + h * 128 + mp * 64 + 32 * s2 + 8 * kq);
                const f32x4 a = {bflo(w.x) * C2, bfhi(w.x) * C2, bflo(w.y) * C2, bfhi(w.y) * C2}, bq = {bflo(w.z) * C2, bfhi(w.z) * C2, bflo(w.w) * C2, bfhi(w.w) * C2};
                qf[mp][s2] = __builtin_bit_cast(bf16x8, pack8(a, bq));
            }
        float mx[2] = {-1e30f, -1e30f}, ls[2] = {0.f, 0.f};
        f32x4 o[2][8];
#pragma unroll
        for (int mp = 0; mp < 2; ++mp)
#pragma unroll
            for (int db = 0; db < 8; ++db) o[mp][db] = (f32x4){0.f, 0.f, 0.f, 0.f};
        const int key0 = half * 2048 + wave * 256;
        const int ngrp = (half == 1 && wave == 7) ? 9 : 8;
        const float* Kn = COUT + O_SDK + ((size_t)e * MS + b * TS) * 512 + h * 128;
        const float* Vn = COUT + O_SDV + ((size_t)e * MS + b * TS) * 512 + h * 128;
        for (int g = 0; g < ngrp; ++g) {
            const bool newk = g == 8;
            const float* kb = (newk ? Kn : Kc + (size_t)(key0 + g * 32) * 512) + (size_t)i15 * 512 + 8 * kq;
            const float* vb = (newk ? Vn : Vc + (size_t)(key0 + g * 32) * 512) + (size_t)(4 * kq) * 512 + i15;
            f32x4 sc[2][2];
            float vr[4][8], vr2[4][8];
            {
                f32x4 kr[2][2][2][2];
#pragma unroll
                for (int mp = 0; mp < 2; ++mp)
#pragma unroll
                    for (int bl = 0; bl < 2; ++bl)
#pragma unroll
                        for (int s2 = 0; s2 < 2; ++s2) { const float* p = kb + (size_t)bl * 16 * 512 + mp * 64 + 32 * s2; kr[mp][bl][s2][0] = *GPTR(const f32x4, p); kr[mp][bl][s2][1] = *GPTR(const f32x4, p + 4); }
#pragma unroll
                for (int db = 0; db < 4; ++db)
#pragma unroll
                    for (int j = 0; j < 8; ++j) vr[db][j] = *GPTR(const float, vb + (size_t)((j < 4 ? 0 : 16) + (j & 3)) * 512 + db * 16);
#pragma unroll
                for (int db = 0; db < 4; ++db)
#pragma unroll
                    for (int j = 0; j < 8; ++j) vr2[db][j] = *GPTR(const float, vb + (size_t)((j < 4 ? 0 : 16) + (j & 3)) * 512 + (db + 4) * 16);
#pragma unroll
                for (int mp = 0; mp < 2; ++mp)
#pragma unroll
                    for (int bl = 0; bl < 2; ++bl) {
                        f32x4 a = {0.f, 0.f, 0.f, 0.f};
#pragma unroll
                        for (int s2 = 0; s2 < 2; ++s2) a = __builtin_amdgcn_mfma_f32_16x16x32_bf16(__builtin_bit_cast(bf16x8, pack8(kr[mp][bl][s2][0], kr[mp][bl][s2][1])), qf[mp][s2], a, 0, 0, 0);
                        sc[mp][bl] = a;
                    }
            }
            if (newk) { sc[0][1] = (f32x4){-1e30f, -1e30f, -1e30f, -1e30f}; sc[1][1] = sc[0][1]; }
            bf16x8 pf[2];
#pragma unroll
            for (int mp = 0; mp < 2; ++mp) {
                float tm = fmaxf(fmaxf(fmaxf(sc[mp][0][0], sc[mp][0][1]), fmaxf(sc[mp][0][2], sc[mp][0][3])), fmaxf(fmaxf(sc[mp][1][0], sc[mp][1][1]), fmaxf(sc[mp][1][2], sc[mp][1][3])));
                tm = fmaxf(tm, __shfl_xor(tm, 16, 64)); tm = fmaxf(tm, __shfl_xor(tm, 32, 64));
                const float mn = fmaxf(mx[mp], tm), al = __builtin_amdgcn_exp2f(mx[mp] - mn);
                f32x4 p0, p1;
#pragma unroll
                for (int r = 0; r < 4; ++r) { p0[r] = __builtin_amdgcn_exp2f(sc[mp][0][r] - mn); p1[r] = __builtin_amdgcn_exp2f(sc[mp][1][r] - mn); }
                ls[mp] = ls[mp] * al + ((p0[0] + p0[1]) + (p0[2] + p0[3])) + ((p1[0] + p1[1]) + (p1[2] + p1[3]));
                mx[mp] = mn;
                pf[mp] = __builtin_bit_cast(bf16x8, pack8(p0, p1));
#pragma unroll
                for (int db = 0; db < 8; ++db) o[mp][db] *= al;
            }
#pragma unroll
            for (int db = 0; db < 4; ++db) {
                const f32x4 a = {vr[db][0], vr[db][1], vr[db][2], vr[db][3]}, bq = {vr[db][4], vr[db][5], vr[db][6], vr[db][7]}; const bf16x8 vf = __builtin_bit_cast(bf16x8, pack8(a, bq));
                o[0][db] = __builtin_amdgcn_mfma_f32_16x16x32_bf16(vf, pf[0], o[0][db], 0, 0, 0);
                o[1][db] = __builtin_amdgcn_mfma_f32_16x16x32_bf16(vf, pf[1], o[1][db], 0, 0, 0);
            }
#pragma unroll
            for (int db = 0; db < 4; ++db) {
                const f32x4 a = {vr2[db][0], vr2[db][1], vr2[db][2], vr2[db][3]}, bq = {vr2[db][4], vr2[db][5], vr2[db][6], vr2[db][7]}; const bf16x8 vf = __builtin_bit_cast(bf16x8, pack8(a, bq));
                o[0][db + 4] = __builtin_amdgcn_mfma_f32_16x16x32_bf16(vf, pf[0], o[0][db + 4], 0, 0, 0);
                o[1][db + 4] = __builtin_amdgcn_mfma_f32_16x16x32_bf16(vf, pf[1], o[1][db + 4], 0, 0, 0);
            }
        }
#pragma unroll
        for (int mp = 0; mp < 2; ++mp) {
            float lt = ls[mp]; lt += __shfl_xor(lt, 16, 64); lt += __shfl_xor(lt, 32, 64);
            __syncthreads();
            LAS float* wq = L + (wave * 16 + i15) * 132;
#pragma unroll
            for (int db = 0; db < 8; ++db) *(LAS f32x4*)(wq + db * 16 + 4 * kq) = o[mp][db];
            if (kq == 0) { wq[128] = mx[mp]; wq[129] = lt; }
            __syncthreads();
            {
                const int q = tid >> 5, d4 = (tid & 31) * 4;
                float M_ = -1e30f;
#pragma unroll
                for (int w = 0; w < 8; ++w) M_ = fmaxf(M_, L[(w * 16 + q) * 132 + 128]);
                float Ls = 0.f; f32x4 acc = {0.f, 0.f, 0.f, 0.f};
#pragma unroll
                for (int w = 0; w < 8; ++w) { const float f = __builtin_amdgcn_exp2f(L[(w * 16 + q) * 132 + 128] - M_); Ls += L[(w * 16 + q) * 132 + 129] * f; acc += *(const LAS f32x4*)(L + (w * 16 + q) * 132 + d4) * f; }
                float* po = PART + ((size_t)((bh * 2 + half) * 2 + mp) * 16 + q) * 132;
                *GPTR(f32x4, po + d4) = acc;
                if ((tid & 31) == 0) { po[128] = M_; po[129] = Ls; }
            }
        }
        __syncthreads();
    }
}
DEVI void ph_diff_combine_sample(const Ctx& c, int e, int bid, int nb) {
    const int TIDX = tid_opaque();
    const float* PART = (const float*)(CWS + B_DPART); bf16_t* CAT = (bf16_t*)(CWS + B_CAT);
    const int wave = TIDX >> 6, lane = TIDX & 63;
    const float lam = lam_of(c, e), li = lam_init_of(2 * e);
    const float* gp = CIN(I_SUBG) + e * 128;
    const float g0 = gp[2 * lane], g1 = gp[2 * lane + 1];
    for (int it = bid * 8 + wave; it < 128 * 16; it += nb * 8) {
        const int bh = it >> 4, q = it & 15, b = bh >> 2, h = bh & 3;
        float a0 = 0.f, a1 = 0.f;
#pragma unroll
        for (int mp = 0; mp < 2; ++mp) {
            const float* p0 = PART + ((size_t)((bh * 2 + 0) * 2 + mp) * 16 + q) * 132; const float* p1 = PART + ((size_t)((bh * 2 + 1) * 2 + mp) * 16 + q) * 132;
            const float m0 = p0[128], m1 = p1[128], mm = fmaxf(m0, m1), f0 = __builtin_amdgcn_exp2f(m0 - mm), f1 = __builtin_amdgcn_exp2f(m1 - mm);
            const float inv = 1.f / (p0[129] * f0 + p1[129] * f1);
            const float x0 = (p0[2 * lane] * f0 + p1[2 * lane] * f1) * inv, x1 = (p0[2 * lane + 1] * f0 + p1[2 * lane + 1] * f1) * inv;
            if (mp == 0) { a0 = x0; a1 = x1; } else { a0 -= lam * x0; a1 -= lam * x1; }
        }
        const float ss = wave_sum(a0 * a0 + a1 * a1);
        const float sc = rsqrtf(ss * (1.f / 128.f) + NORM_EPS) * (1.f - li);
        *(unsigned*)(CAT + (size_t)(MP + b * TS + q) * D + 512 + h * 128 + 2 * lane) = cvt_pk_bf16(a0 * sc * g0, a1 * sc * g1);
    }
}
DEVI void ph_shiftmix(const Ctx& c, int l, int bid, int nb) {
    const int TIDX = tid_opaque();
    const int o = l >> 1;
    const bf16_t* X = (const bf16_t*)(CWS + B_XB); const float* rowss = (const float*)(CWS + B_ROWP) + (size_t)(3 * l) * ROWP_N; bf16_t* XM = (bf16_t*)(CWS + B_XM);
    const float* mu = CIN(I_MU) + (size_t)o * 6 * D; const float* gn = CIN(I_NMIX) + l * D;
    const unsigned total = (unsigned)M * 128u;
    for (unsigned idx = (unsigned)bid * NT + TIDX; idx < total; idx += (unsigned)nb * NT) {
        const int row = (int)(idx >> 7), col = (int)(idx & 127) * 8;
        const bool prompt = row < MP;
        const int b = prompt ? row / TP : (row - MP) / TS, t = prompt ? row % TP : (row - MP) % TS;
        const f32x4 g0 = *GPTR(const f32x4, gn + col), g1 = *GPTR(const f32x4, gn + col + 4);
        const float s = pg8::rs_of(rowss, row);
        const u32x4 xw = *GPTR(const u32x4, X + (size_t)row * D + col);
        const f32x4 h0 = (f32x4){bflo(xw.x), bfhi(xw.x), bflo(xw.y), bfhi(xw.y)} * s * g0, h1 = (f32x4){bflo(xw.z), bfhi(xw.z), bflo(xw.w), bfhi(xw.w)} * s * g1;
        f32x4 p0 = {0.f, 0.f, 0.f, 0.f}, p1 = p0;
        if (t > 0) { const float s1 = pg8::rs_of(rowss, row - 1); const u32x4 pw = *GPTR(const u32x4, X + (size_t)(row - 1) * D + col);
            p0 = (f32x4){bflo(pw.x), bfhi(pw.x), bflo(pw.y), bfhi(pw.y)} * s1 * g0; p1 = (f32x4){bflo(pw.z), bfhi(pw.z), bflo(pw.w), bfhi(pw.w)} * s1 * g1; }
        else if (!prompt) { const float* sp = CIN(I_SSHIFT) + ((size_t)o * NBS + b) * D + col; p0 = *GPTR(const f32x4, sp); p1 = *GPTR(const f32x4, sp + 4); }
        const f32x4 d0 = p0 - h0, d1 = p1 - h1;
#pragma unroll
        for (int i = 0; i < 6; ++i) {
            const f32x4 m0 = *GPTR(const f32x4, mu + i * D + col), m1 = *GPTR(const f32x4, mu + i * D + col + 4);
            *GPTR(u32x4, XM + (size_t)i * M * D + (size_t)row * D + col) = pack8(h0 + d0 * m0, h1 + d1 * m1);
        }
        if (prompt) { if (t == TP - 1) { float* op = COUT + O_PSHIFT + ((size_t)o * NBP + b) * D + col; *GPTR(f32x4, op) = h0; *GPTR(f32x4, op + 4) = h1; } }
        else { if (t == TS - 1) { float* op = COUT + O_SSHIFT + ((size_t)o * NBS + b) * D + col; *GPTR(f32x4, op) = h0; *GPTR(f32x4, op + 4) = h1; } }
    }
}
DEVI float sum16(float v) { v += __shfl_xor(v, 1, 64); v += __shfl_xor(v, 2, 64); v += __shfl_xor(v, 4, 64); v += __shfl_xor(v, 8, 64); return v; }
DEVI void ph_rw_prep(const Ctx& c, int o, int bid, int nb) {
    const int TIDX = tid_opaque();
    bf16_t* K = (bf16_t*)(CWS + B_K); bf16_t* V = (bf16_t*)(CWS + B_V); const bf16_t* W = (const bf16_t*)(CWS + B_W); const bf16_t* A = (const bf16_t*)(CWS + B_A); bf16_t* VF = (bf16_t*)(CWS + B_VF); const bf16_t* VG = (const bf16_t*)(CWS + B_VG);
    float* SMP = (float*)(CWS + B_SMP);
    const int wave = TIDX >> 6, lane = TIDX & 63;
    const float* w0p = CIN(I_W0) + o * D; const float* a0p = CIN(I_A0) + o * D; const float* v0p = CIN(I_V0) + (o > 0 ? o - 1 : 0) * D; const float* kkp = CIN(I_KK) + o * D; const float* kap = CIN(I_KA) + o * D;
    const int items = MS * 4;
    for (int it = bid * 8 + wave; it < items; it += nb * 8) {
        const int row = MP + (it >> 2), col = (it & 3) * 256 + lane * 4; const size_t base = (size_t)row * D + col, sb = (size_t)(it >> 2) * D + col;
        const f32x4 wl = ld4bf(W + base), al = ld4bf(A + base), kl = ld4bf(K + base); f32x4 vl = ld4bf(V + base);
        const f32x4 w0 = *GPTR(const f32x4, w0p + col), a0 = *GPTR(const f32x4, a0p + col), kk0 = *GPTR(const f32x4, kkp + col), ka0 = *GPTR(const f32x4, kap + col);
        f32x4 lw, av, kk, k2;
        if (o > 0) {
            const f32x4 vf = ld4bf(VF + base), vg = ld4bf(VG + base), v0 = *GPTR(const f32x4, v0p + col);
#pragma unroll
            for (int i = 0; i < 4; ++i) vl[i] = vl[i] + (vf[i] - vl[i]) * sigmoidf_(v0[i] + vg[i]);
        } else st4bf(VF + base, vl);
        float n2 = 0.f;
#pragma unroll
        for (int i = 0; i < 4; ++i) {
            const float x = -(w0[i] + wl[i]); const float sp = softplusf_(x);
            lw[i] = -__expf(-sp - 0.5f);
            av[i] = sigmoidf_(a0[i] + al[i]);
            kk[i] = kl[i] * kk0[i]; n2 += kk[i] * kk[i];
            k2[i] = kl[i] * (1.f + (av[i] - 1.f) * ka0[i]);
        }
        const float inv = 1.f / fmaxf(sqrtf(sum16(n2)), 1e-12f);
        kk *= inv;
        *GPTR(f32x4, SMP + 0 * SMPN + sb) = lw; *GPTR(f32x4, SMP + 1 * SMPN + sb) = av; *GPTR(f32x4, SMP + 2 * SMPN + sb) = kk; *GPTR(f32x4, SMP + 3 * SMPN + sb) = k2; *GPTR(f32x4, SMP + 4 * SMPN + sb) = vl;
        st4bf(K + base, k2); st4bf(V + base, vl);
    }
}
DEVI void ph_rw_scan(const Ctx& c, int o, int bid, int nb, LAS float* L) {
    const int TIDX = tid_opaque();
    const bf16_t* R = (const bf16_t*)(CWS + B_R); const float* SMP = (const float*)(CWS + B_SMP); bf16_t* Y = (bf16_t*)(CWS + B_Y);
    const float* W = SMP; const float* A = SMP + SMPN; const float* KKb = SMP + 2 * SMPN; const float* K = SMP + 3 * SMPN; const float* V = SMP + 4 * SMPN;
    const int wave = __builtin_amdgcn_readfirstlane(TIDX >> 6), lane = TIDX & 63, grp = wave >> 2, w4 = wave & 3, k0 = 16 * w4;
    LAS float* red = L + grp * 256;
    LAS float* yred = L + 1024 + grp * 256;
#define RL(x, k_) __builtin_bit_cast(float, __builtin_amdgcn_readlane(__builtin_bit_cast(int, (x)), (k_)))
    for (int it0 = bid; it0 < NBS * 16; it0 += 2 * nb) {
        const int it = it0 + grp * nb; const bool act = it < NBS * 16; const int itc = act ? it : it0;
        const int b = itc >> 4, h = itc & 15, row0 = MP + b * TS;
        float S[16];
        {
            const float* sp = CIN(I_SWKV) + (((size_t)(o * NBS + b) * 16 + h) * 64 + lane) * 64 + k0;
#pragma unroll
            for (int k = 0; k < 16; k += 4) { const f32x4 v = *GPTR(const f32x4, sp + k); S[k] = v[0]; S[k + 1] = v[1]; S[k + 2] = v[2]; S[k + 3] = v[3]; }
        }
        const size_t base0 = (size_t)row0 * D + h * 64 + lane, sbase0 = (size_t)(b * TS) * D + h * 64 + lane;
        float pr[TS], pd[TS], pk[TS], pkk[TS], pab[TS], pv[TS];
#pragma unroll
        for (int t = 0; t < TS; ++t) { const size_t bb = base0 + (size_t)t * D, sb = sbase0 + (size_t)t * D;
            pr[t] = bf2f(R[bb]); pd[t] = W[sb]; pk[t] = K[sb]; pkk[t] = KKb[sb]; pab[t] = A[sb]; pv[t] = V[sb]; }
#pragma unroll
        for (int t = 0; t < TS; ++t) { pd[t] = __expf(pd[t]); pab[t] = pkk[t] * pab[t]; }
        {
            float s0 = 0.f, s1 = 0.f;
#pragma unroll
            for (int k = 0; k < 16; k += 2) { s0 = fmaf(S[k], RL(pkk[0], k0 + k), s0); s1 = fmaf(S[k + 1], RL(pkk[0], k0 + k + 1), s1); }
            red[w4 * 64 + lane] = s0 + s1;
        }
        __syncthreads();
#pragma unroll
        for (int t = 0; t < TS; ++t) {
            const int slot = (t & 1) * 512;
            const float sa = -((red[slot + lane] + red[slot + 64 + lane]) + (red[slot + 128 + lane] + red[slot + 192 + lane]));
            const float vj = pv[t];
            float y0 = 0.f, y1 = 0.f;
#pragma unroll
            for (int k = 0; k < 16; k += 2) {
                S[k] = fmaf(S[k], RL(pd[t], k0 + k), fmaf(sa, RL(pab[t], k0 + k), vj * RL(pk[t], k0 + k))); y0 = fmaf(S[k], RL(pr[t], k0 + k), y0);
                S[k + 1] = fmaf(S[k + 1], RL(pd[t], k0 + k + 1), fmaf(sa, RL(pab[t], k0 + k + 1), vj * RL(pk[t], k0 + k + 1))); y1 = fmaf(S[k + 1], RL(pr[t], k0 + k + 1), y1);
            }
            yred[slot + w4 * 64 + lane] = y0 + y1;
            if (t + 1 < TS) {
                float s0 = 0.f, s1 = 0.f;
#pragma unroll
                for (int k = 0; k < 16; k += 2) { s0 = fmaf(S[k], RL(pkk[t + 1 < TS ? t + 1 : t], k0 + k), s0); s1 = fmaf(S[k + 1], RL(pkk[t + 1 < TS ? t + 1 : t], k0 + k + 1), s1); }
                red[(512 - slot) + w4 * 64 + lane] = s0 + s1;
            }
            __syncthreads();
            if (w4 == 0 && act) Y[base0 + (size_t)t * D] = (bf16_t)(cvt_pk_bf16((yred[slot + lane] + yred[slot + 64 + lane]) + (yred[slot + 128 + lane] + yred[slot + 192 + lane]), 0.f) & 0xffffu);
        }
        if (act) {
            float* op = COUT + O_SWKV + (((size_t)(o * NBS + b) * 16 + h) * 64 + lane) * 64 + k0;
#pragma unroll
            for (int k = 0; k < 16; k += 4) *GPTR(f32x4, op + k) = (f32x4){S[k], S[k + 1], S[k + 2], S[k + 3]};
        }
        __syncthreads();
    }
#undef RL
}
DEVI void ph_rw_post(const Ctx& c, int o, int bid, int nb) {
    const int TIDX = tid_opaque();
    const bf16_t* R = (const bf16_t*)(CWS + B_R); const bf16_t* K = (const bf16_t*)(CWS + B_K); const bf16_t* V = (const bf16_t*)(CWS + B_V); const bf16_t* G = (const bf16_t*)(CWS + B_G); const bf16_t* Y = (const bf16_t*)(CWS + B_Y); bf16_t* YG = (bf16_t*)(CWS + B_YG);
    const int wave = TIDX >> 6, lane = TIDX & 63;
    const float* lgp = CIN(I_LNG) + o * D; const float* lbp = CIN(I_LNB) + o * D; const float* rkp = CIN(I_RK) + o * D;
    const int items = M * 4;
    for (int it = bid * 8 + wave; it < items; it += nb * 8) {
        const int row = it >> 2, col = (it & 3) * 256 + lane * 4; const size_t base = (size_t)row * D + col;
        f32x4 y = ld4bf(Y + base); const f32x4 r = ld4bf(R + base), k = ld4bf(K + base), v = ld4bf(V + base), g = ld4bf(G + base);
        if (row < MP) y += ld4bf((const bf16_t*)(CWS + B_YL) + base);
        const f32x4 lg = *GPTR(const f32x4, lgp + col), lb = *GPTR(const f32x4, lbp + col), rk = *GPTR(const f32x4, rkp + col);
        const float mean = sum16((y[0] + y[1]) + (y[2] + y[3])) * (1.f / 64.f);
        const f32x4 dl = y - mean;
        const float var = sum16((dl[0] * dl[0] + dl[1] * dl[1]) + (dl[2] * dl[2] + dl[3] * dl[3])) * (1.f / 64.f);
        const float rstd = rsqrtf(var + RW_LN_EPS);
        const float bon = sum16((r[0] * k[0] * rk[0] + r[1] * k[1] * rk[1]) + (r[2] * k[2] * rk[2] + r[3] * k[3] * rk[3]));
        f32x4 ov;
#pragma unroll
        for (int i = 0; i < 4; ++i) ov[i] = (dl[i] * rstd * lg[i] + lb[i] + bon * v[i]) * g[i];
        u32x2 w; w.x = cvt_pk_bf16(ov[0], ov[1]); w.y = cvt_pk_bf16(ov[2], ov[3]);
        *GPTR(u32x2, YG + base) = w;
    }
}
DEVI void ph_softmax256(const Ctx& c, int bid, int nb) {
    const int TIDX = tid_opaque();
    const float* S = (const float*)(CWS + B_S); bf16_t* P = (bf16_t*)(CWS + B_P);
    const int wave = TIDX >> 6, lane = TIDX & 63;
    const int items = MP * 4;
    for (int it = bid * 8 + wave; it < items; it += nb * 8) {
        float4 v = *((const float4*)(S + (size_t)it * 256) + lane); v.x *= 0.0625f; v.y *= 0.0625f; v.z *= 0.0625f; v.w *= 0.0625f;
        float mx = fmaxf(fmaxf(v.x, v.y), fmaxf(v.z, v.w));
#pragma unroll
        for (int o = 32; o > 0; o >>= 1) mx = fmaxf(mx, __shfl_xor(mx, o, 64));
        v.x = __expf(v.x - mx); v.y = __expf(v.y - mx); v.z = __expf(v.z - mx); v.w = __expf(v.w - mx);
        const float inv = 1.f / wave_sum(v.x + v.y + v.z + v.w);
        u32x2 w; w.x = cvt_pk_bf16(v.x * inv, v.y * inv); w.y = cvt_pk_bf16(v.z * inv, v.w * inv);
        *((u32x2*)(P + (size_t)it * 256) + lane) = w;
    }
}
DEVI void ph_xattn_sample(const Ctx& c, int l, LAS float* L, int bid, int nb) {
    const int tid = tid_opaque(), wave = __builtin_amdgcn_readfirstlane(tid >> 6), lane = tid & 63, i15 = lane & 15, kq = lane >> 4;
    const bf16_t* Q = (const bf16_t*)(CWS + B_Q); bf16_t* O = (bf16_t*)(CWS + B_O);
    LAS float* rmax = L; LAS float* rsum = L + 128;
    LAS bf16_t* Pl = (LAS bf16_t*)(L + 256);
    constexpr int PP = 264;
    const float C2 = 0.0625f * 1.4426950408889634f;
    for (int item = bid; item < NBS * 4; item += nb) {
        const int b = item >> 2, h = item & 3;
        const float* Kc = CIN(I_CMK) + ((size_t)(l * NBS + b) * NMEM) * D + h * 256; const float* Vc = CIN(I_CMV) + ((size_t)(l * NBS + b) * NMEM) * D + h * 256;
        bf16x8 qf[8];
#pragma unroll
        for (int s2 = 0; s2 < 8; ++s2) {
            const u32x4 w = *GPTR(const u32x4, Q + (size_t)(MP + b * TS + i15) * D + h * 256 + 32 * s2 + 8 * kq);
            const f32x4 a = {bflo(w.x) * C2, bfhi(w.x) * C2, bflo(w.y) * C2, bfhi(w.y) * C2}, bq = {bflo(w.z) * C2, bfhi(w.z) * C2, bflo(w.w) * C2, bfhi(w.w) * C2};
            qf[s2] = __builtin_bit_cast(bf16x8, pack8(a, bq));
        }
        f32x4 sc[2];
#pragma unroll
        for (int bl = 0; bl < 2; ++bl) {
            const float* kb = Kc + (size_t)(32 * wave + 16 * bl + i15) * D + 8 * kq;
            f32x4 kr[8][2];
#pragma unroll
            for (int s2 = 0; s2 < 8; ++s2) { kr[s2][0] = *GPTR(const f32x4, kb + 32 * s2); kr[s2][1] = *GPTR(const f32x4, kb + 32 * s2 + 4); }
            f32x4 a = {0.f, 0.f, 0.f, 0.f};
#pragma unroll
            for (int s2 = 0; s2 < 8; ++s2) a = __builtin_amdgcn_mfma_f32_16x16x32_bf16(__builtin_bit_cast(bf16x8, pack8(kr[s2][0], kr[s2][1])), qf[s2], a, 0, 0, 0);
            sc[bl] = a;
        }
        float vv[8][2][8];
#pragma unroll
        for (int g = 0; g < 8; ++g)
#pragma unroll
            for (int db = 0; db < 2; ++db) {
                const float* vb = Vc + (size_t)(32 * g + 8 * kq) * D + (2 * wave + db) * 16 + i15;
#pragma unroll
                for (int j = 0; j < 8; ++j) vv[g][db][j] = *GPTR(const float, vb + (size_t)j * D);
            }
        float tm = fmaxf(fmaxf(fmaxf(sc[0][0], sc[0][1]), fmaxf(sc[0][2], sc[0][3])), fmaxf(fmaxf(sc[1][0], sc[1][1]), fmaxf(sc[1][2], sc[1][3])));
        tm = fmaxf(tm, __shfl_xor(tm, 16, 64)); tm = fmaxf(tm, __shfl_xor(tm, 32, 64));
        __syncthreads();
        if (kq == 0) rmax[wave * 16 + i15] = tm;
        __syncthreads();
        float M_ = rmax[i15];
#pragma unroll
        for (int w = 1; w < 8; ++w) M_ = fmaxf(M_, rmax[w * 16 + i15]);
        f32x4 p0, p1;
#pragma unroll
        for (int r = 0; r < 4; ++r) { p0[r] = __builtin_amdgcn_exp2f(sc[0][r] - M_); p1[r] = __builtin_amdgcn_exp2f(sc[1][r] - M_); }
        float lt = ((p0[0] + p0[1]) + (p0[2] + p0[3])) + ((p1[0] + p1[1]) + (p1[2] + p1[3]));
        lt += __shfl_xor(lt, 16, 64); lt += __shfl_xor(lt, 32, 64);
        if (kq == 0) rsum[wave * 16 + i15] = lt;
        { u32x2 w0; w0.x = cvt_pk_bf16(p0[0], p0[1]); w0.y = cvt_pk_bf16(p0[2], p0[3]); *(LAS u32x2*)(Pl + i15 * PP + 32 * wave + 4 * kq) = w0;
          u32x2 w1; w1.x = cvt_pk_bf16(p1[0], p1[1]); w1.y = cvt_pk_bf16(p1[2], p1[3]); *(LAS u32x2*)(Pl + i15 * PP + 32 * wave + 16 + 4 * kq) = w1; }
        __syncthreads();
        float Ls = rsum[i15];
#pragma unroll
        for (int w = 1; w < 8; ++w) Ls += rsum[w * 16 + i15];
        const float inv = 1.f / Ls;
        f32x4 o[2] = {{0.f, 0.f, 0.f, 0.f}, {0.f, 0.f, 0.f, 0.f}};
#pragma unroll
        for (int g = 0; g < 8; ++g) {
            const bf16x8 pf = __builtin_bit_cast(bf16x8, *(const LAS u32x4*)(Pl + i15 * PP + 32 * g + 8 * kq));
#pragma unroll
            for (int db = 0; db < 2; ++db) {
                f32x4 a, bq;
#pragma unroll
                for (int j = 0; j < 4; ++j) { a[j] = vv[g][db][j]; bq[j] = vv[g][db][j + 4]; }
                o[db] = __builtin_amdgcn_mfma_f32_16x16x32_bf16(__builtin_bit_cast(bf16x8, pack8(a, bq)), pf, o[db], 0, 0, 0);
            }
        }
#pragma unroll
        for (int db = 0; db < 2; ++db) {
            const f32x4 v = o[db] * inv; u32x2 w; w.x = cvt_pk_bf16(v[0], v[1]); w.y = cvt_pk_bf16(v[2], v[3]);
            *GPTR(u32x2, O + (size_t)(MP + b * TS + i15) * D + h * 256 + (2 * wave + db) * 16 + 4 * kq) = w;
        }
    }
}
DEVI void ph_final(const Ctx& c, int bid, int nb) {
    const int TIDX = tid_opaque();
    const bf16_t* X = (const bf16_t*)(CWS + B_XB); const float* rowss = (const float*)(CWS + B_ROWP) + (size_t)12 * ROWP_N; const float* g = CIN(I_NFIN);
    const int wave = TIDX >> 6, lane = TIDX & 63, step = nb * 8;
    f32x4 g4[4];
#pragma unroll
    for (int i = 0; i < 4; ++i) g4[i] = *GPTR(const f32x4, g + 4 * (lane + 64 * i));
    for (int r0 = bid * 8 + wave; r0 < M; r0 += 3 * step) {
        u32x2 xw[3][4]; float sc[3];
#pragma unroll
        for (int j = 0; j < 3; ++j) { const int r = r0 + j * step;
            if (r < M) { sc[j] = pg8::rs_of(rowss, r);
#pragma unroll
                for (int i = 0; i < 4; ++i) xw[j][i] = *GPTR(const u32x2, X + (size_t)r * D + 4 * (lane + 64 * i)); } }
#pragma unroll
        for (int j = 0; j < 3; ++j) { const int r = r0 + j * step;
            if (r < M) {
#pragma unroll
                for (int i = 0; i < 4; ++i) *GPTR(f32x4, COUT + O_YP + (size_t)r * D + 4 * (lane + 64 * i)) = cv4bf(xw[j][i]) * sc[j] * g4[i]; } }
    }
}


namespace rwk {
typedef float f32x16 __attribute__((ext_vector_type(16)));
constexpr int LP = 68, IMGF = 64 * LP;
enum { G_AT = 0, G_RT, G_BT, G_KT, G_VV, G_MAB, G_MAK, G_MRK, N_IMG };
DEVI int crow(int r, int hi) { return (r & 3) + 8 * (r >> 2) + 4 * hi; }
DEVI bf16x8 frag_row(const LAS float* img, int row, int s, int hi) {
    const LAS float* p = img + row * LP + 16 * s + 8 * hi;
    const f32x4 a = *(const LAS f32x4*)p, b = *(const LAS f32x4*)(p + 4);
    return __builtin_bit_cast(bf16x8, pack8(a, b));
}
DEVI bf16x8 frag_col(const LAS float* img, int col, int s, int hi, float scale) {
    const LAS float* p = img + (16 * s + 8 * hi) * LP + col;
    f32x4 a, b;
    a[0] = p[0]; a[1] = p[LP]; a[2] = p[2 * LP]; a[3] = p[3 * LP]; b[0] = p[4 * LP]; b[1] = p[5 * LP]; b[2] = p[6 * LP]; b[3] = p[7 * LP];
    a *= scale; b *= scale;
    return __builtin_bit_cast(bf16x8, pack8(a, b));
}
#define LDS_BARRIER() asm volatile("s_waitcnt lgkmcnt(0)\n\ts_barrier" ::: "memory")
#define RWK_MMA(acc, Afr, Bfr) acc = __builtin_amdgcn_mfma_f32_32x32x16_bf16((Afr), (Bfr), acc, 0, 0, 0)

DEVI void sub_solve32(const LAS float* Mb, LAS float* ib) {
    float x[32];
#pragma unroll
    for (int tt = 0; tt < 32; ++tt) x[tt] = ib[tt * LP];
#define SUB_LOAD(buf, t_, n_) do { _Pragma("unroll") for (int j4 = 0; j4 < (n_); ++j4) buf[j4] = *(const LAS f32x4*)(Mb + (t_) * LP + 4 * j4); } while (0)
#define SUB_ACC(buf, t_, n_) do { _Pragma("unroll") for (int j4 = 0; j4 < (n_); ++j4) { const int jb = 4 * j4; \
        if (jb + 0 < (t_)) s0 = fmaf(buf[j4][0], x[jb + 0], s0); if (jb + 1 < (t_)) s1 = fmaf(buf[j4][1], x[jb + 1], s1); \
        if (jb + 2 < (t_)) s2 = fmaf(buf[j4][2], x[jb + 2], s2); if (jb + 3 < (t_)) s3 = fmaf(buf[j4][3], x[jb + 3], s3); } } while (0)
    f32x4 pa[8], pb[8]; float s0 = 0.f, s1 = 0.f, s2 = 0.f, s3 = 0.f;
    SUB_LOAD(pa, 1, 1);
    SUB_LOAD(pb, 2, 1); s0 = x[1]; s1 = 0.f; s2 = 0.f; s3 = 0.f; SUB_ACC(pa, 1, 1); x[1] = (s0 + s1) + (s2 + s3);
    SUB_LOAD(pa, 3, 1); s0 = x[2]; s1 = 0.f; s2 = 0.f; s3 = 0.f; SUB_ACC(pb, 2, 1); x[2] = (s0 + s1) + (s2 + s3);
    SUB_LOAD(pb, 4, 1); s0 = x[3]; s1 = 0.f; s2 = 0.f; s3 = 0.f; SUB_ACC(pa, 3, 1); x[3] = (s0 + s1) + (s2 + s3);
    SUB_LOAD(pa, 5, 2); s0 = x[4]; s1 = 0.f; s2 = 0.f; s3 = 0.f; SUB_ACC(pb, 4, 1); x[4] = (s0 + s1) + (s2 + s3);
    SUB_LOAD(pb, 6, 2); s0 = x[5]; s1 = 0.f; s2 = 0.f; s3 = 0.f; SUB_ACC(pa, 5, 2); x[5] = (s0 + s1) + (s2 + s3);
    SUB_LOAD(pa, 7, 2); s0 = x[6]; s1 = 0.f; s2 = 0.f; s3 = 0.f; SUB_ACC(pb, 6, 2); x[6] = (s0 + s1) + (s2 + s3);
    SUB_LOAD(pb, 8, 2); s0 = x[7]; s1 = 0.f; s2 = 0.f; s3 = 0.f; SUB_ACC(pa, 7, 2); x[7] = (s0 + s1) + (s2 + s3);
    SUB_LOAD(pa, 9, 3); s0 = x[8]; s1 = 0.f; s2 = 0.f; s3 = 0.f; SUB_ACC(pb, 8, 2); x[8] = (s0 + s1) + (s2 + s3);
    SUB_LOAD(pb, 10, 3); s0 = x[9]; s1 = 0.f; s2 = 0.f; s3 = 0.f; SUB_ACC(pa, 9, 3); x[9] = (s0 + s1) + (s2 + s3);
    SUB_LOAD(pa, 11, 3); s0 = x[10]; s1 = 0.f; s2 = 0.f; s3 = 0.f; SUB_ACC(pb, 10, 3); x[10] = (s0 + s1) + (s2 + s3);
    SUB_LOAD(pb, 12, 3); s0 = x[11]; s1 = 0.f; s2 = 0.f; s3 = 0.f; SUB_ACC(pa, 11, 3); x[11] = (s0 + s1) + (s2 + s3);
    SUB_LOAD(pa, 13, 4); s0 = x[12]; s1 = 0.f; s2 = 0.f; s3 = 0.f; SUB_ACC(pb, 12, 3); x[12] = (s0 + s1) + (s2 + s3);
    SUB_LOAD(pb, 14, 4); s0 = x[13]; s1 = 0.f; s2 = 0.f; s3 = 0.f; SUB_ACC(pa, 13, 4); x[13] = (s0 + s1) + (s2 + s3);
    SUB_LOAD(pa, 15, 4); s0 = x[14]; s1 = 0.f; s2 = 0.f; s3 = 0.f; SUB_ACC(pb, 14, 4); x[14] = (s0 + s1) + (s2 + s3);
    SUB_LOAD(pb, 16, 4); s0 = x[15]; s1 = 0.f; s2 = 0.f; s3 = 0.f; SUB_ACC(pa, 15, 4); x[15] = (s0 + s1) + (s2 + s3);
    SUB_LOAD(pa, 17, 5); s0 = x[16]; s1 = 0.f; s2 = 0.f; s3 = 0.f; SUB_ACC(pb, 16, 4); x[16] = (s0 + s1) + (s2 + s3);
    SUB_LOAD(pb, 18, 5); s0 = x[17]; s1 = 0.f; s2 = 0.f; s3 = 0.f; SUB_ACC(pa, 17, 5); x[17] = (s0 + s1) + (s2 + s3);
    SUB_LOAD(pa, 19, 5); s0 = x[18]; s1 = 0.f; s2 = 0.f; s3 = 0.f; SUB_ACC(pb, 18, 5); x[18] = (s0 + s1) + (s2 + s3);
    SUB_LOAD(pb, 20, 5); s0 = x[19]; s1 = 0.f; s2 = 0.f; s3 = 0.f; SUB_ACC(pa, 19, 5); x[19] = (s0 + s1) + (s2 + s3);
    SUB_LOAD(pa, 21, 6); s0 = x[20]; s1 = 0.f; s2 = 0.f; s3 = 0.f; SUB_ACC(pb, 20, 5); x[20] = (s0 + s1) + (s2 + s3);
    SUB_LOAD(pb, 22, 6); s0 = x[21]; s1 = 0.f; s2 = 0.f; s3 = 0.f; SUB_ACC(pa, 21, 6); x[21] = (s0 + s1) + (s2 + s3);
    SUB_LOAD(pa, 23, 6); s0 = x[22]; s1 = 0.f; s2 = 0.f; s3 = 0.f; SUB_ACC(pb, 22, 6); x[22] = (s0 + s1) + (s2 + s3);
    SUB_LOAD(pb, 24, 6); s0 = x[23]; s1 = 0.f; s2 = 0.f; s3 = 0.f; SUB_ACC(pa, 23, 6); x[23] = (s0 + s1) + (s2 + s3);
    SUB_LOAD(pa, 25, 7); s0 = x[24]; s1 = 0.f; s2 = 0.f; s3 = 0.f; SUB_ACC(pb, 24, 6); x[24] = (s0 + s1) + (s2 + s3);
    SUB_LOAD(pb, 26, 7); s0 = x[25]; s1 = 0.f; s2 = 0.f; s3 = 0.f; SUB_ACC(pa, 25, 7); x[25] = (s0 + s1) + (s2 + s3);
    SUB_LOAD(pa, 27, 7); s0 = x[26]; s1 = 0.f; s2 = 0.f; s3 = 0.f; SUB_ACC(pb, 26, 7); x[26] = (s0 + s1) + (s2 + s3);
    SUB_LOAD(pb, 28, 7); s0 = x[27]; s1 = 0.f; s2 = 0.f; s3 = 0.f; SUB_ACC(pa, 27, 7); x[27] = (s0 + s1) + (s2 + s3);
    SUB_LOAD(pa, 29, 8); s0 = x[28]; s1 = 0.f; s2 = 0.f; s3 = 0.f; SUB_ACC(pb, 28, 7); x[28] = (s0 + s1) + (s2 + s3);
    SUB_LOAD(pb, 30, 8); s0 = x[29]; s1 = 0.f; s2 = 0.f; s3 = 0.f; SUB_ACC(pa, 29, 8); x[29] = (s0 + s1) + (s2 + s3);
    SUB_LOAD(pa, 31, 8); s0 = x[30]; s1 = 0.f; s2 = 0.f; s3 = 0.f; SUB_ACC(pb, 30, 8); x[30] = (s0 + s1) + (s2 + s3);
    s0 = x[31]; s1 = 0.f; s2 = 0.f; s3 = 0.f; SUB_ACC(pa, 31, 8); x[31] = (s0 + s1) + (s2 + s3);
#undef SUB_LOAD
#undef SUB_ACC
#pragma unroll
    for (int tt = 0; tt < 32; ++tt) ib[tt * LP] = x[tt];
}

DEVI void phaseA(const Ctx& c, int o, LAS float* L, int bid, int nb) {
    const int tid0 = tid_opaque();
    const bf16_t* Rg = (const bf16_t*)(CWS + B_R); const bf16_t* LWg = (const bf16_t*)(CWS + B_W); const bf16_t* Kg = (const bf16_t*)(CWS + B_K); const bf16_t* Vg = (const bf16_t*)(CWS + B_V);
    const bf16_t* Ag = (const bf16_t*)(CWS + B_A);
    float* TC = (float*)(CWS + B_TC); float* UC = (float*)(CWS + B_UC); float* GH = (float*)(CWS + B_GH); bf16_t* Yg = (bf16_t*)(CWS + B_YL);
    LAS float* AT = L + G_AT * IMGF; LAS float* RT = L + G_RT * IMGF; LAS float* BT = L + G_BT * IMGF; LAS float* KT = L + G_KT * IMGF; LAS float* VV = L + G_VV * IMGF;
    LAS float* MAB = L + G_MAB * IMGF; LAS float* MAK = L + G_MAK * IMGF; LAS float* MRK = L + G_MRK * IMGF; LAS float* GL = L + N_IMG * IMGF;
    (void)o;
    for (int chunk = bid; chunk < 4096; chunk += nb) {
        int tid = tid0; asm volatile("" : "+v"(tid));
        const int wave = __builtin_amdgcn_readfirstlane(tid >> 6), lane = tid & 63, l31 = lane & 31, hi = lane >> 5;
        const int bh = chunk >> 6, cc = chunk & 63, b = bh >> 4, h = bh & 15;
        const size_t g0 = ((size_t)(b * TP + cc * 64)) * D + h * 64;
        const int t = tid >> 3, k8 = (tid & 7) * 8;
        const size_t go = g0 + (size_t)t * D + k8;
        LDS_BARRIER();
        f32x4 r0, r1, kx0, kx1, v0, v1, q0, q1, a0, a1;
        {
            const int col = h * 64 + k8;
            const f32x4 wl0 = ld4bf(LWg + go), wl1 = ld4bf(LWg + go + 4), al0 = ld4bf(Ag + go), al1 = ld4bf(Ag + go + 4);
            kx0 = ld4bf(Kg + go); kx1 = ld4bf(Kg + go + 4); v0 = ld4bf(Vg + go); v1 = ld4bf(Vg + go + 4);
            r0 = ld4bf(Rg + go); r1 = ld4bf(Rg + go + 4);
            const float* w0p = CIN(I_W0) + o * D + col; const float* a0p = CIN(I_A0) + o * D + col; const float* kkp = CIN(I_KK) + o * D + col; const float* kap = CIN(I_KA) + o * D + col;
            const f32x4 pw0 = *GPTR(const f32x4, w0p), pw1 = *GPTR(const f32x4, w0p + 4), pa0 = *GPTR(const f32x4, a0p), pa1 = *GPTR(const f32x4, a0p + 4);
            const f32x4 pk0 = *GPTR(const f32x4, kkp), pk1 = *GPTR(const f32x4, kkp + 4), pc0 = *GPTR(const f32x4, kap), pc1 = *GPTR(const f32x4, kap + 4);
            if (o > 0) {
                const bf16_t* VFg = (const bf16_t*)(CWS + B_VF); const bf16_t* VGg = (const bf16_t*)(CWS + B_VG); const float* v0p = CIN(I_V0) + (o - 1) * D + col;
                const f32x4 vf0 = ld4bf(VFg + go), vf1 = ld4bf(VFg + go + 4), vg0 = ld4bf(VGg + go), vg1 = ld4bf(VGg + go + 4), pv0 = *GPTR(const f32x4, v0p), pv1 = *GPTR(const f32x4, v0p + 4);
#pragma unroll
                for (int i = 0; i < 4; ++i) { v0[i] = v0[i] + (vf0[i] - v0[i]) * sigmoidf_(pv0[i] + vg0[i]); v1[i] = v1[i] + (vf1[i] - v1[i]) * sigmoidf_(pv1[i] + vg1[i]); }
            } else { bf16_t* VFw = (bf16_t*)(CWS + B_VF); *GPTR(u32x4, VFw + go) = pack8(v0, v1); }
            f32x4 lw0, lw1; float n2 = 0.f;
#pragma unroll
            for (int i = 0; i < 4; ++i) {
                const float x0 = -(pw0[i] + wl0[i]), x1 = -(pw1[i] + wl1[i]);
                const float sp0 = softplusf_(x0), sp1 = softplusf_(x1);
                lw0[i] = -__expf(-sp0 - 0.5f); lw1[i] = -__expf(-sp1 - 0.5f);
                a0[i] = sigmoidf_(pa0[i] + al0[i]); a1[i] = sigmoidf_(pa1[i] + al1[i]);
                q0[i] = kx0[i] * pk0[i]; q1[i] = kx1[i] * pk1[i]; n2 += q0[i] * q0[i] + q1[i] * q1[i];
                kx0[i] = kx0[i] * (1.f + (a0[i] - 1.f) * pc0[i]); kx1[i] = kx1[i] * (1.f + (a1[i] - 1.f) * pc1[i]);
            }
            n2 += __shfl_xor(n2, 1, 64); n2 += __shfl_xor(n2, 2, 64); n2 += __shfl_xor(n2, 4, 64);
            const float inv = fminf(__builtin_amdgcn_rsqf(n2), 1e12f);
            q0 *= inv; q1 *= inv;
            *(LAS f32x4*)(MAB + t * LP + k8) = lw0; *(LAS f32x4*)(MAB + t * LP + k8 + 4) = lw1;
            bf16_t* Kw = (bf16_t*)(CWS + B_K); bf16_t* Vw = (bf16_t*)(CWS + B_V);
            *GPTR(u32x4, Kw + go) = pack8(kx0, kx1); *GPTR(u32x4, Vw + go) = pack8(v0, v1);
        }
        LDS_BARRIER();
        if (tid < 64) { float run = 0.f;
#pragma unroll
            for (int hb = 0; hb < 2; ++hb) { float cv[32];
#pragma unroll
                for (int tt = 0; tt < 32; ++tt) cv[tt] = MAB[(hb * 32 + tt) * LP + tid];
#pragma unroll
                for (int tt = 0; tt < 32; ++tt) { run += cv[tt]; MAB[(hb * 32 + tt) * LP + tid] = run; } } }
        LDS_BARRIER();
        {
            const f32x4 c0 = *(const LAS f32x4*)(MAB + t * LP + k8), c1 = *(const LAS f32x4*)(MAB + t * LP + k8 + 4);
            f32x4 p0 = (f32x4){0.f, 0.f, 0.f, 0.f}, p1 = p0;
            if (t > 0) { p0 = *(const LAS f32x4*)(MAB + (t - 1) * LP + k8); p1 = *(const LAS f32x4*)(MAB + (t - 1) * LP + k8 + 4); }
            f32x4 at0, at1, rt0, rt1, bt0, bt1, kt0, kt1;
#pragma unroll
            for (int i = 0; i < 4; ++i) {
                const float e0 = __expf(c0[i]), e1 = __expf(c1[i]), i0 = __expf(-c0[i]), i1 = __expf(-c1[i]);
                at0[i] = -q0[i] * __expf(p0[i]); at1[i] = -q1[i] * __expf(p1[i]);
                rt0[i] = r0[i] * e0; rt1[i] = r1[i] * e1;
                bt0[i] = q0[i] * a0[i] * i0; bt1[i] = q1[i] * a1[i] * i1;
                kt0[i] = kx0[i] * i0; kt1[i] = kx1[i] * i1;
                if (t == 63) { GL[k8 + i] = e0; GL[k8 + 4 + i] = e1; }
            }
            *(LAS f32x4*)(AT + t * LP + k8) = at0; *(LAS f32x4*)(AT + t * LP + k8 + 4) = at1;
            *(LAS f32x4*)(RT + t * LP + k8) = rt0; *(LAS f32x4*)(RT + t * LP + k8 + 4) = rt1;
            *(LAS f32x4*)(BT + t * LP + k8) = bt0; *(LAS f32x4*)(BT + t * LP + k8 + 4) = bt1;
            *(LAS f32x4*)(KT + t * LP + k8) = kt0; *(LAS f32x4*)(KT + t * LP + k8 + 4) = kt1;
            *(LAS f32x4*)(VV + t * LP + k8) = v0; *(LAS f32x4*)(VV + t * LP + k8 + 4) = v1;
        }
        LDS_BARRIER();
#define A2_TILE(q_) do { const int prod = (q_) >> 2, ti = ((q_) >> 1) & 1, tj = (q_) & 1; \
            const LAS float* Ai = prod == 2 ? RT : AT; const LAS float* Bi = prod == 0 ? BT : KT; LAS float* Mo = prod == 0 ? MAB : (prod == 1 ? MAK : MRK); \
            f32x16 acc = {}; \
            _Pragma("unroll") for (int s2 = 0; s2 < 4; ++s2) RWK_MMA(acc, frag_row(Ai, ti * 32 + l31, s2, hi), frag_row(Bi, tj * 32 + l31, s2, hi)); \
            const int jj = tj * 32 + l31; \
            _Pragma("unroll") for (int r = 0; r < 16; ++r) { const int tt = ti * 32 + crow(r, hi); const bool keep = prod == 2 ? (jj <= tt) : (jj < tt); Mo[tt * LP + jj] = keep ? acc[r] : 0.f; } } while (0)
        A2_TILE(wave);
        LDS_BARRIER();
        {
            f32x16 pacc = {};
            const int ti = (wave >> 1) & 1, tj = wave & 1;
            if (wave < 4) A2_TILE(wave + 8);
            else {
#pragma unroll
                for (int s2 = 0; s2 < 4; ++s2) RWK_MMA(pacc, frag_row(MAK, ti * 32 + l31, s2, hi), frag_col(VV, tj * 32 + l31, s2, hi, 1.f));
            }
            LDS_BARRIER();
            if (wave >= 4) {
#pragma unroll
                for (int r = 0; r < 16; ++r) MAK[(ti * 32 + crow(r, hi)) * LP + tj * 32 + l31] = pacc[r];
            }
        }
#undef A2_TILE
        LDS_BARRIER();
        if (tid < 128) { LAS float* img = tid < 64 ? AT : MAK; sub_solve32(MAB, img + (tid & 63)); }
        LDS_BARRIER();
        if (wave >= 4) {
            LAS float* img = (wave & 2) ? MAK : AT; const int tj = wave & 1;
            f32x16 acc;
#pragma unroll
            for (int r = 0; r < 16; ++r) acc[r] = img[(32 + crow(r, hi)) * LP + tj * 32 + l31];
#pragma unroll
            for (int s2 = 0; s2 < 2; ++s2) RWK_MMA(acc, frag_row(MAB, 32 + l31, s2, hi), frag_col(img, tj * 32 + l31, s2, hi, 1.f));
#pragma unroll
            for (int r = 0; r < 16; ++r) img[(32 + crow(r, hi)) * LP + tj * 32 + l31] = acc[r];
        }
        LDS_BARRIER();
        if (tid < 128) { LAS float* img = tid < 64 ? AT : MAK; sub_solve32(MAB + 32 * LP + 32, img + 32 * LP + (tid & 63)); }
        LDS_BARRIER();
        {
            const int ti = (wave >> 1) & 1, tj = wave & 1;
            f32x16 acc = {};
            if (wave < 4) {
#pragma unroll
                for (int s2 = 0; s2 < 4; ++s2) RWK_MMA(acc, frag_row(RT, ti * 32 + l31, s2, hi), frag_row(BT, tj * 32 + l31, s2, hi));
                const int jj = tj * 32 + l31;
#pragma unroll
                for (int r = 0; r < 16; ++r) { const int tt = ti * 32 + crow(r, hi); MAB[tt * LP + jj] = (jj <= tt) ? acc[r] : 0.f; }
            } else {
                const float gl = GL[tj * 32 + l31];
#pragma unroll
                for (int s2 = 0; s2 < 4; ++s2) RWK_MMA(acc, frag_col(AT, ti * 32 + l31, s2, hi, 1.f), frag_col(BT, tj * 32 + l31, s2, hi, gl));
                float* out = TC + (size_t)chunk * 4096;
#pragma unroll
                for (int r = 0; r < 16; ++r) { const int kr = ti * 32 + crow(r, hi), kc = tj * 32 + l31; *GPTR(float, out + kr * 64 + kc) = acc[r] + (kr == kc ? gl : 0.f); }
            }
        }
        LDS_BARRIER();
        for (int q = wave; q < 12; q += 8) {
            const int kind = q >> 2, ti = (q >> 1) & 1, tj = q & 1;
            f32x16 acc = {};
            if (kind == 0) {
#pragma unroll
                for (int r = 0; r < 16; ++r) acc[r] = RT[(ti * 32 + crow(r, hi)) * LP + tj * 32 + l31];
#pragma unroll
                for (int s2 = 0; s2 < 4; ++s2) RWK_MMA(acc, frag_row(MAB, ti * 32 + l31, s2, hi), frag_col(AT, tj * 32 + l31, s2, hi, 1.f));
                bf16_t* out = (bf16_t*)GH + (size_t)chunk * 4096;
#pragma unroll
                for (int r = 0; r < 16; ++r) *GPTR(bf16_t, out + (ti * 32 + crow(r, hi)) * 64 + tj * 32 + l31) = (bf16_t)(cvt_pk_bf16(acc[r], 0.f) & 0xffffu);
            } else if (kind == 1) {
#pragma unroll
                for (int s2 = 0; s2 < 4; ++s2) RWK_MMA(acc, frag_row(MRK, ti * 32 + l31, s2, hi), frag_col(VV, tj * 32 + l31, s2, hi, 1.f));
#pragma unroll
                for (int s2 = 0; s2 < 4; ++s2) RWK_MMA(acc, frag_row(MAB, ti * 32 + l31, s2, hi), frag_col(MAK, tj * 32 + l31, s2, hi, 1.f));
#pragma unroll
                for (int r = 0; r < 16; ++r) *GPTR(bf16_t, Yg + g0 + (size_t)(ti * 32 + crow(r, hi)) * D + tj * 32 + l31) = (bf16_t)(cvt_pk_bf16(acc[r], 0.f) & 0xffffu);
            } else {
                const float gl = GL[tj * 32 + l31];
#pragma unroll
                for (int s2 = 0; s2 < 4; ++s2) RWK_MMA(acc, frag_col(MAK, ti * 32 + l31, s2, hi, 1.f), frag_col(BT, tj * 32 + l31, s2, hi, gl));
#pragma unroll
                for (int s2 = 0; s2 < 4; ++s2) RWK_MMA(acc, frag_col(VV, ti * 32 + l31, s2, hi, 1.f), frag_col(KT, tj * 32 + l31, s2, hi, gl));
                float* out = UC + (size_t)chunk * 4096;
#pragma unroll
                for (int r = 0; r < 16; ++r) *GPTR(float, out + (ti * 32 + crow(r, hi)) * 64 + tj * 32 + l31) = acc[r];
            }
        }
    }
    LDS_BARRIER();
}

DEVI void phaseB(const Ctx& c, int o, LAS float* L, int bid, int nb) {
    constexpr int P = 65, IM = 16 * P, SLOT0 = 2 * IM + 16, SLOTF = 4096 + 1024;
    const int tid = tid_opaque(), wave = __builtin_amdgcn_readfirstlane(tid >> 6), lane = tid & 63, i15 = lane & 15, kq = lane >> 4;
    const float* TC = (const float*)(CWS + B_TC); const float* UC = (const float*)(CWS + B_UC); bf16_t* SC = (bf16_t*)(CWS + B_SC);
    for (int item = bid; item < 256; item += nb) {
        const int bh = (item & 7) + 8 * (item >> 5), vt = (item >> 3) & 3;
        LDS_BARRIER();
        f32x4 st = {0.f, 0.f, 0.f, 0.f};
        if (wave < 4) {
#pragma unroll
            for (int r = 0; r < 4; ++r) L[(4 * kq + r) * P + 16 * wave + i15] = 0.f;
        }
        f32x4 rg[3][3];
#define PB_FETCH(set, cidx) do { const size_t cb = (size_t)(bh * 64 + (cidx)) * 4096; rg[set][0] = *GPTR(const f32x4, TC + cb + 4 * tid); rg[set][1] = *GPTR(const f32x4, TC + cb + 2048 + 4 * tid); \
            if (tid < 256) rg[set][2] = *GPTR(const f32x4, UC + cb + vt * 1024 + 4 * tid); } while (0)
#define PB_PARK(set, cidx) do { LAS float* sl = L + SLOT0 + ((cidx) & 1) * SLOTF; *(LAS f32x4*)(sl + 4 * tid) = rg[set][0]; *(LAS f32x4*)(sl + 2048 + 4 * tid) = rg[set][1]; \
            if (tid < 256) *(LAS f32x4*)(sl + 4096 + 4 * tid) = rg[set][2]; } while (0)
#define PB_STEP(cidx) do { if (wave < 4) { const size_t cho = (size_t)(bh * 64 + (cidx)) * 4096; LAS float* Sc = L + ((cidx) & 1) * IM; LAS float* Sn = L + (((cidx) + 1) & 1) * IM; \
            const LAS float* Tl = L + SLOT0 + ((cidx) & 1) * SLOTF; const LAS float* Ul = Tl + 4096; \
            _Pragma("unroll") for (int r = 0; r < 4; ++r) *GPTR(bf16_t, SC + cho + (16 * vt + 4 * kq + r) * 64 + 16 * wave + i15) = (bf16_t)(cvt_pk_bf16(st[r], 0.f) & 0xffffu); \
            f32x4 a0; _Pragma("unroll") for (int r = 0; r < 4; ++r) a0[r] = Ul[(4 * kq + r) * 64 + 16 * wave + i15]; \
            f32x4 a1 = {0.f, 0.f, 0.f, 0.f}, a2 = a1, a3 = a1; \
            _Pragma("unroll") for (int s2 = 0; s2 < 16; s2 += 4) { \
                a0 = __builtin_amdgcn_mfma_f32_16x16x4f32(Sc[i15 * P + 4 * s2 + kq], Tl[(4 * s2 + kq) * 64 + 16 * wave + i15], a0, 0, 0, 0); \
                a1 = __builtin_amdgcn_mfma_f32_16x16x4f32(Sc[i15 * P + 4 * (s2 + 1) + kq], Tl[(4 * (s2 + 1) + kq) * 64 + 16 * wave + i15], a1, 0, 0, 0); \
                a2 = __builtin_amdgcn_mfma_f32_16x16x4f32(Sc[i15 * P + 4 * (s2 + 2) + kq], Tl[(4 * (s2 + 2) + kq) * 64 + 16 * wave + i15], a2, 0, 0, 0); \
                a3 = __builtin_amdgcn_mfma_f32_16x16x4f32(Sc[i15 * P + 4 * (s2 + 3) + kq], Tl[(4 * (s2 + 3) + kq) * 64 + 16 * wave + i15], a3, 0, 0, 0); } \
            st = (a0 + a1) + (a2 + a3); \
            _Pragma("unroll") for (int r = 0; r < 4; ++r) Sn[(4 * kq + r) * P + 16 * wave + i15] = st[r]; } } while (0)
        PB_FETCH(0, 0); PB_FETCH(1, 1); PB_FETCH(2, 2);
        PB_PARK(0, 0);
        LDS_BARRIER();
        for (int cc = 0; cc < 63; cc += 3) {
            PB_FETCH(0, cc + 3); PB_STEP(cc);     PB_PARK(1, cc + 1); LDS_BARRIER();
            if (cc + 4 < 64) PB_FETCH(1, cc + 4); PB_STEP(cc + 1); PB_PARK(2, cc + 2); LDS_BARRIER();
            if (cc + 5 < 64) PB_FETCH(2, cc + 5); PB_STEP(cc + 2); PB_PARK(0, cc + 3); LDS_BARRIER();
        }
        PB_STEP(63);
#undef PB_FETCH
#undef PB_PARK
#undef PB_STEP
        if (wave < 4) {
            const int b = bh >> 4, h = bh & 15;
            float* op = COUT + O_PWKV + (((size_t)(o * NBP + b) * 16 + h) * 64) * 64;
#pragma unroll
            for (int r = 0; r < 4; ++r) *GPTR(float, op + (16 * vt + 4 * kq + r) * 64 + 16 * wave + i15) = st[r];
        }
    }
    LDS_BARRIER();
}

DEVI void phaseC(const Ctx& c, int bid, int nb) {
    const int tid = tid_opaque(), wave = __builtin_amdgcn_readfirstlane(tid >> 6), lane = tid & 63, l31 = lane & 31, hi = lane >> 5;
    const float* GH = (const float*)(CWS + B_GH); const float* SC = (const float*)(CWS + B_SC); bf16_t* Yg = (bf16_t*)(CWS + B_Y);
    for (int q = bid * 8 + wave; q < 4096 * 4; q += nb * 8) {
        const int chunk = q >> 2, ti = (q >> 1) & 1, tj = q & 1, cc = chunk & 63;
        const int bh = chunk >> 6, b = bh >> 4, h = bh & 15;
        f32x16 acc = {};
        if (cc != 0) {
            const bf16_t* ga = (const bf16_t*)GH + (size_t)chunk * 4096 + (ti * 32 + l31) * 64 + 8 * hi;
            const bf16_t* sb = (const bf16_t*)SC + (size_t)chunk * 4096 + (tj * 32 + l31) * 64 + 8 * hi;
#pragma unroll
            for (int s2 = 0; s2 < 4; ++s2) RWK_MMA(acc, __builtin_bit_cast(bf16x8, *GPTR(const u32x4, ga + 16 * s2)), __builtin_bit_cast(bf16x8, *GPTR(const u32x4, sb + 16 * s2)));
        }
        const size_t yo = ((size_t)(b * TP + cc * 64)) * D + h * 64 + tj * 32 + l31;
#pragma unroll
        for (int r = 0; r < 16; ++r) { const size_t p = yo + (size_t)(ti * 32 + crow(r, hi)) * D; *GPTR(bf16_t, Yg + p) = (bf16_t)(cvt_pk_bf16(acc[r], 0.f) & 0xffffu); }
    }
}
#undef RWK_MMA
}

#define XB_TMO      128
#define XB_XCNT(j)  (256  + 64 * (j))
#define XB_XSUB(j)  (1280 + 64 * (j))
#define XB_XGEN(j)  (2304 + 64 * (j))
#define XB_TOP      3328
#define XB_TOPGEN   3392
#define XCD_BAR_WORDS 3456
#define XB_SPIN_CAP (1u << 22)
DEVI unsigned xb_ld(unsigned* p)              { return __hip_atomic_load(p, __ATOMIC_RELAXED, __HIP_MEMORY_SCOPE_AGENT); }
DEVI unsigned xb_add(unsigned* p, unsigned v) { return __hip_atomic_fetch_add(p, v, __ATOMIC_RELAXED, __HIP_MEMORY_SCOPE_AGENT); }
DEVI unsigned xb_xcc_id() { return (unsigned)__builtin_amdgcn_s_getreg((3 << 11) | 20) & 0xFu; }
#define XB_SPIN(cond, bar) do { unsigned _sp = 0; while (cond) { __builtin_amdgcn_s_sleep(1); \
    if ((++_sp & 255u) == 0u) { if (xb_ld(&(bar)[XB_TMO])) break; if (_sp > XB_SPIN_CAP) { atomicAdd(&(bar)[XB_TMO], 1u); break; } } } } while (0)
struct XcdBarrier { unsigned* bar; unsigned x; volatile LAS unsigned* st; };
DEVI XcdBarrier xcd_barrier_post(unsigned* bar, volatile LAS unsigned* st) {
    XcdBarrier b; b.bar = bar; b.x = xb_xcc_id(); b.st = st;
    if (threadIdx.x == 0) (void)xb_add(&bar[XB_XCNT(b.x)], 1u);
    return b;
}
DEVI void xcd_barrier_complete(unsigned* bar, unsigned x, unsigned& nloc, unsigned& nx) {
    const unsigned G = gridDim.x * gridDim.y * gridDim.z;
    unsigned sum, cnt, mine, sp = 0u;
    for (;;) {
        sum = 0u; cnt = 0u; mine = 0u;
#pragma unroll
        for (unsigned j = 0; j < 16; ++j) { const unsigned cc = xb_ld(&bar[XB_XCNT(j)]); sum += cc; cnt += (cc > 0u) ? 1u : 0u; mine = (j == x) ? cc : mine; }
        if (sum == G) break;
        __builtin_amdgcn_s_sleep(1);
        if ((++sp & 255u) == 0u) { if (xb_ld(&bar[XB_TMO])) break; if (sp > XB_SPIN_CAP) { atomicAdd(&bar[XB_TMO], 1u); break; } }
    }
    nloc = mine > 0u ? mine : 1u; nx = cnt > 0u ? cnt : 1u;
}
template <bool FIRST> DEVI void xcd_barrier_t(const XcdBarrier& b) {
    asm volatile("s_waitcnt vmcnt(0)" ::: "memory");
    __syncthreads();
    if (tid_opaque() == 0) {
        unsigned* bar = b.bar; asm volatile("" : "+s"(bar)); unsigned bx = b.x; asm volatile("" : "+s"(bx));
        __builtin_amdgcn_s_waitcnt(0);
        unsigned nloc = b.st[0], nx = b.st[1];
        if (FIRST) { if (nloc == 0u) { xcd_barrier_complete(bar, bx, nloc, nx); b.st[0] = nloc; b.st[1] = nx; } }
        const unsigned old = xb_add(&bar[XB_XSUB(bx)], 1u);
        const unsigned gen = old / nloc;
        if (old + 1u == (gen + 1u) * nloc) {
            __builtin_amdgcn_fence(__ATOMIC_RELEASE, "agent");
            asm volatile("s_waitcnt vmcnt(0)" ::: "memory");
            const unsigned og = xb_add(&bar[XB_TOP], 1u);
            const unsigned tg = og / nx;
            if (og + 1u == (tg + 1u) * nx) xb_add(&bar[XB_TOPGEN], 1u);
            else XB_SPIN(xb_ld(&bar[XB_TOPGEN]) == tg, bar);
            __builtin_amdgcn_fence(__ATOMIC_ACQUIRE, "agent");
            xb_add(&bar[XB_XGEN(bx)], 1u);
            asm volatile("s_waitcnt vmcnt(0)" ::: "memory");
        } else {
            asm volatile("buffer_inv sc1" ::: "memory");
            XB_SPIN(xb_ld(&bar[XB_XGEN(bx)]) == gen, bar);
            asm volatile("s_waitcnt vmcnt(0)" ::: "memory");
        }
    }
    __syncthreads();
}

#define XB_SPLIT 4096
DEVI void split_arrive(unsigned* bar) {
    asm volatile("s_waitcnt vmcnt(0)" ::: "memory");
    __syncthreads();
    if (tid_opaque() == 0) { asm volatile("" : "+s"(bar)); __builtin_amdgcn_fence(__ATOMIC_RELEASE, "agent"); asm volatile("s_waitcnt vmcnt(0)" ::: "memory"); (void)xb_add(&bar[XB_SPLIT], 1u); }
}
DEVI void split_wait(unsigned* bar, unsigned target) {
    if (tid_opaque() == 0) { asm volatile("" : "+s"(bar)); XB_SPIN(xb_ld(&bar[XB_SPLIT]) < target, bar); __builtin_amdgcn_fence(__ATOMIC_ACQUIRE, "agent"); asm volatile("s_waitcnt vmcnt(0)" ::: "memory"); }
    __syncthreads();
}

constexpr int LDS_BYTES = 147456;
constexpr int MISC_OFF = 147456 - 64;

typedef pg8::EpiStore<true, false, 0, false, D, 256, 256, false> EpiF32;
typedef pg8::EpiStore<false, true, 0, false, D, 256, 256, false> EpiB16;
typedef pg8::EpiStore<true, true, 0, false, D, 256, 256, false> EpiF32B16;
typedef pg8::EpiStore<false, true, 0, true, D, 256, 256, false> EpiQ;
typedef pg8::EpiStore<false, true, 0, false, 256, 256, 1024u * 256u, false> EpiVT;
typedef pg8::EpiStore<false, true, 1, false, 128, 128, 0, false> EpiLoraTanh;
typedef pg8::EpiStore<false, true, 0, false, 128, 128, 0, false> EpiLora128;
typedef pg8::EpiStore<false, true, 2, false, 256, 256, 0, false> EpiLoraSig;
typedef pg8::EpiStore<true, false, 0, false, D, 256, 0, true> EpiScore;
typedef pg8::EpiStore<false, true, 0, false, D, 256, 0, true> EpiPV;
typedef pg8::EpiStore<false, true, 0, false, D, 256, 256, true> EpiFold;

__global__ void __launch_bounds__(NT, 2) mega_fwd(Ctx c) {
    extern __shared__ __attribute__((aligned(16))) unsigned char lds_raw[];
    LAS unsigned char* lds = (LAS unsigned char*)lds_raw;
    float* sm = (float*)lds_raw;
    if (threadIdx.x < 4) ((volatile LAS unsigned*)(lds + MISC_OFF))[threadIdx.x] = 0u;
    __syncthreads();
    XcdBarrier xb = xcd_barrier_post((unsigned*)(CWS + B_CTL), (volatile LAS unsigned*)(lds + MISC_OFF));
    const int bid0 = blockIdx.x, nb0 = gridDim.x;
#define bid opaque_s(bid0)
#define nb opaque_s(nb0)
#define BAR() xcd_barrier_t<false>(xb)
#define ws CWS
#define rowss ((float*)(CWS + B_ROWP))
#define X ((float*)(CWS + B_X))
#define XB ((bf16_t*)(CWS + B_XB))
#define WSB(off) ((bf16_t*)(CWS + (off)))
#define WSF(off) ((float*)(CWS + (off)))
#define GEMM(LDA_, LDB_, K_, EPI_T, Aptr, Bptr, nM_, nN_, Eobj, rot) do { pg8::Order<LDA_, LDB_, false> S_; { const int nb_ = nb; S_.init((nM_), (nN_), nb_, (bid + (rot)) % nb_); } \
        pg8::gemm_phase<LDA_, LDB_, K_, false, EPI_T>(lds, (Aptr), (Bptr), S_, (Eobj)); } while (0)

#ifdef PROBE_PAIR
    unsigned long long tacc0 = 0, tacc1 = 0, tacc2 = 0, tacc3 = 0, tlast = __builtin_amdgcn_s_memrealtime();
#define TCLASS(k) do { const unsigned long long tn_ = __builtin_amdgcn_s_memrealtime(); tacc##k += tn_ - tlast; tlast = tn_; } while (0)
#else
#define TCLASS(k) do {} while (0)
#endif
    ph_prologue(c, sm, bid, nb);
    xcd_barrier_t<true>(xb); TCLASS(3);
    for (int l = 0; l < 4; ++l) {
        const int e = l >> 1, o = l >> 1;
        if ((l & 1) == 0) {
            {
                pg8::EpiEvIn E{rowss + (size_t)(3 * l) * ROWP_N, COUT, CWS, e};
                GEMM(D, D, D, pg8::EpiEvIn, XB, WSB(B_WIN) + (size_t)e * 2048 * D, 66, 8, E, 0);
            }
            if (l == 2) for (int l2 = 2; l2 < 4; ++l2) {
                { pg8::Order<D, D, true> S_; { const int nb_ = nb; S_.init(1, 4, nb_, (bid + (l2 == 2 ? 240 : 112)) % nb_); } S_.nz = 16; S_.aZ1 = 256u * D * 2; S_.aZ2 = 512; S_.bZ1 = 0; S_.bZ2 = 512;
                  EpiFold E{nullptr, WSB(B_WKT) + (size_t)l2 * 4 * D * D, nullptr, (unsigned)D * D, 256u * D};
                  pg8::gemm_phase<D, D, 256, true, EpiFold>(lds, WSB(B_PMKB) + (size_t)l2 * 1024 * D, WSB(B_XWQN) + (size_t)l2 * D * D, S_, E); }
                { pg8::Order<D, D, true> S_; { const int nb_ = nb; S_.init(4, 1, nb_, (bid + (l2 == 2 ? 176 : 240)) % nb_); } S_.nz = 16; S_.aZ1 = 0; S_.aZ2 = 512; S_.bZ1 = 256u * D * 2; S_.bZ2 = 512;
                  EpiFold E{nullptr, WSB(B_VWT) + (size_t)l2 * 4 * D * D, nullptr, (unsigned)D * D, 256u};
                  pg8::gemm_phase<D, D, 256, true, EpiFold>(lds, WSB(B_XWO) + (size_t)l2 * D * D, WSB(B_PMVT) + (size_t)l2 * 1024 * D, S_, E); }
            }
            if (l == 0) for (int l2 = 0; l2 < 4; ++l2) {
                { EpiF32B16 E{COUT + O_PMK + (size_t)l2 * 1024 * D, WSB(B_PMKB) + (size_t)l2 * 1024 * D, nullptr, 0, 0}; GEMM(D, D, D, EpiF32B16, WSB(B_MEMB), WSB(B_XWK) + (size_t)l2 * D * D, 4, 4, E, 48 * l2 + 24); }
                { EpiF32B16 E{COUT + O_PMV + (size_t)l2 * 1024 * D, WSB(B_PMVT) + (size_t)l2 * 1024 * D, nullptr, 0, 0}; GEMM(D, D, D, EpiF32B16, WSB(B_MEMB), WSB(B_XWV) + (size_t)l2 * D * D, 4, 4, E, 48 * l2 + 24 + 16); }
            }
            BAR(); TCLASS(0);
            ph_pool_prep(c, e, bid, nb);
            for (int pass = 0; pass < 2; ++pass) {
                if (((pass ^ (int)bid) & 1) == 0) {
                    const attn_body::AttnTensors AT{(const attn_body::bf16*)(CWS + B_QB), (const attn_body::bf16*)(CWS + B_KB), (const attn_body::bf16*)(CWS + B_VB), (attn_body::bf16*)(CWS + B_OV)};
                    const attn_body::StaticOrder SO((int)nb, (int)bid);
                    attn_body::attn_phase<attn_body::StaticOrder>((char*)lds_raw, AT, SO);
                } else ph_diffattn_sample(c, e, (LAS float*)lds, bid, nb);
                __syncthreads();
            }
            BAR(); TCLASS(2);
            ph_diff_combine(c, e, bid, nb);
            ph_diff_combine_sample(c, e, bid, nb);
            if (l == 0) for (int l2 = 0; l2 < 2; ++l2) {
                { pg8::Order<D, D, true> S_; { const int nb_ = nb; S_.init(1, 4, nb_, (bid + 128 * l2) % nb_); } S_.nz = 16; S_.aZ1 = 256u * D * 2; S_.aZ2 = 512; S_.bZ1 = 0; S_.bZ2 = 512;
                  EpiFold E{nullptr, WSB(B_WKT) + (size_t)l2 * 4 * D * D, nullptr, (unsigned)D * D, 256u * D};
                  pg8::gemm_phase<D, D, 256, true, EpiFold>(lds, WSB(B_PMKB) + (size_t)l2 * 1024 * D, WSB(B_XWQN) + (size_t)l2 * D * D, S_, E); }
                { pg8::Order<D, D, true> S_; { const int nb_ = nb; S_.init(4, 1, nb_, (bid + 128 * l2 + 64) % nb_); } S_.nz = 16; S_.aZ1 = 0; S_.aZ2 = 512; S_.bZ1 = 256u * D * 2; S_.bZ2 = 512;
                  EpiFold E{nullptr, WSB(B_VWT) + (size_t)l2 * 4 * D * D, nullptr, (unsigned)D * D, 256u};
                  pg8::gemm_phase<D, D, 256, true, EpiFold>(lds, WSB(B_XWO) + (size_t)l2 * D * D, WSB(B_PMVT) + (size_t)l2 * 1024 * D, S_, E); }
            }
            BAR(); TCLASS(3);
            { pg8::EpiResid E{X, XB, rowss + (size_t)(3 * l + 1) * ROWP_N}; GEMM(D, D, D, pg8::EpiResid, WSB(B_CAT), WSB(B_WOUT) + (size_t)e * D * D, 64, 4, E, 0); }
            gemm_sample<D, D, 0>((LAS float*)lds, WSB(B_CAT), WSB(B_WOUT) + (size_t)e * D * D, X, XB, rowss + (size_t)(3 * l + 1) * ROWP_N, nullptr, nullptr, bid, nb);
            BAR(); TCLASS(0);
        } else {
            ph_shiftmix(c, l, bid, nb);
            BAR(); TCLASS(3);
            {
                { EpiB16 E{nullptr, WSB(B_R), nullptr, 0, 0}; GEMM(D, D, D, EpiB16, WSB(B_XM) + (size_t)0 * M * D, WSB(B_WR) + (size_t)o * D * D, 66, 4, E, 0); }
                { EpiB16 E{nullptr, WSB(B_K), nullptr, 0, 0}; GEMM(D, D, D, EpiB16, WSB(B_XM) + (size_t)2 * M * D, WSB(B_WK) + (size_t)o * D * D, 66, 4, E, 8); }
                { EpiB16 E{nullptr, WSB(B_V), nullptr, 0, 0}; GEMM(D, D, D, EpiB16, WSB(B_XM) + (size_t)3 * M * D, WSB(B_WV) + (size_t)o * D * D, 66, 4, E, 16); }
                { EpiLoraTanh E{nullptr, WSB(B_LW), nullptr, 0, 0}; GEMM(D, D, D, EpiLoraTanh, WSB(B_XM) + (size_t)1 * M * D, WSB(B_L1) + (size_t)(o * 4 + 0) * 256 * D, 66, 1, E, 24); }
                { EpiLora128 E{nullptr, WSB(B_LA), nullptr, 0, 0}; GEMM(D, D, D, EpiLora128, WSB(B_XM) + (size_t)4 * M * D, WSB(B_L1) + (size_t)(o * 4 + 1) * 256 * D, 66, 1, E, 90); }
                { EpiLoraSig E{nullptr, WSB(B_LG), nullptr, 0, 0}; GEMM(D, D, D, EpiLoraSig, WSB(B_XM) + (size_t)5 * M * D, WSB(B_L1) + (size_t)(o * 4 + 2) * 256 * D, 66, 1, E, 156); }
                if (o > 0) { EpiLora128 E{nullptr, WSB(B_LV), nullptr, 0, 0}; GEMM(D, D, D, EpiLora128, WSB(B_XM) + (size_t)3 * M * D, WSB(B_L1) + (size_t)(o * 4 + 3) * 256 * D, 66, 1, E, 222); }
            }
            BAR(); TCLASS(0);
            {
                { EpiB16 E{nullptr, WSB(B_W), nullptr, 0, 0}; GEMM(128, 128, 128, EpiB16, WSB(B_LW), WSB(B_L2W) + (size_t)o * D * 128, 66, 4, E, 0); }
                { EpiB16 E{nullptr, WSB(B_A), nullptr, 0, 0}; GEMM(128, 128, 128, EpiB16, WSB(B_LA), WSB(B_L2A) + (size_t)o * D * 128, 66, 4, E, 8); }
                { EpiB16 E{nullptr, WSB(B_G), nullptr, 0, 0}; GEMM(256, 256, 256, EpiB16, WSB(B_LG), WSB(B_L2G) + (size_t)o * D * 256, 66, 4, E, 16); }
                if (o > 0) { EpiB16 E{nullptr, WSB(B_VG), nullptr, 0, 0}; GEMM(128, 128, 128, EpiB16, WSB(B_LV), WSB(B_L2V) + (size_t)o * D * 128, 66, 4, E, 24); }
            }
            BAR(); TCLASS(0);
            ph_rw_prep(c, o, bid, nb);
            rwk::phaseA(c, o, (LAS float*)lds, bid, nb);
            BAR(); TCLASS(1);
            ph_rw_scan(c, o, bid, nb, (LAS float*)lds);
            rwk::phaseB(c, o, (LAS float*)lds, bid, nb);
            BAR(); TCLASS(1);
            rwk::phaseC(c, bid, nb);
            BAR(); TCLASS(1);
            ph_rw_post(c, o, bid, nb);
            BAR(); TCLASS(3);
            { pg8::EpiResid E{X, XB, rowss + (size_t)(3 * l + 1) * ROWP_N}; GEMM(D, D, D, pg8::EpiResid, WSB(B_YG), WSB(B_WO) + (size_t)o * D * D, 64, 4, E, 0); }
            gemm_sample<D, D, 0>((LAS float*)lds, WSB(B_YG), WSB(B_WO) + (size_t)o * D * D, X, XB, rowss + (size_t)(3 * l + 1) * ROWP_N, nullptr, nullptr, bid, nb);
            BAR(); TCLASS(0);
        }
        {
            pg8::Order<D, D, true> S_; S_.init(16, 1, nb, bid); S_.nz = 16; S_.aZ1 = (unsigned)TP * D * 2; S_.aZ2 = 0; S_.bZ1 = (unsigned)D * D * 2; S_.bZ2 = 256u * D * 2;
            pg8::EpiSoftmax E{WSB(B_P), (unsigned)TP * D, 256, (LAS float*)(lds + 131072), rowss + (size_t)(3 * l + 1) * ROWP_N};
            pg8::gemm_phase<D, D, D, true, pg8::EpiSoftmax>(lds, XB, WSB(B_WKT) + (size_t)l * 4 * D * D, S_, E);
        }
        gemm_sample<D, D, 1>((LAS float*)lds, XB, WSB(B_XWQ) + (size_t)l * D * D, nullptr, nullptr, nullptr, rowss + (size_t)(3 * l + 1) * ROWP_N, WSB(B_Q), bid, nb);
        BAR(); TCLASS(0);
        ph_xattn_sample(c, l, (LAS float*)lds, bid, nb);
        split_arrive((unsigned*)(CWS + B_CTL));
        {
            pg8::Order<D, D, true> S_; S_.init(16, 4, nb, bid); S_.nz = 4; S_.aZ1 = 0; S_.aZ2 = (unsigned)TP * D * 2; S_.bZ1 = 0; S_.bZ2 = (unsigned)D * D * 2;
            pg8::EpiResidT<true> E{X, XB, rowss + (size_t)(3 * l + 2) * ROWP_N};
            pg8::gemm_phase<D, D, D, true, pg8::EpiResidT<true>>(lds, WSB(B_P), WSB(B_VWT) + (size_t)l * 4 * D * D, S_, E);
        }
        {
            const int b_ = bid, h_ = nb >> 1;
            if (b_ >= h_) {
                split_wait((unsigned*)(CWS + B_CTL), (unsigned)(l + 1) * (unsigned)nb);
                gemm_sample<D, D, 0>((LAS float*)lds, WSB(B_O), WSB(B_XWO) + (size_t)l * D * D, X, XB, rowss + (size_t)(3 * l + 2) * ROWP_N, nullptr, nullptr, b_ - h_, nb - h_);
            }
        }
        BAR(); TCLASS(0);
        { pg8::EpiSwiglu E{rowss + (size_t)(3 * l + 2) * ROWP_N, WSB(B_HG)}; GEMM(D, D, D, pg8::EpiSwiglu, XB, WSB(B_FGU) + (size_t)l * 5632 * D, 66, 22, E, 0); }
        BAR(); TCLASS(0);
        { pg8::EpiResid E{X, XB, rowss + (size_t)(3 * l + 3) * ROWP_N}; GEMM(DFF, DFF, DFF, pg8::EpiResid, WSB(B_HG), WSB(B_FWD) + (size_t)l * D * DFF, 64, 4, E, 0); }
        gemm_sample<DFF, DFF, 0>((LAS float*)lds, WSB(B_HG), WSB(B_FWD) + (size_t)l * D * DFF, X, XB, rowss + (size_t)(3 * l + 3) * ROWP_N, nullptr, nullptr, bid, nb);
        BAR(); TCLASS(0);
    }
    ph_final(c, bid, nb);
#ifdef PROBE_PAIR
    TCLASS(3);
    __syncthreads();
    if (blockIdx.x == 0 && threadIdx.x == 0) {
        const float tA = (float)(PROBE_PAIR == 0 ? tacc0 : tacc2) * 0.01f, tB = (float)(PROBE_PAIR == 0 ? tacc1 : tacc3) * 0.01f;
        COUT[O_YP] = 8.f * tA; COUT[O_PSHIFT] = tB;
    }
#endif
#undef ws
#undef rowss
#undef X
#undef XB
#undef bid
#undef nb
}
}

extern "C" void kernel_launch(void* const* d_in, const int* in_sizes, int n_in, void* d_out, int out_size, void* d_ws, size_t ws_size, hipStream_t stream) {
    if (n_in != N_IN || (size_t)out_size != O_END || ws_size < B_END) return;
    Ctx c; for (int i = 0; i < N_IN; ++i) c.in[i] = (const float*)d_in[i];
    c.out = (float*)d_out; c.ws = (unsigned char*)d_ws;
    static int grid = 0;
    if (!grid) {
        int dev = 0, cus = 0;
        (void)hipGetDevice(&dev);
        (void)hipDeviceGetAttribute(&cus, hipDeviceAttributeMultiprocessorCount, dev);
        (void)hipFuncSetAttribute((const void*)mega_fwd, hipFuncAttributeMaxDynamicSharedMemorySize, LDS_BYTES);
        grid = cus > 0 ? cus : 256;
    }
    (void)hipMemsetAsync(d_ws, 0, 32768, stream);
    hipLaunchKernelGGL(mega_fwd, dim3(grid), dim3(NT), LDS_BYTES, stream, c);
}
```
